# Optimizing an MI355X kernel written in HIP

```python
import math
import jax, jax.numpy as jnp
from jax import lax
import numpy as np


D_MODEL = 1024
BATCH = 8
SEQ = 4096
DEPTH = 4

N_MEM = 256
N_BRANCH = 4
W_BRANCH = D_MODEL // 2
POOL_WINDOWS = (2, 4, 8, 16)
POOL_GROUP = W_BRANCH // len(POOL_WINDOWS)
DIL_GROUPS = ((128, 1), (512, 4), (2048, 16))
ATT_HEADS = 8
ATT_HEAD_DIM = W_BRANCH // ATT_HEADS
SSM_GROUP = 16
SSM_GROUPS = W_BRANCH // SSM_GROUP
SSM_STATE = 64
SGU_CHUNK = 128
SGU_GROUPS = 4
SGU_GROUP_DIM = W_BRANCH // SGU_GROUPS
X_HEADS = 4
X_HEAD_DIM = 128
D_FF = 4 * D_MODEL
REL_BUCKETS = 32
REL_MAX_DIST = 2048
EPS = 1e-6
NEG_INF = -1e30
N_ATT_COLS = 3 * len(DIL_GROUPS) * W_BRANCH
OFF_POOL = 0
OFF_ATT = OFF_POOL + W_BRANCH
OFF_SSM = OFF_ATT + N_ATT_COLS
OFF_SGU = OFF_SSM + W_BRANCH
OFF_GATE = OFF_SGU + 2 * W_BRANCH
IN_WIDTH = OFF_GATE + N_BRANCH * D_MODEL

kernel_name = 'hybrid_gated_parallel_mixer_block'


def rmsnorm(x, g):
    xf = x.astype(jnp.float32)
    y = xf * lax.rsqrt(jnp.mean(xf * xf, axis=-1, keepdims=True) + EPS)
    return (y * g.astype(jnp.float32)).astype(x.dtype)


def _t5_bucket(n):
    exact = REL_BUCKETS // 2
    nf = np.maximum(n, 1).astype(np.float32)
    large = exact + (np.log(nf / exact) / np.log(REL_MAX_DIST / exact) * (REL_BUCKETS - exact)).astype(np.int32)
    large = np.minimum(large, REL_BUCKETS - 1)
    return np.where(n < exact, n, large).astype(np.int32)


def _band_pattern(band, dil):
    i = np.arange(band)[:, None]
    kk = np.arange(2 * band)[None, :]
    dist = band + i - kk
    local = (dist >= 0) & (dist <= band)
    bucket = _t5_bucket(np.clip(dist, 0, band) * dil)
    return local, bucket


def pool_mixer(h, w_pool, scale):
    B, S, _ = h.shape
    hf = h.astype(jnp.float32)
    cs = jnp.pad(jnp.cumsum(hf, axis=1), ((0, 0), (1, 0), (0, 0)))
    t = jnp.arange(S)
    outs = []
    for gi, w in enumerate(POOL_WINDOWS):
        sl = slice(gi * POOL_GROUP, (gi + 1) * POOL_GROUP)
        lo = jnp.maximum(t + 1 - w, 0)
        cnt = jnp.minimum(t + 1, w).astype(jnp.float32)
        mean = (cs[:, 1:, sl] - cs[:, lo, sl]) / cnt[None, :, None]
        outs.append(mean - hf[..., sl])
    p = jnp.stack(outs, axis=2)
    y = jnp.einsum('bsgc,gcd->bsgd', p, w_pool.astype(jnp.float32)).reshape(B, S, W_BRANCH)
    return (y * scale.astype(jnp.float32)).astype(h.dtype)


def _dilated_group(q, k, v, bias, local, band, dil):
    B, S, H, E = q.shape
    L = S // dil
    nb = -(-L // band)
    Lp = nb * band

    def to_sub(a):
        a = a.reshape(B, L, dil, H, E).transpose(0, 2, 1, 3, 4)
        a = jnp.pad(a, ((0, 0), (0, 0), (0, Lp - L), (0, 0), (0, 0)))
        return a.reshape(B, dil, nb, band, H, E)

    def with_prev(a):
        prev = jnp.pad(a, ((0, 0), (0, 0), (1, 0), (0, 0), (0, 0), (0, 0)))[:, :, :-1]
        return jnp.concatenate([prev, a], axis=3)

    qs = to_sub(q)
    kk = with_prev(to_sub(k))
    vv = with_prev(to_sub(v))
    logits = jnp.einsum('brnqhe,brnkhe->brnhqk', qs, kk).astype(jnp.float32) * (E ** -0.5) + bias
    first = (jnp.arange(nb) == 0)[:, None, None] & (jnp.arange(2 * band) < band)[None, None, :]
    valid = local[None] & ~first
    logits = jnp.where(valid[None, None, :, None], logits, NEG_INF)
    m = jnp.max(logits, axis=-1, keepdims=True)
    p = jnp.exp(logits - m)
    s = jnp.sum(p, axis=-1, keepdims=True)
    o = jnp.einsum('brnhqk,brnkhe->brnqhe', (p / s).astype(v.dtype), vv)
    lse = (m + jnp.log(s))[..., 0]
    o = o.reshape(B, dil, Lp, H, E)[:, :, :L].transpose(0, 2, 1, 3, 4).reshape(B, S, H, E)
    lse = lse.transpose(0, 1, 2, 4, 3).reshape(B, dil, Lp, H)[:, :, :L]
    lse = lse.transpose(0, 2, 1, 3).reshape(B, S, H)
    return o, lse


def dilated_attention(qkv, rel_bias):
    B, S, _ = qkv.shape
    ng = len(DIL_GROUPS)
    q, k, v = [a.reshape(B, S, ng, ATT_HEADS, ATT_HEAD_DIM) for a in jnp.split(qkv, 3, axis=-1)]
    outs, lses = [], []
    for g, (win, dil) in enumerate(DIL_GROUPS):
        band = win // dil
        local, bucket = _band_pattern(band, dil)
        bias = rel_bias[jnp.asarray(bucket)][..., g * ATT_HEADS:(g + 1) * ATT_HEADS]
        bias = bias.transpose(2, 0, 1).astype(jnp.float32)
        o, lse = _dilated_group(q[:, :, g], k[:, :, g], v[:, :, g], bias, jnp.asarray(local), band, dil)
        outs.append(o.astype(jnp.float32))
        lses.append(lse)
    wts = jax.nn.softmax(jnp.stack(lses, axis=0), axis=0)
    out = jnp.sum(wts[..., None] * jnp.stack(outs, axis=0), axis=0)
    return out.reshape(B, S, W_BRANCH).astype(qkv.dtype)


def s5_mixer(u, a_re, a_im, log_dt, b_re, b_im, c_re, c_im, d_skip, w_glu, b_glu):
    f32 = jnp.float32
    B, S, _ = u.shape
    uf = u.astype(f32).reshape(B, S, SSM_GROUPS, SSM_GROUP)
    lam_re = jnp.minimum(a_re.astype(f32), -1e-4)
    lam_im = a_im.astype(f32)
    dt = jnp.exp(log_dt.astype(f32))[:, None]
    mag = jnp.exp(lam_re * dt)
    ab_re, ab_im = mag * jnp.cos(lam_im * dt), mag * jnp.sin(lam_im * dt)
    den = lam_re * lam_re + lam_im * lam_im
    f_re = ((ab_re - 1.0) * lam_re + ab_im * lam_im) / den
    f_im = (ab_im * lam_re - (ab_re - 1.0) * lam_im) / den
    br, bi = b_re.astype(f32), b_im.astype(f32)
    bb_re = f_re[..., None] * br - f_im[..., None] * bi
    bb_im = f_re[..., None] * bi + f_im[..., None] * br
    bu_re = jnp.einsum('bsgc,gpc->bsgp', uf, bb_re)
    bu_im = jnp.einsum('bsgc,gpc->bsgp', uf, bb_im)

    def combine(e1, e2):
        a1r, a1i, b1r, b1i = e1
        a2r, a2i, b2r, b2i = e2
        return (a2r * a1r - a2i * a1i, a2r * a1i + a2i * a1r,
                a2r * b1r - a2i * b1i + b2r, a2r * b1i + a2i * b1r + b2i)

    ar = jnp.broadcast_to(ab_re[None, None], (1, S, SSM_GROUPS, SSM_STATE))
    ai = jnp.broadcast_to(ab_im[None, None], (1, S, SSM_GROUPS, SSM_STATE))
    _, _, hr, hi = lax.associative_scan(combine, (ar, ai, bu_re, bu_im), axis=1)
    y = (jnp.einsum('bsgp,gcp->bsgc', hr, c_re.astype(f32))
         - jnp.einsum('bsgp,gcp->bsgc', hi, c_im.astype(f32))
         + uf * d_skip.astype(f32).reshape(SSM_GROUPS, SSM_GROUP))
    g = jax.nn.gelu(y.reshape(B, S, W_BRANCH))
    out = g * jax.nn.sigmoid(g @ w_glu.astype(f32) + b_glu.astype(f32))
    return out.astype(u.dtype)


def sgu_mixer(z, ln_g, ln_b, w_s, b_s):
    B, S, _ = z.shape
    z = jax.nn.gelu(z)
    u, v = jnp.split(z, 2, axis=-1)
    vf = v.astype(jnp.float32)
    mu = jnp.mean(vf, axis=-1, keepdims=True)
    var = jnp.mean(jnp.square(vf - mu), axis=-1, keepdims=True)
    vf = (vf - mu) * lax.rsqrt(var + EPS) * ln_g.astype(jnp.float32) + ln_b.astype(jnp.float32)
    vf = vf.reshape(B, S // SGU_CHUNK, SGU_CHUNK, SGU_GROUPS, SGU_GROUP_DIM)
    tri = jnp.tril(jnp.ones((SGU_CHUNK, SGU_CHUNK), jnp.float32))
    ws = w_s.astype(jnp.float32) * tri[None]
    sv = jnp.einsum('gts,bnsgc->bntgc', ws, vf) + b_s.astype(jnp.float32).T[:, :, None]
    return (u.astype(jnp.float32) * sv.reshape(B, S, W_BRANCH)).astype(z.dtype)


def cross_attn(h, mem_n, w_cq, w_ckv, w_co):
    B, S, _ = h.shape
    q = (h @ w_cq).reshape(B, S, X_HEADS, X_HEAD_DIM)
    k, v = jnp.split(mem_n @ w_ckv, 2, axis=-1)
    k = k.reshape(B, N_MEM, X_HEADS, X_HEAD_DIM)
    v = v.reshape(B, N_MEM, X_HEADS, X_HEAD_DIM)
    logits = jnp.einsum('bshe,bmhe->bhsm', q, k).astype(jnp.float32) * (X_HEAD_DIM ** -0.5)
    p = jax.nn.softmax(logits, axis=-1).astype(h.dtype)
    o = jnp.einsum('bhsm,bmhe->bshe', p, v).reshape(B, S, X_HEADS * X_HEAD_DIM)
    return o @ w_co


def setup_inputs(seed: int = 0) -> dict:
    key = jax.random.key(seed)
    ks = iter(jax.random.split(key, 48))
    f32 = jnp.float32
    L = DEPTH

    def nrm(shape, scale):
        return jax.random.normal(next(ks), shape, f32) * scale

    def gain(shape):
        return 1.0 + nrm(shape, 0.02)

    d = {}
    d['x'] = nrm((BATCH, SEQ, D_MODEL), 1.0)
    d['mem'] = nrm((BATCH, N_MEM, D_MODEL), 1.0)
    d['rel_bias'] = nrm((REL_BUCKETS, len(DIL_GROUPS) * ATT_HEADS), 0.5)
    d['g_mix_pre'] = gain((L, D_MODEL))
    d['g_mix_post'] = gain((L, D_MODEL))
    d['w_in'] = nrm((L, D_MODEL, IN_WIDTH), D_MODEL ** -0.5)
    d['gate_b'] = nrm((L, N_BRANCH, D_MODEL), 0.01)
    d['pool_w'] = nrm((L, len(POOL_WINDOWS), POOL_GROUP, POOL_GROUP), POOL_GROUP ** -0.5)
    d['pool_scale'] = 1.0 + nrm((L, W_BRANCH), 0.1)
    n_idx = jnp.arange(SSM_STATE, dtype=f32)
    d['a_re'] = -0.5 + nrm((L, SSM_GROUPS, SSM_STATE), 0.01)
    d['a_im'] = jnp.pi * n_idx + nrm((L, SSM_GROUPS, SSM_STATE), 0.01)
    d['log_dt'] = jax.random.uniform(next(ks), (L, SSM_GROUPS), f32, math.log(1e-3), math.log(1e-1))
    d['b_re'] = nrm((L, SSM_GROUPS, SSM_STATE, SSM_GROUP), (2 * SSM_GROUP) ** -0.5)
    d['b_im'] = nrm((L, SSM_GROUPS, SSM_STATE, SSM_GROUP), (2 * SSM_GROUP) ** -0.5)
    d['c_re'] = nrm((L, SSM_GROUPS, SSM_GROUP, SSM_STATE), (2 * SSM_STATE) ** -0.5)
    d['c_im'] = nrm((L, SSM_GROUPS, SSM_GROUP, SSM_STATE), (2 * SSM_STATE) ** -0.5)
    d['d_skip'] = nrm((L, W_BRANCH), 1.0)
    d['w_glu'] = nrm((L, W_BRANCH, W_BRANCH), W_BRANCH ** -0.5)
    d['b_glu'] = nrm((L, W_BRANCH), 0.01)
    d['sgu_ln_g'] = gain((L, W_BRANCH))
    d['sgu_ln_b'] = nrm((L, W_BRANCH), 0.01)
    d['w_s'] = nrm((L, SGU_GROUPS, SGU_CHUNK, SGU_CHUNK), SGU_CHUNK ** -0.5)
    d['b_s'] = 1.0 + nrm((L, SGU_GROUPS, SGU_CHUNK), 0.01)
    d['w_up'] = nrm((L, N_BRANCH, W_BRANCH, D_MODEL), W_BRANCH ** -0.5)
    d['w_out'] = nrm((L, D_MODEL, D_MODEL), D_MODEL ** -0.5)
    d['g_x_pre'] = gain((L, D_MODEL))
    d['g_x_post'] = gain((L, D_MODEL))
    d['g_mem'] = gain((L, D_MODEL))
    d['w_cq'] = nrm((L, D_MODEL, X_HEADS * X_HEAD_DIM), D_MODEL ** -0.5)
    d['w_ckv'] = nrm((L, D_MODEL, 2 * X_HEADS * X_HEAD_DIM), D_MODEL ** -0.5)
    d['w_co'] = nrm((L, X_HEADS * X_HEAD_DIM, D_MODEL), (X_HEADS * X_HEAD_DIM) ** -0.5)
    d['g_ff_pre'] = gain((L, D_MODEL))
    d['g_ff_post'] = gain((L, D_MODEL))
    d['w_ff1'] = nrm((L, D_MODEL, D_FF), D_MODEL ** -0.5)
    d['w_ff2'] = nrm((L, D_FF, D_MODEL), D_FF ** -0.5)
    return d


def reference(x, mem, rel_bias, g_mix_pre, g_mix_post, w_in, gate_b, pool_w, pool_scale,
              a_re, a_im, log_dt, b_re, b_im, c_re, c_im, d_skip, w_glu, b_glu,
              sgu_ln_g, sgu_ln_b, w_s, b_s, w_up, w_out, g_x_pre, g_x_post, g_mem,
              w_cq, w_ckv, w_co, g_ff_pre, g_ff_post, w_ff1, w_ff2):
    B, S, _ = x.shape
    for l in range(DEPTH):
        h = rmsnorm(x, g_mix_pre[l])
        proj = h @ w_in[l]
        a_out = pool_mixer(proj[..., OFF_POOL:OFF_ATT], pool_w[l], pool_scale[l])
        b_out = dilated_attention(proj[..., OFF_ATT:OFF_SSM], rel_bias)
        c_out = s5_mixer(proj[..., OFF_SSM:OFF_SGU], a_re[l], a_im[l], log_dt[l], b_re[l], b_im[l],
                         c_re[l], c_im[l], d_skip[l], w_glu[l], b_glu[l])
        d_out = sgu_mixer(proj[..., OFF_SGU:OFF_GATE], sgu_ln_g[l], sgu_ln_b[l], w_s[l], b_s[l])
        gates = jax.nn.sigmoid(proj[..., OFF_GATE:].reshape(B, S, N_BRANCH, D_MODEL) + gate_b[l])
        branches = (a_out, b_out, c_out, d_out)
        merged = gates[:, :, 0] * (branches[0] @ w_up[l, 0])
        for i in range(1, N_BRANCH):
            merged = merged + gates[:, :, i] * (branches[i] @ w_up[l, i])
        x = x + rmsnorm(merged @ w_out[l], g_mix_post[l])
        h = rmsnorm(x, g_x_pre[l])
        mem_n = rmsnorm(mem, g_mem[l])
        x = x + rmsnorm(cross_attn(h, mem_n, w_cq[l], w_ckv[l], w_co[l]), g_x_post[l])
        h = rmsnorm(x, g_ff_pre[l])
        ff = jnp.square(jax.nn.relu(h @ w_ff1[l])) @ w_ff2[l]
        x = x + rmsnorm(ff, g_ff_post[l])
    return x
```

```cpp
#include <hip/hip_runtime.h>
#include <hip/hip_cooperative_groups.h>
#include <cstdio>
#include <cstdint>
namespace cg = cooperative_groups;

constexpr int NB = 8, S = 4096, D = 1024, M = NB * S, MH = M / 2, DEPTH = 4, NMEM = 256;
constexpr int INW = 10752, OFF_ATT = 512, OFF_SSM = 5120, OFF_SGU = 5632, OFF_GATE = 6656;
constexpr int DFF = 4096;
constexpr float EPS = 1e-6f;

namespace pg8 {
#define PG8_LAS __attribute__((address_space(3)))
typedef unsigned short bf16_t;
typedef short bf16x8 __attribute__((ext_vector_type(8)));
typedef float f32x4 __attribute__((ext_vector_type(4)));
typedef unsigned u32x4 __attribute__((ext_vector_type(4)));
constexpr int BM = 256, BK = 64, HALF = 128, HTB = HALF * BK * 2  , STAGE_BYTES = 8 * HTB, NXCD = 8, WGM = 8;

__host__ __device__ __forceinline__ int lds_byte(int r, int c) { const int st = (r >> 4) * 2 + (c >> 5), rr = r & 15, cc = c & 31, ob = rr * 64 + cc * 2; return st * 1024 + (ob ^ (((ob >> 9) & 1) << 5)); }
__host__ __device__ __forceinline__ void stage_rc(int b, int& R, int& C) { const int st = b / 1024, sb = b % 1024, swz = sb ^ (((sb >> 9) & 1) << 5); R = (st >> 1) * 16 + swz / 64; C = (st & 1) * 32 + (swz % 64) / 2; }
__host__ __device__ __forceinline__ int perm32(int rho) { const int n = rho >> 4, i = rho & 15; return 8 * (i >> 2) + 4 * n + (i & 3); }

struct Unit { int pm, pn; };
struct Gemm { const bf16_t* A; const bf16_t* Bt; int M, N, K, lda; };

struct StaticOrder {
    int nM, nN, nwg, G, c;
    __host__ __device__ void init(int M, int N, int G_, int c_) { nM = M / BM; nN = N / BM; nwg = nM * nN; G = G_; c = c_; }
    __host__ __device__ bool next(int i, Unit& u) const {
        const long L = (long)i * G + c; if (L >= nwg) return false;
        int wgid = (int)L; { const int q = nwg / NXCD, r = nwg % NXCD, xcd = wgid % NXCD, off = wgid / NXCD; wgid = (xcd < r ? xcd * (q + 1) : r * (q + 1) + (xcd - r) * q) + off; }
        const int nig = WGM * nN, gid = wgid / nig, fm = gid * WGM, gsz = (nM - fm) < WGM ? (nM - fm) : WGM;
        u.pm = fm + ((wgid % nig) % gsz); u.pn = (wgid % nig) / gsz; return true;
    }
    __device__ __forceinline__ void a_ready(const Unit&) const {}
    __device__ __forceinline__ void done(const Unit&) const {}
};
__device__ __forceinline__ unsigned cvt_pk_bf16(float lo, float hi) { unsigned r; asm volatile("v_cvt_pk_bf16_f32 %0, %1, %2" : "=v"(r) : "v"(lo), "v"(hi)); return r; }
__device__ __forceinline__ float bflo(unsigned w) { return __builtin_bit_cast(float, w << 16); }
__device__ __forceinline__ float bfhi(unsigned w) { return __builtin_bit_cast(float, w & 0xffff0000u); }
__device__ __forceinline__ float sigm(float x) { return __builtin_amdgcn_rcpf(1.f + __expf(-x)); }
__device__ __forceinline__ float gelu_t(float x) { const float z = 1.5957691216057308f * (x + 0.044715f * x * x * x); return x * __builtin_amdgcn_rcpf(1.f + __expf(-z)); }

#define EPI_ARGS const f32x4 (&acc)[2][2][4][2], const Unit& u, int wr, int wc, int fr, int fq
#define EPI_FOR_ROWS _Pragma("unroll") for (int ai = 0; ai < 2; ++ai) _Pragma("unroll") for (int m = 0; m < 4; ++m)
#define EPI_FOR_BJ _Pragma("unroll") for (int bj = 0; bj < 2; ++bj)

struct EpiProj {
    static constexpr bool PERM = true, AFTER_DRAIN = false, CHAIN = false;
    bf16_t* O; const float* gb;
    __device__ __forceinline__ void operator()(EPI_ARGS) const {
        const int colt = u.pn * BM; const int mode = colt >= OFF_GATE ? 2 : (colt >= OFF_SGU ? 1 : 0);
        const int col0 = colt + wc * 32 + 8 * fq;
        f32x4 bv[2][2];
        EPI_FOR_BJ { _Pragma("unroll") for (int n = 0; n < 2; ++n) bv[bj][n] = (mode == 2) ? *(const f32x4*)(gb + (col0 - OFF_GATE) + bj * HALF + 4 * n) : (f32x4){0.f, 0.f, 0.f, 0.f}; }
        EPI_FOR_ROWS { const int row = u.pm * BM + ai * HALF + wr * 64 + m * 16 + fr; bf16_t* rowp = O + (size_t)row * INW + col0;
            EPI_FOR_BJ { f32x4 v0 = acc[ai][bj][m][0] + bv[bj][0], v1 = acc[ai][bj][m][1] + bv[bj][1];
                if (mode == 2) { _Pragma("unroll") for (int j = 0; j < 4; ++j) { v0[j] = sigm(v0[j]); v1[j] = sigm(v1[j]); } }
                else if (mode == 1) { _Pragma("unroll") for (int j = 0; j < 4; ++j) { v0[j] = gelu_t(v0[j]); v1[j] = gelu_t(v1[j]); } }
                u32x4 w; w.x = cvt_pk_bf16(v0[0], v0[1]); w.y = cvt_pk_bf16(v0[2], v0[3]); w.z = cvt_pk_bf16(v1[0], v1[1]); w.w = cvt_pk_bf16(v1[2], v1[3]);
                *(u32x4*)(rowp + bj * HALF) = w; } }
    }
};
template <int ACT  > struct EpiPlain {
    static constexpr bool PERM = true, AFTER_DRAIN = false, CHAIN = false;
    bf16_t* O; int ldc; float scale;
    __device__ __forceinline__ void operator()(EPI_ARGS) const {
        const int col0 = u.pn * BM + wc * 32 + 8 * fq;
        EPI_FOR_ROWS { const int row = u.pm * BM + ai * HALF + wr * 64 + m * 16 + fr; bf16_t* rowp = O + (size_t)row * ldc + col0;
            EPI_FOR_BJ { f32x4 v0 = acc[ai][bj][m][0], v1 = acc[ai][bj][m][1];
                if (ACT == 1) { _Pragma("unroll") for (int j = 0; j < 4; ++j) { const float a = fmaxf(v0[j], 0.f), b = fmaxf(v1[j], 0.f); v0[j] = a * a; v1[j] = b * b; } }
                v0 = v0 * scale; v1 = v1 * scale;
                u32x4 w; w.x = cvt_pk_bf16(v0[0], v0[1]); w.y = cvt_pk_bf16(v0[2], v0[3]); w.z = cvt_pk_bf16(v1[0], v1[1]); w.w = cvt_pk_bf16(v1[2], v1[3]);
                *(u32x4*)(rowp + bj * HALF) = w; } }
    }
};
struct EpiGlu {
    static constexpr bool PERM = true, AFTER_DRAIN = false, CHAIN = false;
    const bf16_t* G; bf16_t* O; const float* bias;
    __device__ __forceinline__ void operator()(EPI_ARGS) const {
        const int col0 = u.pn * BM + wc * 32 + 8 * fq;
        f32x4 bv[2][2];
        EPI_FOR_BJ { _Pragma("unroll") for (int n = 0; n < 2; ++n) bv[bj][n] = *(const f32x4*)(bias + col0 + bj * HALF + 4 * n); }
        EPI_FOR_ROWS { const int row = u.pm * BM + ai * HALF + wr * 64 + m * 16 + fr;
            EPI_FOR_BJ { const u32x4 gw = *(const u32x4*)(G + (size_t)row * INW + OFF_SSM + col0 + bj * HALF);
                f32x4 v0 = acc[ai][bj][m][0] + bv[bj][0], v1 = acc[ai][bj][m][1] + bv[bj][1];
                v0[0] = bflo(gw.x) * sigm(v0[0]); v0[1] = bfhi(gw.x) * sigm(v0[1]); v0[2] = bflo(gw.y) * sigm(v0[2]); v0[3] = bfhi(gw.y) * sigm(v0[3]);
                v1[0] = bflo(gw.z) * sigm(v1[0]); v1[1] = bfhi(gw.z) * sigm(v1[1]); v1[2] = bflo(gw.w) * sigm(v1[2]); v1[3] = bfhi(gw.w) * sigm(v1[3]);
                u32x4 w; w.x = cvt_pk_bf16(v0[0], v0[1]); w.y = cvt_pk_bf16(v0[2], v0[3]); w.z = cvt_pk_bf16(v1[0], v1[1]); w.w = cvt_pk_bf16(v1[2], v1[3]);
                *(u32x4*)(O + (size_t)row * 512 + col0 + bj * HALF) = w; } }
    }
};
struct EpiGateAcc {
    static constexpr bool PERM = true, AFTER_DRAIN = false, CHAIN = false;
    const bf16_t* P; float* TOT; bf16_t* O;
    __device__ __forceinline__ void operator()(EPI_ARGS) const {
        const int br = u.pn >> 2, pn = u.pn & 3, pm = u.pm & 63;
        const int col0 = pn * BM + wc * 32 + 8 * fq;
        EPI_FOR_ROWS { const int row = pm * BM + ai * HALF + wr * 64 + m * 16 + fr;
            EPI_FOR_BJ { const int col = col0 + bj * HALF;
                const u32x4 gw = *(const u32x4*)(P + (size_t)row * INW + OFF_GATE + br * 1024 + col);
                float* tp = TOT + (size_t)row * 1024 + col;
                f32x4 t0 = {0.f, 0.f, 0.f, 0.f}, t1 = {0.f, 0.f, 0.f, 0.f};
                if (br > 0) { t0 = *(const f32x4*)tp; t1 = *(const f32x4*)(tp + 4); }
                const f32x4 v0 = acc[ai][bj][m][0], v1 = acc[ai][bj][m][1];
                t0[0] += bflo(gw.x) * v0[0]; t0[1] += bfhi(gw.x) * v0[1]; t0[2] += bflo(gw.y) * v0[2]; t0[3] += bfhi(gw.y) * v0[3];
                t1[0] += bflo(gw.z) * v1[0]; t1[1] += bfhi(gw.z) * v1[1]; t1[2] += bflo(gw.w) * v1[2]; t1[3] += bfhi(gw.w) * v1[3];
                if (br < 3) { *(f32x4*)tp = t0; *(f32x4*)(tp + 4) = t1; }
                else { u32x4 w; w.x = cvt_pk_bf16(t0[0], t0[1]); w.y = cvt_pk_bf16(t0[2], t0[3]); w.z = cvt_pk_bf16(t1[0], t1[1]); w.w = cvt_pk_bf16(t1[2], t1[3]);
                    *(u32x4*)(O + (size_t)row * 1024 + col) = w; } } }
    }
};
struct EpiF32 {
    static constexpr bool PERM = false, AFTER_DRAIN = false, CHAIN = false;
    float* Y; int ldc;
    __device__ __forceinline__ void operator()(EPI_ARGS) const {
        const int col0 = u.pn * BM + wc * 32 + 4 * fq;
        EPI_FOR_ROWS { const int row = u.pm * BM + ai * HALF + wr * 64 + m * 16 + fr; float* rowp = Y + (size_t)row * ldc + col0;
            EPI_FOR_BJ { _Pragma("unroll") for (int n = 0; n < 2; ++n) *(f32x4*)(rowp + bj * HALF + n * 16) = acc[ai][bj][m][n]; } }
    }
};
struct EpiGateChain {
    static constexpr bool PERM = true, AFTER_DRAIN = false, CHAIN = true;
    const bf16_t* P; bf16_t* O;
    __device__ __forceinline__ void operator()(f32x4 (&acc)[2][2][4][2], const Unit& u, int wr, int wc, int fr, int fq) const {
        const int br = u.pn >> 2, pn = u.pn & 3, pm = u.pm & 63;
        const int col0 = pn * BM + wc * 32 + 8 * fq;
        EPI_FOR_ROWS { const int row = pm * BM + ai * HALF + wr * 64 + m * 16 + fr;
            EPI_FOR_BJ { const int col = col0 + bj * HALF;
                const bf16_t* gp = P + (size_t)row * INW + OFF_GATE + br * 1024 + col;
                const u32x4 gc = *(const u32x4*)gp;
                f32x4 v0 = acc[ai][bj][m][0], v1 = acc[ai][bj][m][1];
                v0[0] *= bflo(gc.x); v0[1] *= bfhi(gc.x); v0[2] *= bflo(gc.y); v0[3] *= bfhi(gc.y);
                v1[0] *= bflo(gc.z); v1[1] *= bfhi(gc.z); v1[2] *= bflo(gc.w); v1[3] *= bfhi(gc.w);
                if (br < 3) { const u32x4 gn = *(const u32x4*)(gp + 1024);
                    v0[0] *= __builtin_amdgcn_rcpf(fmaxf(bflo(gn.x), 1e-30f)); v0[1] *= __builtin_amdgcn_rcpf(fmaxf(bfhi(gn.x), 1e-30f)); v0[2] *= __builtin_amdgcn_rcpf(fmaxf(bflo(gn.y), 1e-30f)); v0[3] *= __builtin_amdgcn_rcpf(fmaxf(bfhi(gn.y), 1e-30f));
                    v1[0] *= __builtin_amdgcn_rcpf(fmaxf(bflo(gn.z), 1e-30f)); v1[1] *= __builtin_amdgcn_rcpf(fmaxf(bfhi(gn.z), 1e-30f)); v1[2] *= __builtin_amdgcn_rcpf(fmaxf(bflo(gn.w), 1e-30f)); v1[3] *= __builtin_amdgcn_rcpf(fmaxf(bfhi(gn.w), 1e-30f));
                    acc[ai][bj][m][0] = v0; acc[ai][bj][m][1] = v1; }
                else { u32x4 w; w.x = cvt_pk_bf16(v0[0], v0[1]); w.y = cvt_pk_bf16(v0[2], v0[3]); w.z = cvt_pk_bf16(v1[0], v1[1]); w.w = cvt_pk_bf16(v1[2], v1[3]);
                    *(u32x4*)(O + (size_t)row * 1024 + col) = w;
                    acc[ai][bj][m][0] = (f32x4){0.f, 0.f, 0.f, 0.f}; acc[ai][bj][m][1] = (f32x4){0.f, 0.f, 0.f, 0.f}; } } }
    }
};
struct BranchOrder {
    int G, c;
    __device__ bool next(int i, Unit& u) const { const int r = i >> 2, br = i & 3, T = r * G + c; if (T >= 256) return false; u.pm = br * 64 + (T >> 2); u.pn = br * 4 + (T & 3); return true; }
    __device__ __forceinline__ void a_ready(const Unit&) const {}
    __device__ __forceinline__ void done(const Unit&) const {}
};
template <class Epi, class Sched, bool ALIGN_EPI = false, bool SP2 = false>
__device__ __forceinline__ void gemm_phase(PG8_LAS unsigned char* lds, const Gemm g, const Sched& S, const Epi& E) {
    int tid_ = threadIdx.x; asm volatile("" : "+v"(tid_)); const int tid = tid_, wid = __builtin_amdgcn_readfirstlane(tid >> 6), lane = tid & 63, wr = wid >> 2, wc = wid & 3, fr = lane & 15, fq = lane >> 4;
    const int K = g.K, nt = K / BK;
    unsigned voffA[2], voffB[2];
#pragma unroll
    for (int i = 0; i < 2; ++i) { int R, C; stage_rc(tid * 16 + i * 8192, R, C); const int Rb = Epi::PERM ? ((R & ~31) + perm32(R & 31)) : R;
        voffA[i] = (unsigned)(R * g.lda + C) * 2u; voffB[i] = (unsigned)(Rb * K + C) * 2u; }
    const size_t kstep = (size_t)(BK * 2);
    const size_t hstepA = (size_t)HALF * g.lda * 2, hstepB = (size_t)HALF * K * 2;
    const size_t tstepA = 2 * hstepA, tstepB = 2 * hstepB;
    const unsigned ldsw = (unsigned)wid * 1024u;
    const int aoff = lds_byte(wr * 64 + fr, fq * 8), boff = lds_byte(wc * 32 + fr, fq * 8);
#define PG8_SA(b, h) (((b) * 2 + (h)) * HTB)
#define PG8_SB(b, h) ((4 + (b) * 2 + (h)) * HTB)
#define PG8_STAGE(bufoff, gbase, voff) do { _Pragma("unroll") for (int _i = 0; _i < 2; ++_i) \
        __builtin_amdgcn_global_load_lds((const unsigned*)((const char*)(gbase) + (voff)[_i]), (PG8_LAS unsigned*)(lds + (bufoff) + ldsw + _i * 8192), 16, 0, 0); } while (0)
#define PG8_LDA(dst, b, h) do { _Pragma("unroll") for (int m = 0; m < 4; ++m) _Pragma("unroll") for (int k = 0; k < 2; ++k) dst[m][k] = *(const PG8_LAS bf16x8*)(lds + PG8_SA(b, h) + aoff + m * 2048 + k * 1024); } while (0)
#define PG8_LDB(dst, b, h) do { _Pragma("unroll") for (int n = 0; n < 2; ++n) _Pragma("unroll") for (int k = 0; k < 2; ++k) dst[n][k] = *(const PG8_LAS bf16x8*)(lds + PG8_SB(b, h) + boff + n * 2048 + k * 1024); } while (0)
#define PG8_MMA(ai, bj, At, Bt) do { __builtin_amdgcn_s_setprio(1); _Pragma("unroll") for (int m = 0; m < 4; ++m) _Pragma("unroll") for (int n = 0; n < 2; ++n) _Pragma("unroll") for (int k = 0; k < 2; ++k) \
        acc[ai][bj][m][n] = __builtin_amdgcn_mfma_f32_16x16x32_bf16(Bt[n][k], At[m][k], acc[ai][bj][m][n], 0, 0, 0); __builtin_amdgcn_s_setprio(0); } while (0)
#define PG8_WAIT_V(n) asm volatile("s_waitcnt vmcnt(" #n ")" ::: "memory")
#define PG8_WAIT_L(n) asm volatile("s_waitcnt lgkmcnt(" #n ")" ::: "memory")
#define PG8_BAR __builtin_amdgcn_s_barrier()
#define PG8_SCHED __builtin_amdgcn_sched_barrier(0)
    Unit cur, nxt; int ui = 0;
    if (!S.next(0, cur)) return;
    f32x4 acc[2][2][4][2];
#pragma unroll
    for (int a = 0; a < 2; ++a)
#pragma unroll
        for (int b = 0; b < 2; ++b)
#pragma unroll
            for (int m = 0; m < 4; ++m)
#pragma unroll
                for (int n = 0; n < 2; ++n) acc[a][b][m][n] = (f32x4){0.f, 0.f, 0.f, 0.f};
    bf16x8 At[4][2], B0[2][2], B1[2][2];
    const char* cA = (const char*)g.A + (size_t)cur.pm * tstepA; const char* cB = (const char*)g.Bt + (size_t)cur.pn * tstepB;
    S.a_ready(cur);
    if constexpr (SP2) {
        PG8_STAGE(PG8_SB(0, 0), cB, voffB); PG8_STAGE(PG8_SB(0, 1), cB + hstepB, voffB); PG8_STAGE(PG8_SA(0, 0), cA, voffA); PG8_STAGE(PG8_SA(0, 1), cA + hstepA, voffA);
        if (wr == 1) PG8_BAR;
        PG8_WAIT_V(2); PG8_BAR;
        PG8_STAGE(PG8_SB(1, 0), cB + kstep, voffB); PG8_STAGE(PG8_SA(1, 0), cA + kstep, voffA); PG8_STAGE(PG8_SB(1, 1), cB + hstepB + kstep, voffB);
        PG8_WAIT_V(6); PG8_BAR;
    } else {
        PG8_STAGE(PG8_SB(0, 0), cB, voffB); PG8_STAGE(PG8_SA(0, 0), cA, voffA); PG8_STAGE(PG8_SB(0, 1), cB + hstepB, voffB); PG8_STAGE(PG8_SA(0, 1), cA + hstepA, voffA);
        if (wr == 1) PG8_BAR;
        PG8_WAIT_V(4); PG8_BAR;
        PG8_STAGE(PG8_SB(1, 0), cB + kstep, voffB); PG8_STAGE(PG8_SA(1, 0), cA + kstep, voffA); PG8_STAGE(PG8_SB(1, 1), cB + hstepB + kstep, voffB);
        PG8_WAIT_V(6); PG8_BAR;
    }
    for (;;) {
        const bool has_next = S.next(ui + 1, nxt);
        const char* nA = has_next ? (const char*)g.A + (size_t)nxt.pm * tstepA : cA; const char* nB = has_next ? (const char*)g.Bt + (size_t)nxt.pn * tstepB : cB;
        for (int t = 0; t < nt; t += 2) {
            const bool last = (t == nt - 2);
            const char* a1 = cA + (size_t)(t + 1) * kstep;
            const char* a2 = last ? nA : cA + (size_t)(t + 2) * kstep; const char* b2 = last ? nB : cB + (size_t)(t + 2) * kstep;
            const char* a3 = a2 + kstep; const char* b3 = b2 + kstep;
            if (last && has_next) S.a_ready(nxt);
            if constexpr (SP2) {
            PG8_LDB(B0, 0, 0); PG8_LDB(B1, 0, 1); PG8_SCHED; PG8_LDA(At, 0, 0); PG8_STAGE(PG8_SA(1, 1), a1 + hstepA, voffA);
            PG8_WAIT_V(8); PG8_WAIT_L(0); PG8_BAR; PG8_MMA(0, 0, At, B0); PG8_MMA(0, 1, At, B1); PG8_BAR; PG8_SCHED;
            PG8_LDA(At, 0, 1); PG8_STAGE(PG8_SB(0, 0), b2, voffB); PG8_STAGE(PG8_SB(0, 1), b2 + hstepB, voffB); PG8_STAGE(PG8_SA(0, 0), a2, voffA);
            PG8_WAIT_V(8); PG8_WAIT_L(0); PG8_BAR; PG8_MMA(1, 0, At, B0); PG8_MMA(1, 1, At, B1); PG8_BAR; PG8_SCHED;
            PG8_LDB(B0, 1, 0); PG8_LDB(B1, 1, 1); PG8_SCHED; PG8_LDA(At, 1, 0); PG8_STAGE(PG8_SA(0, 1), a2 + hstepA, voffA);
            PG8_WAIT_V(8); PG8_WAIT_L(0); PG8_BAR; PG8_MMA(0, 0, At, B0); PG8_MMA(0, 1, At, B1); PG8_BAR; PG8_SCHED;
            PG8_LDA(At, 1, 1); PG8_STAGE(PG8_SB(1, 0), b3, voffB); PG8_STAGE(PG8_SB(1, 1), b3 + hstepB, voffB); PG8_STAGE(PG8_SA(1, 0), a3, voffA);
            PG8_WAIT_V(8); PG8_WAIT_L(0); PG8_BAR; PG8_MMA(1, 0, At, B0); PG8_MMA(1, 1, At, B1); PG8_BAR; PG8_SCHED;
            } else {
            PG8_LDB(B0, 0, 0); PG8_SCHED; PG8_LDA(At, 0, 0); PG8_STAGE(PG8_SA(1, 1), a1 + hstepA, voffA);
            PG8_WAIT_L(8); PG8_BAR; PG8_WAIT_L(0); PG8_MMA(0, 0, At, B0); PG8_BAR; PG8_SCHED;
            PG8_LDB(B1, 0, 1); PG8_STAGE(PG8_SB(0, 0), b2, voffB);
            PG8_BAR; PG8_WAIT_L(0); PG8_MMA(0, 1, At, B1); PG8_BAR;
            PG8_LDA(At, 0, 1); PG8_STAGE(PG8_SA(0, 0), a2, voffA);
            PG8_BAR; PG8_WAIT_L(0); PG8_MMA(1, 0, At, B0); PG8_BAR; PG8_SCHED;
            PG8_STAGE(PG8_SB(0, 1), b2 + hstepB, voffB);
            PG8_WAIT_V(6); PG8_BAR; PG8_MMA(1, 1, At, B1); PG8_BAR;
            PG8_LDB(B0, 1, 0); PG8_SCHED; PG8_LDA(At, 1, 0); PG8_STAGE(PG8_SA(0, 1), a2 + hstepA, voffA);
            PG8_WAIT_L(8); PG8_BAR; PG8_WAIT_L(0); PG8_MMA(0, 0, At, B0); PG8_BAR; PG8_SCHED;
            PG8_LDB(B1, 1, 1); PG8_STAGE(PG8_SB(1, 0), b3, voffB);
            PG8_BAR; PG8_WAIT_L(0); PG8_MMA(0, 1, At, B1); PG8_BAR;
            PG8_LDA(At, 1, 1); PG8_STAGE(PG8_SA(1, 0), a3, voffA);
            PG8_BAR; PG8_WAIT_L(0); PG8_MMA(1, 0, At, B0); PG8_BAR; PG8_SCHED;
            PG8_STAGE(PG8_SB(1, 1), b3 + hstepB, voffB);
            PG8_WAIT_V(6); PG8_BAR; PG8_MMA(1, 1, At, B1); PG8_BAR;
            }
        }
        if constexpr (ALIGN_EPI) { if (wr == 0) PG8_BAR; }
        if constexpr (!Epi::AFTER_DRAIN) { E(acc, cur, wr, wc, fr, fq); S.done(cur); }
        if (!has_next) break;
        if constexpr (!Epi::CHAIN) {
#pragma unroll
        for (int a = 0; a < 2; ++a)
#pragma unroll
            for (int b = 0; b < 2; ++b)
#pragma unroll
                for (int m = 0; m < 4; ++m)
#pragma unroll
                    for (int n = 0; n < 2; ++n) acc[a][b][m][n] = (f32x4){0.f, 0.f, 0.f, 0.f};
        }
        cur = nxt; cA = nA; cB = nB; ++ui;
        if constexpr (ALIGN_EPI) { if (wr == 1) PG8_BAR; }
    }
    PG8_WAIT_V(0);
    if constexpr (!ALIGN_EPI) { if (wr == 0) PG8_BAR; }
    PG8_BAR;
    if constexpr (Epi::AFTER_DRAIN) { E.fused(acc, cur, wr, wc, fr, fq, lds, wid, lane); S.done(cur); }
#undef PG8_SA
#undef PG8_SB
#undef PG8_STAGE
#undef PG8_LDA
#undef PG8_LDB
#undef PG8_MMA
#undef PG8_WAIT_V
#undef PG8_WAIT_L
#undef PG8_BAR
#undef PG8_SCHED
}
}

constexpr size_t MiB = 1u << 20, KiB = 1u << 10;
constexpr size_t WS_CTL = 0, CTL_BYTES = 1 * MiB;
constexpr size_t WS_WIN = 1 * MiB, WS_WUP = 22 * MiB, WS_WOUT = 26 * MiB, WS_WCQ = 28 * MiB, WS_WCKV = 29 * MiB, WS_WCO = 31 * MiB, WS_WFF1 = 32 * MiB, WS_WFF2 = 40 * MiB, WS_WGLU = 48 * MiB;
constexpr size_t WS_POOLT = 48 * MiB + 512 * KiB, WS_WST = WS_POOLT + 256 * KiB, WS_AB = WS_WST + 256 * KiB, WS_BBT = WS_AB + 256 * KiB, WS_CM = WS_BBT + 256 * KiB;
constexpr size_t WS_MEMN = 50 * MiB, WS_KV = 54 * MiB, WS_LSE = 58 * MiB, WS_H = 60 * MiB, WS_MERGED = 124 * MiB, WS_TOT = 188 * MiB, WS_BR = 252 * MiB, WS_PROJ = 316 * MiB, WS_END = 652 * MiB;
constexpr size_t WS_Y = WS_PROJ, WS_Q = 444 * MiB, WS_O = 476 * MiB, WS_HID = WS_PROJ, WS_YFF = WS_MERGED;
static_assert(WS_CM + 256 * KiB <= WS_MEMN && WS_PROJ + (size_t)MH * INW * 2 <= WS_END && WS_HID + (size_t)M * DFF * 2 <= WS_END && WS_YFF + (size_t)M * D * 4 <= WS_BR, "ws map");
constexpr int LDS_BYTES = 147456;

#define LAS __attribute__((address_space(3)))
typedef unsigned short bf16;
typedef unsigned v4u __attribute__((ext_vector_type(4)));
typedef unsigned v2u __attribute__((ext_vector_type(2)));
typedef float f32x4 __attribute__((ext_vector_type(4)));
typedef short bf16x8 __attribute__((ext_vector_type(8)));
using pg8::bflo; using pg8::bfhi; using pg8::sigm; using pg8::gelu_t;
__device__ __forceinline__ unsigned f2bf(float f) { unsigned u = __builtin_bit_cast(unsigned, f); return (u + 0x7fffu + ((u >> 16) & 1u)) >> 16; }
__device__ __forceinline__ unsigned pk2(float lo, float hi) { return f2bf(lo) | (f2bf(hi) << 16); }
__device__ __forceinline__ float bf2f(bf16 b) { return __builtin_bit_cast(float, (unsigned)b << 16); }
__device__ __forceinline__ float wave_sum(float v) {
#pragma unroll
    for (int o = 1; o < 64; o <<= 1) v += __shfl_xor(v, o);
    return v;
}
#define LDS_WAIT() asm volatile("s_waitcnt lgkmcnt(0)" ::: "memory")

struct Args { const float* in[35]; float* out; unsigned char* ws; };
enum { I_X = 0, I_MEM, I_RELB, I_GMIXPRE, I_GMIXPOST, I_WIN, I_GATEB, I_POOLW, I_POOLS, I_ARE, I_AIM, I_LOGDT, I_BRE, I_BIM, I_CRE, I_CIM, I_DSKIP, I_WGLU, I_BGLU,
       I_LNG, I_LNB, I_WS, I_BS, I_WUP, I_WOUT, I_GXPRE, I_GXPOST, I_GMEM, I_WCQ, I_WCKV, I_WCO, I_GFFPRE, I_GFFPOST, I_WFF1, I_WFF2 };

__device__ __forceinline__ void tr_item(const float* W, int K, int N, bf16* WT, LAS float* scr, int item, int lane) {
    const int nblk = N / 32, kb = item / nblk, nb = item % nblk, k0 = 64 * kb, n0 = 32 * nb;
#pragma unroll 8
    for (int i = 0; i < 32; ++i) { const int kk = 2 * i + (lane >> 5); scr[kk * 33 + (lane & 31)] = W[(size_t)(k0 + kk) * N + n0 + (lane & 31)]; }
    LDS_WAIT();
    const int c = lane & 7;
#pragma unroll
    for (int j = 0; j < 4; ++j) { const int n = (lane >> 3) + 8 * j; const LAS float* s = scr + (8 * c) * 33 + n;
        v4u o; o.x = pk2(s[0 * 33], s[1 * 33]); o.y = pk2(s[2 * 33], s[3 * 33]); o.z = pk2(s[4 * 33], s[5 * 33]); o.w = pk2(s[6 * 33], s[7 * 33]);
        *(v4u*)(WT + (size_t)(n0 + n) * K + k0 + 8 * c) = o; }
    LDS_WAIT();
}
__device__ __forceinline__ void rms_row_bf16(const float* xrow, const float* g, bf16* orow, int lane) {
    const f32x4* xr = (const f32x4*)xrow + lane; const f32x4* gr = (const f32x4*)g + lane;
    f32x4 v[4]; float s = 0.f;
#pragma unroll
    for (int j = 0; j < 4; ++j) { v[j] = xr[64 * j]; s += (v[j].x * v[j].x + v[j].y * v[j].y) + (v[j].z * v[j].z + v[j].w * v[j].w); }
    const float r = rsqrtf(wave_sum(s) * (1.f / D) + EPS);
    v2u* o8 = (v2u*)orow + lane;
#pragma unroll
    for (int j = 0; j < 4; ++j) { const f32x4 gv = gr[64 * j]; v2u w; w.x = pk2(v[j].x * r * gv.x, v[j].y * r * gv.y); w.y = pk2(v[j].z * r * gv.z, v[j].w * r * gv.w); o8[64 * j] = w; }
}
__device__ __forceinline__ void rowpass(const float* Xi, const bf16* Y, const float* gpost, const float* gpre, float* Xo, bf16* Hh, int gw, int NGW, int lane) {
    for (int row = gw; row < M; row += NGW) {
        const v2u* yr = (const v2u*)(Y + (size_t)row * D) + lane; const f32x4* xr = (const f32x4*)(Xi + (size_t)row * D) + lane;
        f32x4 y[4], x[4]; float s = 0.f;
#pragma unroll
        for (int j = 0; j < 4; ++j) { const v2u yw = yr[64 * j]; y[j] = (f32x4){bflo(yw.x), bfhi(yw.x), bflo(yw.y), bfhi(yw.y)}; x[j] = xr[64 * j]; s += (y[j].x * y[j].x + y[j].y * y[j].y) + (y[j].z * y[j].z + y[j].w * y[j].w); }
        const float r = rsqrtf(wave_sum(s) * (1.f / D) + EPS); float s2 = 0.f;
        f32x4* xo = (f32x4*)(Xo + (size_t)row * D) + lane;
#pragma unroll
        for (int j = 0; j < 4; ++j) { const f32x4 gv = ((const f32x4*)gpost)[lane + 64 * j]; x[j] = x[j] + y[j] * r * gv; xo[64 * j] = x[j];
            s2 += (x[j].x * x[j].x + x[j].y * x[j].y) + (x[j].z * x[j].z + x[j].w * x[j].w); }
        if (gpre) { const float r2 = rsqrtf(wave_sum(s2) * (1.f / D) + EPS); v2u* o8 = (v2u*)(Hh + (size_t)row * D) + lane;
#pragma unroll
            for (int j = 0; j < 4; ++j) { const f32x4 gv = ((const f32x4*)gpre)[lane + 64 * j]; v2u w; w.x = pk2(x[j].x * r2 * gv.x, x[j].y * r2 * gv.y); w.y = pk2(x[j].z * r2 * gv.z, x[j].w * r2 * gv.w); o8[64 * j] = w; } }
    }
}
__device__ __forceinline__ int t5_bucket(int n) {
    if (n < 16) return n;
    return 16 + (n >= 22) + (n >= 30) + (n >= 40) + (n >= 54) + (n >= 73) + (n >= 99) + (n >= 134) + (n >= 182) + (n >= 246) + (n >= 332) + (n >= 450) + (n >= 609) + (n >= 825) + (n >= 1117) + (n >= 1513);
}
__device__ __forceinline__ double dexp_small(double x) {
    double t = 1.0, s = 1.0;
#pragma unroll
    for (int k = 1; k <= 16; ++k) { t *= x / (double)k; s += t; }
    return s;
}
__device__ __forceinline__ double dexp(double x) { double e = dexp_small(x * (1.0 / 32.0)); e *= e; e *= e; e *= e; e *= e; e *= e; return e; }
__device__ __forceinline__ void dsincos(double x, double& sn, double& cs) {
    const double TWO_PI = 6.283185307179586476925286766559;
    x -= TWO_PI * __builtin_rint(x * (1.0 / TWO_PI));
    const double r = x * 0.125, r2 = r * r;
    double st = r, ct = 1.0, s = r, c = 1.0;
#pragma unroll
    for (int k = 1; k <= 8; ++k) { ct *= -r2 / (double)((2 * k - 1) * (2 * k)); st *= -r2 / (double)((2 * k) * (2 * k + 1)); c += ct; s += st; }
#pragma unroll
    for (int k = 0; k < 3; ++k) { const double s2 = 2.0 * s * c, c2 = c * c - s * s; s = s2; c = c2; }
    sn = s; cs = c;
}
typedef short v4i16_t __attribute__((ext_vector_type(4)));
#define MFMA16(bfrag, afrag, c) __builtin_amdgcn_mfma_f32_16x16x32_bf16((bfrag), (afrag), (c), 0, 0, 0)
__device__ __forceinline__ void attn_naive(bf16* P, float* LSE, const float* relb, int gw, int NGW, int lane) {
    for (int uidx = gw; uidx < MH * 24; uidx += NGW) {
        const int r = uidx / 24, gh = uidx % 24, g = gh >> 3, h = gh & 7;
        const int t = r & (S - 1), dil = g == 0 ? 1 : (g == 1 ? 4 : 16);
        const int nd = min(t / dil, 128);
        bf16* prow = P + (size_t)r * INW + OFF_ATT + g * 512 + h * 64 + lane;
        const float q = bf2f(*prow);
        float mx = -1e30f, ss = 0.f, o = 0.f;
        for (int dist = 0; dist <= nd; ++dist) {
            const bf16* kp = prow - (size_t)dist * dil * INW;
            const float kv = bf2f(kp[1536]), vv = bf2f(kp[3072]);
            const float sc = wave_sum(q * kv) * 0.125f + relb[t5_bucket(dist * dil) * 24 + gh];
            const float mn = fmaxf(mx, sc), corr = __expf(mx - mn), p = __expf(sc - mn);
            ss = ss * corr + p; o = o * corr + p * vv; mx = mn;
        }
        *prow = (bf16)f2bf(o / ss);
        if (lane == 0) LSE[((size_t)g * MH + r) * 8 + h] = mx + __logf(ss);
    }
}
__device__ __forceinline__ void attn_merge(const bf16* __restrict__ P, const float* __restrict__ LSE, bf16* __restrict__ BR1, int gt, int NGT) {
#pragma unroll 4
    for (int e = gt; e < MH * 64; e += NGT) {
        const int r = e >> 6, ch = e & 63, h = ch >> 3;
        const float l0 = LSE[((size_t)0 * MH + r) * 8 + h], l1 = LSE[((size_t)1 * MH + r) * 8 + h], l2 = LSE[((size_t)2 * MH + r) * 8 + h];
        const float mx = fmaxf(l0, fmaxf(l1, l2));
        float w0 = __expf(l0 - mx), w1 = __expf(l1 - mx), w2 = __expf(l2 - mx); const float inv = 1.f / (w0 + w1 + w2); w0 *= inv; w1 *= inv; w2 *= inv;
        const bf16* base = P + (size_t)r * INW + OFF_ATT + ch * 8;
        const v4u a0 = *(const v4u*)base, a1 = *(const v4u*)(base + 512), a2 = *(const v4u*)(base + 1024);
        v4u o;
        o.x = pk2(w0 * bflo(a0.x) + w1 * bflo(a1.x) + w2 * bflo(a2.x), w0 * bfhi(a0.x) + w1 * bfhi(a1.x) + w2 * bfhi(a2.x));
        o.y = pk2(w0 * bflo(a0.y) + w1 * bflo(a1.y) + w2 * bflo(a2.y), w0 * bfhi(a0.y) + w1 * bfhi(a1.y) + w2 * bfhi(a2.y));
        o.z = pk2(w0 * bflo(a0.z) + w1 * bflo(a1.z) + w2 * bflo(a2.z), w0 * bfhi(a0.z) + w1 * bfhi(a1.z) + w2 * bfhi(a2.z));
        o.w = pk2(w0 * bflo(a0.w) + w1 * bflo(a1.w) + w2 * bflo(a2.w), w0 * bfhi(a0.w) + w1 * bfhi(a1.w) + w2 * bfhi(a2.w));
        *(v4u*)(BR1 + (size_t)r * 512 + ch * 8) = o;
    }
}
__device__ __forceinline__ void ssm_naive(bf16* P, const float* AB, const bf16* BBT, const bf16* CM, const float* dskip, int gw, int NGW, int lane) {
    for (int uidx = gw; uidx < 4 * 32; uidx += NGW) {
        const int bl = uidx >> 5, g = uidx & 31;
        float bbr[16], bbi[16], cr[16], ci[16];
#pragma unroll
        for (int c = 0; c < 16; ++c) { bbr[c] = bf2f(BBT[(g * 128 + lane) * 16 + c]); bbi[c] = bf2f(BBT[(g * 128 + 64 + lane) * 16 + c]);
            cr[c] = bf2f(CM[(g * 16 + c) * 128 + lane]); ci[c] = bf2f(CM[(g * 16 + c) * 128 + 64 + lane]); }
        const float ar = AB[(g * 64 + lane) * 2], ai = AB[(g * 64 + lane) * 2 + 1];
        const float dsk = dskip[g * 16 + (lane & 15)];
        float hr = 0.f, hi = 0.f;
        for (int t = 0; t < S; ++t) {
            bf16* up = P + (size_t)(bl * S + t) * INW + OFF_SSM + g * 16;
            const v4u u0 = *(const v4u*)up, u1 = *(const v4u*)(up + 8);
            const float ul = bf2f(up[lane & 15]);
            float u[16] = {bflo(u0.x), bfhi(u0.x), bflo(u0.y), bfhi(u0.y), bflo(u0.z), bfhi(u0.z), bflo(u0.w), bfhi(u0.w),
                           bflo(u1.x), bfhi(u1.x), bflo(u1.y), bfhi(u1.y), bflo(u1.z), bfhi(u1.z), bflo(u1.w), bfhi(u1.w)};
            float bur = 0.f, bui = 0.f;
#pragma unroll
            for (int c = 0; c < 16; ++c) { bur += bbr[c] * u[c]; bui += bbi[c] * u[c]; }
            const float nhr = ar * hr - ai * hi + bur, nhi = ar * hi + ai * hr + bui; hr = nhr; hi = nhi;
            float ym = 0.f;
#pragma unroll
            for (int c = 0; c < 16; ++c) { const float yc = wave_sum(cr[c] * hr + ci[c] * hi); if (lane == c) ym = yc; }
            if (lane < 16) up[lane] = (bf16)f2bf(gelu_t(ym + ul * dsk));
        }
    }
}
__device__ __forceinline__ void sgu_unit(LAS unsigned char* lds, const bf16* P, const bf16* WST, const float* lng, const float* lnb, const float* bs, bf16* BR3, int unit, int tid, int lane, int wave) {
    const int g = unit & 3, n = (unit >> 2) & 31, bl = unit >> 7;
    const int r0 = bl * S + n * 128;
    LAS float* stats = (LAS float*)lds; LAS bf16* VnT = (LAS bf16*)(lds + 1024);
    const int fr = lane & 15, fq = lane >> 4, tq = fr >> 2, tp = fr & 3, t = 16 * wave + fr, nks = (wave >> 1) + 1;
    v4u xs[16], vn[4]; bf16x8 wf[4]; v2u uw[8];
#pragma unroll
    for (int rr = 0; rr < 16; ++rr) xs[rr] = *(const v4u*)(P + (size_t)(r0 + 16 * wave + rr) * INW + OFF_SGU + 512 + lane * 8);
#pragma unroll
    for (int it = 0; it < 4; ++it) { const int idx = tid + 512 * it, s = idx >> 4, ch = (idx & 15) * 8; vn[it] = *(const v4u*)(P + (size_t)(r0 + s) * INW + OFF_SGU + 512 + g * 128 + ch); }
#pragma unroll
    for (int ks = 0; ks < 4; ++ks) wf[ks] = *(const bf16x8*)(WST + ((size_t)g * 128 + t) * 128 + 32 * ks + 8 * fq);
#pragma unroll
    for (int nt = 0; nt < 8; ++nt) uw[nt] = *(const v2u*)(P + (size_t)(r0 + t) * INW + OFF_SGU + g * 128 + 16 * nt + 4 * fq);
    const float bst = bs[g * 128 + t];
#pragma unroll
    for (int rr = 0; rr < 16; ++rr) { const int row = 16 * wave + rr; const v4u x = xs[rr];
        float v[8] = {bflo(x.x), bfhi(x.x), bflo(x.y), bfhi(x.y), bflo(x.z), bfhi(x.z), bflo(x.w), bfhi(x.w)};
        float s = 0.f;
#pragma unroll
        for (int j = 0; j < 8; ++j) s += v[j];
        const float mean = wave_sum(s) * (1.f / 512.f); float q = 0.f;
#pragma unroll
        for (int j = 0; j < 8; ++j) { const float d = v[j] - mean; q += d * d; }
        const float rstd = rsqrtf(wave_sum(q) * (1.f / 512.f) + EPS);
        if (lane == 0) { stats[row * 2] = mean; stats[row * 2 + 1] = rstd; } }
    __syncthreads();
#pragma unroll
    for (int it = 0; it < 4; ++it) { const int idx = tid + 512 * it, s = idx >> 4, ch = (idx & 15) * 8;
        const v4u x = vn[it];
        const float mean = stats[s * 2], rstd = stats[s * 2 + 1];
        float v[8] = {bflo(x.x), bfhi(x.x), bflo(x.y), bfhi(x.y), bflo(x.z), bfhi(x.z), bflo(x.w), bfhi(x.w)};
        const f32x4 g0 = *(const f32x4*)(lng + g * 128 + ch), g1 = *(const f32x4*)(lng + g * 128 + ch + 4), b0 = *(const f32x4*)(lnb + g * 128 + ch), b1 = *(const f32x4*)(lnb + g * 128 + ch + 4);
#pragma unroll
        for (int j = 0; j < 4; ++j) { v[j] = (v[j] - mean) * rstd * g0[j] + b0[j]; v[4 + j] = (v[4 + j] - mean) * rstd * g1[j] + b1[j]; }
        v4u w; w.x = pk2(v[0], v[1]); w.y = pk2(v[2], v[3]); w.z = pk2(v[4], v[5]); w.w = pk2(v[6], v[7]);
        *(LAS v4u*)(VnT + s * 136 + ch) = w;
    }
    __syncthreads();
    { f32x4 acc[8];
#pragma unroll
      for (int nt = 0; nt < 8; ++nt) acc[nt] = (f32x4){0.f, 0.f, 0.f, 0.f};
#pragma unroll
      for (int ks = 0; ks < 4; ++ks) if (ks < nks) {
#pragma unroll
          for (int nt = 0; nt < 8; ++nt) {
              const v4i16_t lo = __builtin_amdgcn_ds_read_tr16_b64_v4i16((LAS v4i16_t*)(VnT + (32 * ks + 8 * fq + tq) * 136 + 16 * nt + 4 * tp));
              const v4i16_t hi = __builtin_amdgcn_ds_read_tr16_b64_v4i16((LAS v4i16_t*)(VnT + (32 * ks + 8 * fq + 4 + tq) * 136 + 16 * nt + 4 * tp));
              const bf16x8 vf = {lo[0], lo[1], lo[2], lo[3], hi[0], hi[1], hi[2], hi[3]};
              acc[nt] = MFMA16(vf, wf[ks], acc[nt]); } }
#pragma unroll
      for (int nt = 0; nt < 8; ++nt) { const int c = 16 * nt + 4 * fq;
          v2u o; o.x = pk2(bflo(uw[nt].x) * (acc[nt][0] + bst), bfhi(uw[nt].x) * (acc[nt][1] + bst)); o.y = pk2(bflo(uw[nt].y) * (acc[nt][2] + bst), bfhi(uw[nt].y) * (acc[nt][3] + bst));
          *(v2u*)(BR3 + (size_t)(r0 + t) * 512 + g * 128 + c) = o; } }
    __syncthreads();
}
__device__ __forceinline__ void pool_unit(LAS unsigned char* lds, const bf16* P, const bf16* poolt, const float* pscale, bf16* BR0, int unit, int tid, int lane, int wave) {
    const int gi = unit & 3, tt = (unit >> 2) & 31, bl = unit >> 7;
    const int t0 = tt * 128, r0 = bl * S + t0, w = 2 << gi;
    LAS bf16* raw = (LAS bf16*)lds; LAS bf16* Pt = (LAS bf16*)(lds + 36864);
    const int fr = lane & 15, fq = lane >> 4;
    v4u rx[5];
#pragma unroll
    for (int it = 0; it < 5; ++it) { const int idx = tid + 512 * it, j = idx >> 4, ch = (idx & 15) * 8;
        rx[it] = (v4u){0u, 0u, 0u, 0u};
        if (idx < 144 * 16 && t0 - 16 + j >= 0) rx[it] = *(const v4u*)(P + (size_t)(r0 - 16 + j) * INW + gi * 128 + ch); }
    bf16x8 wfa[2][8];
#pragma unroll
    for (int ks = 0; ks < 2; ++ks)
#pragma unroll
        for (int nt = 0; nt < 8; ++nt) wfa[ks][nt] = *(const bf16x8*)(poolt + ((size_t)gi * 128 + 16 * nt + fr) * 128 + 32 * ks + 8 * fq);
#pragma unroll
    for (int it = 0; it < 5; ++it) { const int idx = tid + 512 * it, j = idx >> 4, ch = (idx & 15) * 8; if (idx < 144 * 16) *(LAS v4u*)(raw + j * 128 + ch) = rx[it]; }
    __syncthreads();
    { const int c = tid & 127, tq = tid >> 7, tb0 = tq * 32; const float rc = 1.f / (float)w;
      float s = 0.f;
      for (int j = 0; j < w; ++j) s += bf2f(raw[(16 + tb0 - j) * 128 + c]);
      for (int i = 0; i < 32; ++i) { const int t = tb0 + i; const int cnt = min(t0 + t + 1, w);
          const float cur = bf2f(raw[(16 + t) * 128 + c]);
          const float mean = (cnt == w) ? s * rc : s / (float)cnt;
          Pt[t * 136 + c] = (bf16)f2bf(mean - cur);
          s += bf2f(raw[(17 + t) * 128 + c]) - bf2f(raw[(17 + t - w) * 128 + c]); } }
    __syncthreads();
    { const int t = 16 * wave + fr;
      f32x4 acc[8];
#pragma unroll
      for (int nt = 0; nt < 8; ++nt) acc[nt] = (f32x4){0.f, 0.f, 0.f, 0.f};
#pragma unroll
      for (int ks = 0; ks < 4; ++ks) { const bf16x8 pf = *(const LAS bf16x8*)(Pt + t * 136 + 32 * ks + 8 * fq);
#pragma unroll
          for (int nt = 0; nt < 8; ++nt) { const bf16x8 wf = ks < 2 ? wfa[ks & 1][nt] : *(const bf16x8*)(poolt + ((size_t)gi * 128 + 16 * nt + fr) * 128 + 32 * ks + 8 * fq); acc[nt] = MFMA16(wf, pf, acc[nt]); } }
#pragma unroll
      for (int nt = 0; nt < 8; ++nt) { const int d = 16 * nt + 4 * fq; const f32x4 sc = *(const f32x4*)(pscale + gi * 128 + d);
          v2u o; o.x = pk2(acc[nt][0] * sc[0], acc[nt][1] * sc[1]); o.y = pk2(acc[nt][2] * sc[2], acc[nt][3] * sc[3]);
          *(v2u*)(BR0 + (size_t)(r0 + t) * 512 + gi * 128 + d) = o; } }
    __syncthreads();
}
__device__ __forceinline__ void xattn_naive(const bf16* Q, const bf16* KV, bf16* O, int gw, int NGW, int lane) {
    for (int uidx = gw; uidx < M * 4; uidx += NGW) {
        const int T = uidx >> 2, h = uidx & 3, b = T / S;
        const unsigned qw = *(const unsigned*)(Q + (size_t)T * 512 + h * 128 + 2 * lane);
        const float q0 = bflo(qw), q1 = bfhi(qw);
        float mx = -1e30f, ss = 0.f, o0 = 0.f, o1 = 0.f;
        for (int j = 0; j < NMEM; ++j) {
            const bf16* kr = KV + (size_t)(b * NMEM + j) * 1024 + h * 128 + 2 * lane;
            const unsigned kw = *(const unsigned*)kr, vw = *(const unsigned*)(kr + 512);
            const float sc = wave_sum(q0 * bflo(kw) + q1 * bfhi(kw));
            const float mn = fmaxf(mx, sc), corr = __expf(mx - mn), p = __expf(sc - mn);
            ss = ss * corr + p; o0 = o0 * corr + p * bflo(vw); o1 = o1 * corr + p * bfhi(vw); mx = mn;
        }
        const float inv = 1.f / ss;
        *(unsigned*)(O + (size_t)T * 512 + h * 128 + 2 * lane) = pk2(o0 * inv, o1 * inv);
    }
}
__device__ __forceinline__ void ssm_unit(LAS unsigned char* lds, bf16* P, const float* ABp, const bf16* BBTp, const bf16* CMp, const float* dskip, int unit, int tid, int lane, int wave) {
    const int bl = unit >> 5, g = unit & 31, fr = lane & 15, fq = lane >> 4;
    LAS float* bu = (LAS float*)(lds + wave * 16896);
    LAS bf16* hb = (LAS bf16*)(lds + wave * 16896);
    LAS float* ends = (LAS float*)(lds + 135168);
    const bf16x8 z8 = {0, 0, 0, 0, 0, 0, 0, 0};
    bf16x8 bbf[8], cmf[4];
#pragma unroll
    for (int nt = 0; nt < 8; ++nt) bbf[nt] = fq < 2 ? *(const bf16x8*)(BBTp + (size_t)(g * 128 + 16 * nt + fr) * 16 + 8 * fq) : z8;
#pragma unroll
    for (int ks = 0; ks < 4; ++ks) cmf[ks] = *(const bf16x8*)(CMp + (size_t)(g * 16 + fr) * 128 + 32 * ks + 8 * fq);
    const float ar = ABp[(g * 64 + lane) * 2], ai = ABp[(g * 64 + lane) * 2 + 1];
    float pr = ar, pi = ai;
#pragma unroll
    for (int i = 0; i < 5; ++i) { const float nr = pr * pr - pi * pi, ni = 2.f * pr * pi; pr = nr; pi = ni; }
    const f32x4 dsk = *(const f32x4*)(dskip + g * 16 + 4 * fq);
    float cr = 0.f, ci = 0.f;
    bf16x8 uf[2]; v2u uep[2], uepn[2];
#pragma unroll
    for (int mt = 0; mt < 2; ++mt) { const bf16* up = P + (size_t)(bl * S + wave * 32 + 16 * mt + fr) * INW + OFF_SSM + g * 16;
        uf[mt] = fq < 2 ? *(const bf16x8*)(up + 8 * fq) : z8; uep[mt] = *(const v2u*)(up + 4 * fq); }
    for (int ms = 0; ms < 16; ++ms) {
        const int rbase = bl * S + ms * 256 + wave * 32;
#pragma unroll
        for (int mt = 0; mt < 2; ++mt)
#pragma unroll
            for (int nt = 0; nt < 8; ++nt) { f32x4 acc = {0.f, 0.f, 0.f, 0.f}; acc = MFMA16(bbf[nt], uf[mt], acc);
                *(LAS f32x4*)(bu + (16 * mt + fr) * 132 + 16 * nt + 4 * fq) = acc; }
        { const int rn = bl * S + min(ms + 1, 15) * 256 + wave * 32;
#pragma unroll
          for (int mt = 0; mt < 2; ++mt) { const bf16* up = P + (size_t)(rn + 16 * mt + fr) * INW + OFF_SSM + g * 16;
              uf[mt] = fq < 2 ? *(const bf16x8*)(up + 8 * fq) : z8; uepn[mt] = *(const v2u*)(up + 4 * fq); } }
        LDS_WAIT();
        float vbr[32], vbi[32];
#pragma unroll
        for (int t = 0; t < 32; ++t) { vbr[t] = bu[t * 132 + lane]; vbi[t] = bu[t * 132 + 64 + lane]; }
        float hr = 0.f, hi = 0.f;
#pragma unroll
        for (int t = 0; t < 32; ++t) { const float nhr = ar * hr - ai * hi + vbr[t], nhi = ar * hi + ai * hr + vbi[t]; hr = nhr; hi = nhi; }
        ends[wave * 128 + lane] = hr; ends[wave * 128 + 64 + lane] = hi;
        __syncthreads();
        float sr = cr, si = ci, myr = cr, myi = ci;
#pragma unroll
        for (int w = 0; w < 8; ++w) { if (w == wave) { myr = sr; myi = si; }
            const float er = ends[w * 128 + lane], ei = ends[w * 128 + 64 + lane];
            const float nsr = pr * sr - pi * si + er, nsi = pr * si + pi * sr + ei; sr = nsr; si = nsi; }
        cr = sr; ci = si;
        hr = myr; hi = myi;
#pragma unroll
        for (int t = 0; t < 32; ++t) { const float nhr = ar * hr - ai * hi + vbr[t], nhi = ar * hi + ai * hr + vbi[t]; hr = nhr; hi = nhi;
            hb[t * 136 + lane] = (bf16)f2bf(hr); hb[t * 136 + 64 + lane] = (bf16)f2bf(hi); }
        LDS_WAIT();
#pragma unroll
        for (int mt = 0; mt < 2; ++mt) { f32x4 acc = {0.f, 0.f, 0.f, 0.f};
#pragma unroll
            for (int ks = 0; ks < 4; ++ks) { const bf16x8 hf_ = *(const LAS bf16x8*)(hb + (16 * mt + fr) * 136 + 32 * ks + 8 * fq); acc = MFMA16(cmf[ks], hf_, acc); }
            const float y0 = gelu_t(acc[0] + bflo(uep[mt].x) * dsk[0]), y1 = gelu_t(acc[1] + bfhi(uep[mt].x) * dsk[1]);
            const float y2 = gelu_t(acc[2] + bflo(uep[mt].y) * dsk[2]), y3 = gelu_t(acc[3] + bfhi(uep[mt].y) * dsk[3]);
            v2u o; o.x = pk2(y0, y1); o.y = pk2(y2, y3);
            *(v2u*)(P + (size_t)(rbase + 16 * mt + fr) * INW + OFF_SSM + g * 16 + 4 * fq) = o; }
        uep[0] = uepn[0]; uep[1] = uepn[1];
        __syncthreads();
    }
}
template <int HD> struct AttnRegs { v4u kx[256 * (HD / 8) / 512], vx[256 * (HD / 8) / 512]; bf16x8 qf[HD / 32]; };
template <int HD>
__device__ __forceinline__ void attn_issue(AttnRegs<HD>& R, const bf16* Qp, size_t qstride, const bf16* Kp, const bf16* Vp, size_t kstride, int kfirst, int tid, int lane, int wave) {
    constexpr int CPR = HD / 8, NIT = 256 * CPR / 512, KST = HD / 32;
#pragma unroll
    for (int it = 0; it < NIT; ++it) { const int idx = tid + 512 * it, kk = idx / CPR, cc = idx % CPR;
        R.kx[it] = (v4u){0u, 0u, 0u, 0u}; R.vx[it] = (v4u){0u, 0u, 0u, 0u};
        if (kk >= kfirst) { R.kx[it] = *(const v4u*)(Kp + (ptrdiff_t)kk * (ptrdiff_t)kstride + cc * 8); R.vx[it] = *(const v4u*)(Vp + (ptrdiff_t)kk * (ptrdiff_t)kstride + cc * 8); } }
    const int qi = 16 * wave + (lane & 15), fq = lane >> 4;
#pragma unroll
    for (int ks = 0; ks < KST; ++ks) R.qf[ks] = *(const bf16x8*)(Qp + (size_t)qi * qstride + 32 * ks + 8 * fq);
}
template <int HD, bool DIL>
__device__ __forceinline__ void attn_stage(LAS unsigned char* lds, const AttnRegs<HD>& R, const float* relb, int dil, int gh, int tid) {
    constexpr int PITCH = HD + 8, CPR = HD / 8, NIT = 256 * CPR / 512;
    LAS bf16* Ks = (LAS bf16*)lds; LAS bf16* Vs = (LAS bf16*)(lds + 256 * PITCH * 2); LAS float* tb = (LAS float*)(lds + 2 * 256 * PITCH * 2);
#pragma unroll
    for (int it = 0; it < NIT; ++it) { const int idx = tid + 512 * it, kk = idx / CPR, cc = idx % CPR;
        *(LAS v4u*)(Ks + kk * PITCH + cc * 8) = R.kx[it]; *(LAS v4u*)(Vs + kk * PITCH + cc * 8) = R.vx[it]; }
    if (DIL) { if (tid < 256) { const int dist = tid - 64; tb[tid] = (dist >= 0 && dist <= 128) ? relb[t5_bucket(dist * dil) * 24 + gh] : 0.f; } }
}
template <int HD, bool DIL>
__device__ __forceinline__ void attn_compute(LAS unsigned char* lds, const bf16x8 (&qf)[HD / 32], int kfirst, bf16* Op, size_t ostride, float* lsep, int dil, int tid, int lane, int wave) {
    constexpr int PITCH = HD + 8, KST = HD / 32, NDT = HD / 16, NT = DIL ? 10 : 16, NK2 = NT / 2;
    const int ntb = DIL ? (wave & ~1) : 0;
    LAS bf16* Ks = (LAS bf16*)lds; LAS bf16* Vs = (LAS bf16*)(lds + 256 * PITCH * 2); LAS float* tb = (LAS float*)(lds + 2 * 256 * PITCH * 2);
    const int fr = lane & 15, fq = lane >> 4;
    const int qi = 16 * wave + fr;
    f32x4 sacc[NT];
#pragma unroll
    for (int nt = 0; nt < NT; ++nt) { f32x4 acc = {0.f, 0.f, 0.f, 0.f};
#pragma unroll
        for (int ks = 0; ks < KST; ++ks) { const bf16x8 kf = *(const LAS bf16x8*)(Ks + (16 * (ntb + nt) + fr) * PITCH + 32 * ks + 8 * fq); acc = MFMA16(kf, qf[ks], acc); }
        sacc[nt] = acc; }
    const LAS float* tbl = tb + (33 + qi - 16 * ntb - 4 * fq);
    float mx = -1e30f;
#pragma unroll
    for (int nt = 0; nt < NT; ++nt)
#pragma unroll
        for (int j = 0; j < 4; ++j) { float s = sacc[nt][j];
            if (DIL) { const int kk = 16 * (ntb + nt) + 4 * fq + j, dist = 128 + qi - kk; const bool ok = (dist >= 0) && (dist <= 128) && (kk >= kfirst);
                const float bv = tbl[159 - (16 * nt + j)];
                s = ok ? fmaf(s, 0.125f, bv) : -1e30f; }
            sacc[nt][j] = s; mx = fmaxf(mx, s); }
    mx = fmaxf(mx, __shfl_xor(mx, 16)); mx = fmaxf(mx, __shfl_xor(mx, 32));
    float sum = 0.f;
    bf16x8 pf[NK2];
#pragma unroll
    for (int k2 = 0; k2 < NK2; ++k2) { float p[8];
#pragma unroll
        for (int j = 0; j < 4; ++j) { p[j] = __expf(sacc[2 * k2][j] - mx); p[4 + j] = __expf(sacc[2 * k2 + 1][j] - mx); }
#pragma unroll
        for (int j = 0; j < 8; ++j) sum += p[j];
        v4u w; w.x = pk2(p[0], p[1]); w.y = pk2(p[2], p[3]); w.z = pk2(p[4], p[5]); w.w = pk2(p[6], p[7]);
        pf[k2] = __builtin_bit_cast(bf16x8, w); }
    sum += __shfl_xor(sum, 16); sum += __shfl_xor(sum, 32);
    const float inv = 1.f / sum;
    const int tq = fr >> 2, tp = fr & 3;
#pragma unroll
    for (int dt = 0; dt < NDT; ++dt) { f32x4 oacc = {0.f, 0.f, 0.f, 0.f};
#pragma unroll
        for (int k2 = 0; k2 < NK2; ++k2) {
            const v4i16_t lo = __builtin_amdgcn_ds_read_tr16_b64_v4i16((LAS v4i16_t*)(Vs + (16 * ntb + 32 * k2 + 4 * fq + tq) * PITCH + 16 * dt + 4 * tp));
            const v4i16_t hi = __builtin_amdgcn_ds_read_tr16_b64_v4i16((LAS v4i16_t*)(Vs + (16 * ntb + 32 * k2 + 16 + 4 * fq + tq) * PITCH + 16 * dt + 4 * tp));
            const bf16x8 vf = {lo[0], lo[1], lo[2], lo[3], hi[0], hi[1], hi[2], hi[3]};
            oacc = MFMA16(vf, pf[k2], oacc); }
        v2u o; o.x = pk2(oacc[0] * inv, oacc[1] * inv); o.y = pk2(oacc[2] * inv, oacc[3] * inv);
        *(v2u*)(Op + (size_t)qi * ostride + 16 * dt + 4 * fq) = o; }
    if (DIL) { if (fq == 0) lsep[(size_t)qi * 8 * dil] = mx + __logf(sum); }
    __syncthreads();
}
struct DilU { bf16* Qp; const bf16* Kp; size_t stride; float* lsep; int kfirst, dil, gh; };
__device__ __forceinline__ DilU dil_decode(int v, bf16* PROJp, float* LSEp) {
    const int h = v & 7, j32 = (v >> 3) & 31, bg = v >> 8, g = bg % 3, bl = bg / 3, dil = g == 0 ? 1 : (g == 1 ? 4 : 16), res = j32 % dil, n = j32 / dil;
    const int rq0 = bl * S + 128 * n * dil + res;
    DilU d; d.Qp = PROJp + (size_t)rq0 * INW + OFF_ATT + g * 512 + h * 64; d.Kp = d.Qp + 1536 - (ptrdiff_t)128 * dil * INW; d.stride = (size_t)dil * INW;
    d.lsep = LSEp + ((size_t)g * MH + rq0) * 8 + h; d.kfirst = n == 0 ? 128 : 0; d.dil = dil; d.gh = g * 8 + h; return d;
}
__device__ __forceinline__ const float* kin(int k) { int kk = k; asm volatile("" : "+s"(kk)); return ((const float* const __attribute__((address_space(4)))*)__builtin_amdgcn_kernarg_segment_ptr())[kk]; }
typedef __attribute__((address_space(1))) unsigned gu32;
#define XB_TMO      128
#define XB_XCNT(j)  (256  + 64 * (j))
#define XB_XSUB(j)  (1280 + 64 * (j))
#define XB_XGEN(j)  (2304 + 64 * (j))
#define XB_TOP      3328
#define XB_TOPGEN   3392
#define XCD_BAR_WORDS 3456
#define XB_SPIN_CAP (1u << 18)

__device__ __forceinline__ unsigned xb_ld(unsigned* p)              { return __hip_atomic_load(p, __ATOMIC_RELAXED, __HIP_MEMORY_SCOPE_AGENT); }
__device__ __forceinline__ unsigned xb_add(unsigned* p, unsigned v) { return __hip_atomic_fetch_add(p, v, __ATOMIC_RELAXED, __HIP_MEMORY_SCOPE_AGENT); }
__device__ __forceinline__ unsigned xb_xcc_id() { return (unsigned)__builtin_amdgcn_s_getreg((3 << 11) | 20) & 0xFu; }
#define XB_SPIN(cond, bar) do { unsigned _sp = 0; while (cond) { __builtin_amdgcn_s_sleep(1); \
    if ((++_sp & 255u) == 0u) { if (xb_ld(&(bar)[XB_TMO])) break; if (_sp > XB_SPIN_CAP) { atomicAdd(&(bar)[XB_TMO], 1u); break; } } } } while (0)

struct XcdBarrier {
    unsigned* bar; unsigned x;
    volatile LAS unsigned* st;
};

__device__ __forceinline__ XcdBarrier xcd_barrier_post(unsigned* bar, volatile LAS unsigned* st) {
    XcdBarrier b; b.bar = bar; b.x = xb_xcc_id(); b.st = st;
    if (threadIdx.x == 0) (void)xb_add(&bar[XB_XCNT(b.x)], 1u);
    return b;
}
__device__ __forceinline__ void xcd_barrier_complete(unsigned* bar, unsigned x, unsigned& nloc, unsigned& nx) {
    const unsigned G = gridDim.x * gridDim.y * gridDim.z;
    unsigned sum, cnt, mine, sp = 0u;
    for (;;) {
        sum = 0u; cnt = 0u; mine = 0u;
#pragma unroll
        for (unsigned j = 0; j < 16; ++j) { const unsigned c = xb_ld(&bar[XB_XCNT(j)]); sum += c; cnt += (c > 0u) ? 1u : 0u; mine = (j == x) ? c : mine; }
        if (sum == G) break;
        __builtin_amdgcn_s_sleep(1);
        if ((++sp & 255u) == 0u) { if (xb_ld(&bar[XB_TMO])) break; if (sp > XB_SPIN_CAP) { atomicAdd(&bar[XB_TMO], 1u); break; } }
    }
    nloc = mine > 0u ? mine : 1u; nx = cnt > 0u ? cnt : 1u;
}

__device__ __forceinline__ void xcd_barrier(const XcdBarrier& b) {
    asm volatile("s_waitcnt vmcnt(0)" ::: "memory");
    __syncthreads();
    if (threadIdx.x == 0) {
        unsigned* bar = b.bar;
        __builtin_amdgcn_s_waitcnt(0);
        unsigned nloc = b.st[0], nx = b.st[1];
        if (nloc == 0u) { xcd_barrier_complete(bar, b.x, nloc, nx); b.st[0] = nloc; b.st[1] = nx; }
        const unsigned old = xb_add(&bar[XB_XSUB(b.x)], 1u);
        const unsigned gen = old / nloc;
        if (old + 1u == (gen + 1u) * nloc) {
            __builtin_amdgcn_fence(__ATOMIC_RELEASE, "agent");
            asm volatile("s_waitcnt vmcnt(0)" ::: "memory");
            const unsigned og = xb_add(&bar[XB_TOP], 1u);
            const unsigned tg = og / nx;
            if (og + 1u == (tg + 1u) * nx) xb_add(&bar[XB_TOPGEN], 1u);
            else XB_SPIN(xb_ld(&bar[XB_TOPGEN]) == tg, bar);
            __builtin_amdgcn_fence(__ATOMIC_ACQUIRE, "agent");
            xb_add(&bar[XB_XGEN(b.x)], 1u);
            asm volatile("s_waitcnt vmcnt(0)" ::: "memory");
        } else {
            XB_SPIN(xb_ld(&bar[XB_XGEN(b.x)]) == gen, bar);
            __builtin_amdgcn_fence(__ATOMIC_ACQUIRE, "agent");
            asm volatile("s_waitcnt vmcnt(0)" ::: "memory");
        }
    }
    __syncthreads();
}

__global__ void __launch_bounds__(512, 2) mk_fwd(Args a) {
    extern __shared__ __attribute__((aligned(16))) unsigned char lds_raw[];
    cg::grid_group grid = cg::this_grid();
    LAS unsigned char* lds = (LAS unsigned char*)lds_raw;
    const int G = gridDim.x, bid = blockIdx.x, NGW = G * 8, NGT = G * 512;
#define PH_BEGIN unsigned char* ws = a.ws; asm volatile("" : "+s"(ws)); int tid = threadIdx.x; asm volatile("" : "+v"(tid)); int l = ll; asm volatile("" : "+s"(l)); \
    const int lane = tid & 63, wave = __builtin_amdgcn_readfirstlane(tid >> 6), gw = bid * 8 + wave, gt = bid * 512 + tid; (void)lane; (void)wave; (void)gw; (void)gt; (void)l; (void)ws;
#define WP(T, off) ((T*)(ws + (off)))
#define WIN_T WP(bf16, WS_WIN)
#define WUP_T WP(bf16, WS_WUP)
#define WOUT_T WP(bf16, WS_WOUT)
#define WCQ_T WP(bf16, WS_WCQ)
#define WCKV_T WP(bf16, WS_WCKV)
#define WCO_T WP(bf16, WS_WCO)
#define WFF1_T WP(bf16, WS_WFF1)
#define WFF2_T WP(bf16, WS_WFF2)
#define WGLU_T WP(bf16, WS_WGLU)
#define POOLT WP(bf16, WS_POOLT)
#define WST WP(bf16, WS_WST)
#define AB WP(float, WS_AB)
#define BBT WP(bf16, WS_BBT)
#define CM WP(bf16, WS_CM)
#define MEMN WP(bf16, WS_MEMN)
#define KV WP(bf16, WS_KV)
#define LSE WP(float, WS_LSE)
#define Hn WP(bf16, WS_H)
#define MERGED WP(bf16, WS_MERGED)
#define TOT WP(float, WS_TOT)
#define BR WP(bf16, WS_BR)
#define PROJ WP(bf16, WS_PROJ)
#define Y WP(bf16, WS_Y)
#define Qb WP(bf16, WS_Q)
#define Ob WP(bf16, WS_O)
#define HID WP(bf16, WS_HID)
#define YFF WP(bf16, WS_YFF)
#define X (a.out)
#define IN(k) kin(k)
    volatile LAS unsigned* MISC = (volatile LAS unsigned*)(lds + LDS_BYTES - 64);
    if (threadIdx.x < 16) MISC[threadIdx.x] = 0u;
    __syncthreads();
    XcdBarrier xb = xcd_barrier_post((unsigned*)(a.ws + WS_CTL) + 4096, MISC + 8);
    grid.sync();
    for (int ll = 0; ll < DEPTH; ++ll) {
        { PH_BEGIN
            LAS float* scr = (LAS float*)(lds + wave * 16384);
            const float* w_in = IN(I_WIN) + (size_t)l * D * INW; const float* w_up = IN(I_WUP) + (size_t)l * 4 * 512 * 1024; const float* w_out = IN(I_WOUT) + (size_t)l * D * D;
            const float* w_cq = IN(I_WCQ) + (size_t)l * D * 512; const float* w_ckv = IN(I_WCKV) + (size_t)l * D * 1024; const float* w_co = IN(I_WCO) + (size_t)l * 512 * D;
            const float* w_ff1 = IN(I_WFF1) + (size_t)l * D * DFF; const float* w_ff2 = IN(I_WFF2) + (size_t)l * DFF * D; const float* w_glu = IN(I_WGLU) + (size_t)l * 512 * 512;
            const float* pool_w = IN(I_POOLW) + (size_t)l * 4 * 128 * 128;
            constexpr int N_WIN = (D / 64) * (INW / 32), N_UP = (512 / 64) * (1024 / 32), N_OUT = (D / 64) * (D / 32), N_CQ = (D / 64) * (512 / 32), N_CKV = (D / 64) * (1024 / 32),
                          N_CO = (512 / 64) * (D / 32), N_FF1 = (D / 64) * (DFF / 32), N_FF2 = (DFF / 64) * (D / 32), N_GLU = (512 / 64) * (512 / 32), N_POOL = (128 / 64) * (128 / 32);
            constexpr int NITEMS = N_WIN + 4 * N_UP + N_OUT + N_CQ + N_CKV + N_CO + N_FF1 + N_FF2 + N_GLU + 4 * N_POOL;
            for (int it = gw; it < NITEMS; it += NGW) {
                int r = it;
                if (r < N_WIN) { tr_item(w_in, D, INW, WIN_T, scr, r, lane); continue; } r -= N_WIN;
                if (r < 4 * N_UP) { const int i = r / N_UP; tr_item(w_up + (size_t)i * 512 * 1024, 512, 1024, WUP_T + (size_t)i * 1024 * 512, scr, r % N_UP, lane); continue; } r -= 4 * N_UP;
                if (r < N_OUT) { tr_item(w_out, D, D, WOUT_T, scr, r, lane); continue; } r -= N_OUT;
                if (r < N_CQ) { tr_item(w_cq, D, 512, WCQ_T, scr, r, lane); continue; } r -= N_CQ;
                if (r < N_CKV) { tr_item(w_ckv, D, 1024, WCKV_T, scr, r, lane); continue; } r -= N_CKV;
                if (r < N_CO) { tr_item(w_co, 512, D, WCO_T, scr, r, lane); continue; } r -= N_CO;
                if (r < N_FF1) { tr_item(w_ff1, D, DFF, WFF1_T, scr, r, lane); continue; } r -= N_FF1;
                if (r < N_FF2) { tr_item(w_ff2, DFF, D, WFF2_T, scr, r, lane); continue; } r -= N_FF2;
                if (r < N_GLU) { tr_item(w_glu, 512, 512, WGLU_T, scr, r, lane); continue; } r -= N_GLU;
                { const int i = r / N_POOL; tr_item(pool_w + (size_t)i * 128 * 128, 128, 128, POOLT + (size_t)i * 128 * 128, scr, r % N_POOL, lane); }
            }
            const float* w_s = IN(I_WS) + (size_t)l * 4 * 128 * 128;
            for (int e = gt; e < 4 * 128 * 128; e += NGT) { const int t = (e >> 7) & 127, s = e & 127; WST[e] = (s <= t) ? (bf16)f2bf(w_s[e]) : (bf16)0; }
            for (int e = gt; e < 32 * 64; e += NGT) {
                const int g = e >> 6, p = e & 63;
                const float are = fminf(IN(I_ARE)[(size_t)l * 2048 + e], -1e-4f), aim = IN(I_AIM)[(size_t)l * 2048 + e];
                const double lr = (double)are, li = (double)aim, dt = dexp((double)IN(I_LOGDT)[l * 32 + g]);
                const double mag = dexp_small(lr * dt); double sn, cs; dsincos(li * dt, sn, cs);
                const double abr = mag * cs, abi = mag * sn, den = lr * lr + li * li;
                const double fr_ = ((abr - 1.0) * lr + abi * li) / den, fi_ = (abi * lr - (abr - 1.0) * li) / den;
                AB[e * 2] = (float)abr; AB[e * 2 + 1] = (float)abi;
                const float* br_ = IN(I_BRE) + ((size_t)l * 2048 + e) * 16; const float* bi_ = IN(I_BIM) + ((size_t)l * 2048 + e) * 16;
                for (int c = 0; c < 16; ++c) { const double brc = br_[c], bic = bi_[c];
                    BBT[(g * 128 + p) * 16 + c] = (bf16)f2bf((float)(fr_ * brc - fi_ * bic)); BBT[(g * 128 + 64 + p) * 16 + c] = (bf16)f2bf((float)(fr_ * bic + fi_ * brc));
                    CM[(g * 16 + c) * 128 + p] = (bf16)f2bf(IN(I_CRE)[((size_t)l * 512 + g * 16 + c) * 64 + p]); CM[(g * 16 + c) * 128 + 64 + p] = (bf16)f2bf(-IN(I_CIM)[((size_t)l * 512 + g * 16 + c) * 64 + p]); }
            }
            for (int row = gw; row < NB * NMEM; row += NGW) rms_row_bf16(IN(I_MEM) + (size_t)row * D, IN(I_GMEM) + (size_t)l * D, MEMN + (size_t)row * D, lane);
            if (l == 0) for (int row = gw; row < M; row += NGW) rms_row_bf16(IN(I_X) + (size_t)row * D, IN(I_GMIXPRE), Hn + (size_t)row * D, lane);
        }
        xcd_barrier(xb);
        { PH_BEGIN
          pg8::Gemm g{MEMN, WCKV_T, NB * NMEM, 1024, D, D}; pg8::StaticOrder So; So.init(NB * NMEM, 1024, G, (bid + G / 2) % G);
          pg8::EpiPlain<0> E{KV, 1024, 1.f};
          pg8::gemm_phase<pg8::EpiPlain<0>, pg8::StaticOrder, true, true>(lds, g, So, E); }
        for (int hh = 0; hh < 2; ++hh) {
            { PH_BEGIN int hf = hh; asm volatile("" : "+s"(hf));
              pg8::Gemm g{Hn + (size_t)hf * MH * D, WIN_T, MH, INW, D, D}; pg8::StaticOrder So; So.init(MH, INW, G, bid);
              pg8::EpiProj E{PROJ, IN(I_GATEB) + (size_t)l * 4 * D};
              pg8::gemm_phase<pg8::EpiProj, pg8::StaticOrder, true, true>(lds, g, So, E); }
            xcd_barrier(xb);
            { PH_BEGIN int hf = hh; asm volatile("" : "+s"(hf));
                unsigned* ctr = (unsigned*)(ws + WS_CTL) + 8192 + (l * 2 + hf) * 64;
                volatile LAS int* nxt = (volatile LAS int*)(lds + LDS_BYTES - 64 + 16);
                if (tid == 0) { nxt[0] = (int)atomicAdd(ctr, 1u); nxt[1] = (int)atomicAdd(ctr, 1u); }
                __syncthreads();
                int u = nxt[0], un = nxt[1];
                __syncthreads();
                while (u < 1152) {
                    unsigned unn = 0u; if (tid == 0) unn = atomicAdd(ctr, 1u);
                    if (u < 128) ssm_unit(lds, PROJ, AB, BBT, CM, IN(I_DSKIP) + (size_t)l * 512, u, tid, lane, wave);
                    else if (u < 640) sgu_unit(lds, PROJ, WST, IN(I_LNG) + (size_t)l * 512, IN(I_LNB) + (size_t)l * 512, IN(I_BS) + (size_t)l * 512, BR + (size_t)3 * MH * 512, u - 128, tid, lane, wave);
                    else pool_unit(lds, PROJ, POOLT, IN(I_POOLS) + (size_t)l * 512, BR, u - 640, tid, lane, wave);
                    if (tid == 0) nxt[0] = (int)unn;
                    __syncthreads();
                    u = un; un = nxt[0];
                    __syncthreads();
                }
                if (u < 4224) {
                    AttnRegs<64> R;
                    { const DilU d = dil_decode(u - 1152, PROJ, LSE); attn_issue<64>(R, d.Qp, d.stride, d.Kp, d.Kp + 1536, d.stride, d.kfirst, tid, lane, wave); }
                    while (u < 4224) {
                        unsigned unn = 0u; if (tid == 0) unn = atomicAdd(ctr, 1u);
                        const DilU d = dil_decode(u - 1152, PROJ, LSE);
                        attn_stage<64, true>(lds, R, IN(I_RELB), d.dil, d.gh, tid);
                        bf16x8 qf[2] = {R.qf[0], R.qf[1]};
                        __syncthreads();
                        if (un < 4224) { const DilU dn = dil_decode(un - 1152, PROJ, LSE); attn_issue<64>(R, dn.Qp, dn.stride, dn.Kp, dn.Kp + 1536, dn.stride, dn.kfirst, tid, lane, wave); }
                        attn_compute<64, true>(lds, qf, d.kfirst, d.Qp, d.stride, d.lsep, d.dil, tid, lane, wave);
                        if (tid == 0) nxt[0] = (int)unn;
                        __syncthreads();
                        u = un; un = nxt[0];
                        __syncthreads();
                    }
                }
            }
            xcd_barrier(xb);
            { PH_BEGIN
                attn_merge(PROJ, LSE, BR + (size_t)1 * MH * 512, gt, NGT);
                pg8::Gemm g{PROJ + OFF_SSM, WGLU_T, MH, 512, 512, INW}; pg8::StaticOrder So; So.init(MH, 512, G, bid);
                pg8::EpiGlu E{PROJ, BR + (size_t)2 * MH * 512, IN(I_BGLU) + (size_t)l * 512};
                pg8::gemm_phase<pg8::EpiGlu, pg8::StaticOrder, true, true>(lds, g, So, E);
            }
            xcd_barrier(xb);
            { PH_BEGIN int hf = hh; asm volatile("" : "+s"(hf));
              pg8::Gemm g{BR, WUP_T, 4 * MH, 4 * 1024, 512, 512}; pg8::BranchOrder So{G, bid};
              pg8::EpiGateChain E{PROJ, MERGED + (size_t)hf * MH * D};
              pg8::gemm_phase<pg8::EpiGateChain, pg8::BranchOrder, true, true>(lds, g, So, E); }
            xcd_barrier(xb);
        }
        { PH_BEGIN
          pg8::Gemm g{MERGED, WOUT_T, M, D, D, D}; pg8::StaticOrder So; So.init(M, D, G, bid);
          pg8::EpiPlain<0> E{Y, D, 1.f};
          pg8::gemm_phase<pg8::EpiPlain<0>, pg8::StaticOrder, true, true>(lds, g, So, E); }
        xcd_barrier(xb);
        { PH_BEGIN rowpass(l == 0 ? IN(I_X) : X, Y, IN(I_GMIXPOST) + (size_t)l * D, IN(I_GXPRE) + (size_t)l * D, X, Hn, gw, NGW, lane); }
        xcd_barrier(xb);
        { PH_BEGIN
          pg8::Gemm g{Hn, WCQ_T, M, 512, D, D}; pg8::StaticOrder So; So.init(M, 512, G, bid);
          pg8::EpiPlain<0> E{Qb, 512, 0.08838834764831845f};
          pg8::gemm_phase<pg8::EpiPlain<0>, pg8::StaticOrder, true, true>(lds, g, So, E); }
        xcd_barrier(xb);
        { PH_BEGIN
          for (int bu = bid; bu < 256; bu += G) {
              const int bh = bu >> 3, b = bh >> 2, h = bh & 3, tile0 = b * 32 + (bu & 7) * 4;
              const bf16* Kp = KV + (size_t)b * NMEM * 1024 + h * 128;
              bf16x8 qf[4];
              { AttnRegs<128> R; attn_issue<128>(R, Qb + (size_t)tile0 * 128 * 512 + h * 128, 512, Kp, Kp + 512, 1024, 0, tid, lane, wave);
                attn_stage<128, false>(lds, R, nullptr, 1, 0, tid);
#pragma unroll
                for (int ks = 0; ks < 4; ++ks) qf[ks] = R.qf[ks]; }
              __syncthreads();
              for (int k = 0; k < 4; ++k) { const int tile = tile0 + k, tn = tile0 + min(k + 1, 3);
                  bf16x8 qn[4];
#pragma unroll
                  for (int ks = 0; ks < 4; ++ks) qn[ks] = *(const bf16x8*)(Qb + (size_t)(tn * 128 + 16 * wave + (lane & 15)) * 512 + h * 128 + 32 * ks + 8 * (lane >> 4));
                  attn_compute<128, false>(lds, qf, 0, Ob + (size_t)tile * 128 * 512 + h * 128, 512, nullptr, 1, tid, lane, wave);
#pragma unroll
                  for (int ks = 0; ks < 4; ++ks) qf[ks] = qn[ks]; } } }
        xcd_barrier(xb);
        { PH_BEGIN
          pg8::Gemm g{Ob, WCO_T, M, D, 512, 512}; pg8::StaticOrder So; So.init(M, D, G, bid);
          pg8::EpiPlain<0> E{Y, D, 1.f};
          pg8::gemm_phase<pg8::EpiPlain<0>, pg8::StaticOrder, true, true>(lds, g, So, E); }
        xcd_barrier(xb);
        { PH_BEGIN rowpass(X, Y, IN(I_GXPOST) + (size_t)l * D, IN(I_GFFPRE) + (size_t)l * D, X, Hn, gw, NGW, lane); }
        xcd_barrier(xb);
        { PH_BEGIN
          pg8::Gemm g{Hn, WFF1_T, M, DFF, D, D}; pg8::StaticOrder So; So.init(M, DFF, G, bid);
          pg8::EpiPlain<1> E{HID, DFF, 1.f};
          pg8::gemm_phase<pg8::EpiPlain<1>, pg8::StaticOrder, true, true>(lds, g, So, E); }
        xcd_barrier(xb);
        { PH_BEGIN
          pg8::Gemm g{HID, WFF2_T, M, D, DFF, DFF}; pg8::StaticOrder So; So.init(M, D, G, bid);
          pg8::EpiPlain<0> E{YFF, D, 1.f};
          pg8::gemm_phase<pg8::EpiPlain<0>, pg8::StaticOrder, true, true>(lds, g, So, E); }
        xcd_barrier(xb);
        { PH_BEGIN rowpass(X, YFF, IN(I_GFFPOST) + (size_t)l * D, (l + 1 < DEPTH) ? IN(I_GMIXPRE) + (size_t)(l + 1) * D : nullptr, X, Hn, gw, NGW, lane); }
        xcd_barrier(xb);
    }
}

extern "C" void kernel_launch(void* const* d_in, const int* in_sizes, int n_in, void* d_out, int out_size, void* d_ws, size_t ws_size, hipStream_t stream) {
    static int grid = 0;
    if (grid == 0) {
        if (n_in != 35 || in_sizes[0] != M * D || out_size != M * D || ws_size < WS_END) { fprintf(stderr, "kernel_launch: unexpected problem (n_in %d, ws %zu, need %zu)\n", n_in, ws_size, (size_t)WS_END); grid = -1; return; }
        int dev = 0, cus = 0, per_cu = 0;
        (void)hipGetDevice(&dev); (void)hipDeviceGetAttribute(&cus, hipDeviceAttributeMultiprocessorCount, dev);
        if (hipFuncSetAttribute((const void*)mk_fwd, hipFuncAttributeMaxDynamicSharedMemorySize, LDS_BYTES) != hipSuccess) { fprintf(stderr, "kernel_launch: hipFuncSetAttribute failed\n"); grid = -1; return; }
        if (hipOccupancyMaxActiveBlocksPerMultiprocessor(&per_cu, (const void*)mk_fwd, 512, LDS_BYTES) != hipSuccess || per_cu < 1) per_cu = 1;
        (void)hipGetLastError();
        grid = cus * 1;
        if (grid <= 0) grid = 256;
    }
    if (grid < 0) return;
    if (hipMemsetAsync((char*)d_ws + WS_CTL, 0, 65536, stream) != hipSuccess) { fprintf(stderr, "memset failed\n"); return; }
    Args a{};
    for (int i = 0; i < 35; ++i) a.in[i] = (const float*)d_in[i];
    a.out = (float*)d_out; a.ws = (unsigned char*)d_ws;
    void* args[] = {&a};
    hipError_t e = hipLaunchCooperativeKernel((const void*)mk_fwd, dim3(grid), dim3(512), args, LDS_BYTES, stream);
    if (e != hipSuccess) fprintf(stderr, "cooperative launch failed: %s (grid %d)\n", hipGetErrorString(e), grid);
}
```

```cpp
#include <hip/hip_runtime.h>
#include <hip/hip_cooperative_groups.h>
#include <cstdio>
#include <cstdint>
namespace cg = cooperative_groups;

constexpr int NB = 8, S = 4096, D = 1024, M = NB * S, MH = M / 2, DEPTH = 4, NMEM = 256;
constexpr int INW = 10752, OFF_ATT = 512, OFF_SSM = 5120, OFF_SGU = 5632, OFF_GATE = 6656;
constexpr int DFF = 4096;
constexpr float EPS = 1e-6f;

namespace pg8 {
#define PG8_LAS __attribute__((address_space(3)))
typedef unsigned short bf16_t;
typedef short bf16x8 __attribute__((ext_vector_type(8)));
typedef float f32x4 __attribute__((ext_vector_type(4)));
typedef unsigned u32x4 __attribute__((ext_vector_type(4)));
constexpr int BM = 256, BK = 64, HALF = 128, HTB = HALF * BK * 2  , STAGE_BYTES = 8 * HTB, NXCD = 8, WGM = 8;

__host__ __device__ __forceinline__ int lds_byte(int r, int c) { const int st = (r >> 4) * 2 + (c >> 5), rr = r & 15, cc = c & 31, ob = rr * 64 + cc * 2; return st * 1024 + (ob ^ (((ob >> 9) & 1) << 5)); }
__host__ __device__ __forceinline__ void stage_rc(int b, int& R, int& C) { const int st = b / 1024, sb = b % 1024, swz = sb ^ (((sb >> 9) & 1) << 5); R = (st >> 1) * 16 + swz / 64; C = (st & 1) * 32 + (swz % 64) / 2; }
__host__ __device__ __forceinline__ int perm32(int rho) { const int n = rho >> 4, i = rho & 15; return 8 * (i >> 2) + 4 * n + (i & 3); }

struct Unit { int pm, pn; };
struct Gemm { const bf16_t* A; const bf16_t* Bt; int M, N, K, lda; };

struct StaticOrder {
    int nM, nN, nwg, G, c;
    __host__ __device__ void init(int M, int N, int G_, int c_) { nM = M / BM; nN = N / BM; nwg = nM * nN; G = G_; c = c_; }
    __host__ __device__ bool next(int i, Unit& u) const {
        const long L = (long)i * G + c; if (L >= nwg) return false;
        int wgid = (int)L; { const int q = nwg / NXCD, r = nwg % NXCD, xcd = wgid % NXCD, off = wgid / NXCD; wgid = (xcd < r ? xcd * (q + 1) : r * (q + 1) + (xcd - r) * q) + off; }
        const int nig = WGM * nN, gid = wgid / nig, fm = gid * WGM, gsz = (nM - fm) < WGM ? (nM - fm) : WGM;
        u.pm = fm + ((wgid % nig) % gsz); u.pn = (wgid % nig) / gsz; return true;
    }
    __device__ __forceinline__ void a_ready(const Unit&) const {}
    __device__ __forceinline__ void done(const Unit&) const {}
};
__device__ __forceinline__ unsigned cvt_pk_bf16(float lo, float hi) { unsigned r; asm volatile("v_cvt_pk_bf16_f32 %0, %1, %2" : "=v"(r) : "v"(lo), "v"(hi)); return r; }
__device__ __forceinline__ float bflo(unsigned w) { return __builtin_bit_cast(float, w << 16); }
__device__ __forceinline__ float bfhi(unsigned w) { return __builtin_bit_cast(float, w & 0xffff0000u); }
__device__ __forceinline__ float sigm(float x) { return __builtin_amdgcn_rcpf(1.f + __expf(-x)); }
__device__ __forceinline__ float gelu_t(float x) { const float z = 1.5957691216057308f * (x + 0.044715f * x * x * x); return x * __builtin_amdgcn_rcpf(1.f + __expf(-z)); }

#define EPI_ARGS const f32x4 (&acc)[2][2][4][2], const Unit& u, int wr, int wc, int fr, int fq
#define EPI_FOR_ROWS _Pragma("unroll") for (int ai = 0; ai < 2; ++ai) _Pragma("unroll") for (int m = 0; m < 4; ++m)
#define EPI_FOR_BJ _Pragma("unroll") for (int bj = 0; bj < 2; ++bj)

struct EpiProj {
    static constexpr bool PERM = true, AFTER_DRAIN = false, CHAIN = false;
    bf16_t* O; const float* gb;
    __device__ __forceinline__ void operator()(EPI_ARGS) const {
        const int colt = u.pn * BM; const int mode = colt >= OFF_GATE ? 2 : (colt >= OFF_SGU ? 1 : 0);
        const int col0 = colt + wc * 32 + 8 * fq;
        f32x4 bv[2][2];
        EPI_FOR_BJ { _Pragma("unroll") for (int n = 0; n < 2; ++n) bv[bj][n] = (mode == 2) ? *(const f32x4*)(gb + (col0 - OFF_GATE) + bj * HALF + 4 * n) : (f32x4){0.f, 0.f, 0.f, 0.f}; }
        EPI_FOR_ROWS { const int row = u.pm * BM + ai * HALF + wr * 64 + m * 16 + fr; bf16_t* rowp = O + (size_t)row * INW + col0;
            EPI_FOR_BJ { f32x4 v0 = acc[ai][bj][m][0] + bv[bj][0], v1 = acc[ai][bj][m][1] + bv[bj][1];
                if (mode == 2) { _Pragma("unroll") for (int j = 0; j < 4; ++j) { v0[j] = sigm(v0[j]); v1[j] = sigm(v1[j]); } }
                else if (mode == 1) { _Pragma("unroll") for (int j = 0; j < 4; ++j) { v0[j] = gelu_t(v0[j]); v1[j] = gelu_t(v1[j]); } }
                u32x4 w; w.x = cvt_pk_bf16(v0[0], v0[1]); w.y = cvt_pk_bf16(v0[2], v0[3]); w.z = cvt_pk_bf16(v1[0], v1[1]); w.w = cvt_pk_bf16(v1[2], v1[3]);
                *(u32x4*)(rowp + bj * HALF) = w; } }
    }
};
template <int ACT  > struct EpiPlain {
    static constexpr bool PERM = true, AFTER_DRAIN = false, CHAIN = false;
    bf16_t* O; int ldc; float scale;
    __device__ __forceinline__ void operator()(EPI_ARGS) const {
        const int col0 = u.pn * BM + wc * 32 + 8 * fq;
        EPI_FOR_ROWS { const int row = u.pm * BM + ai * HALF + wr * 64 + m * 16 + fr; bf16_t* rowp = O + (size_t)row * ldc + col0;
            EPI_FOR_BJ { f32x4 v0 = acc[ai][bj][m][0], v1 = acc[ai][bj][m][1];
                if (ACT == 1) { _Pragma("unroll") for (int j = 0; j < 4; ++j) { const float a = fmaxf(v0[j], 0.f), b = fmaxf(v1[j], 0.f); v0[j] = a * a; v1[j] = b * b; } }
                v0 = v0 * scale; v1 = v1 * scale;
                u32x4 w; w.x = cvt_pk_bf16(v0[0], v0[1]); w.y = cvt_pk_bf16(v0[2], v0[3]); w.z = cvt_pk_bf16(v1[0], v1[1]); w.w = cvt_pk_bf16(v1[2], v1[3]);
                *(u32x4*)(rowp + bj * HALF) = w; } }
    }
};
struct EpiGlu {
    static constexpr bool PERM = true, AFTER_DRAIN = false, CHAIN = false;
    const bf16_t* G; bf16_t* O; const float* bias;
    __device__ __forceinline__ void operator()(EPI_ARGS) const {
        const int col0 = u.pn * BM + wc * 32 + 8 * fq;
        f32x4 bv[2][2];
        EPI_FOR_BJ { _Pragma("unroll") for (int n = 0; n < 2; ++n) bv[bj][n] = *(const f32x4*)(bias + col0 + bj * HALF + 4 * n); }
        EPI_FOR_ROWS { const int row = u.pm * BM + ai * HALF + wr * 64 + m * 16 + fr;
            EPI_FOR_BJ { const u32x4 gw = *(const u32x4*)(G + (size_t)row * INW + OFF_SSM + col0 + bj * HALF);
                f32x4 v0 = acc[ai][bj][m][0] + bv[bj][0], v1 = acc[ai][bj][m][1] + bv[bj][1];
                v0[0] = bflo(gw.x) * sigm(v0[0]); v0[1] = bfhi(gw.x) * sigm(v0[1]); v0[2] = bflo(gw.y) * sigm(v0[2]); v0[3] = bfhi(gw.y) * sigm(v0[3]);
                v1[0] = bflo(gw.z) * sigm(v1[0]); v1[1] = bfhi(gw.z) * sigm(v1[1]); v1[2] = bflo(gw.w) * sigm(v1[2]); v1[3] = bfhi(gw.w) * sigm(v1[3]);
                u32x4 w; w.x = cvt_pk_bf16(v0[0], v0[1]); w.y = cvt_pk_bf16(v0[2], v0[3]); w.z = cvt_pk_bf16(v1[0], v1[1]); w.w = cvt_pk_bf16(v1[2], v1[3]);
                *(u32x4*)(O + (size_t)row * 512 + col0 + bj * HALF) = w; } }
    }
};
struct EpiGateAcc {
    static constexpr bool PERM = true, AFTER_DRAIN = false, CHAIN = false;
    const bf16_t* P; float* TOT; bf16_t* O;
    __device__ __forceinline__ void operator()(EPI_ARGS) const {
        const int br = u.pn >> 2, pn = u.pn & 3, pm = u.pm & 63;
        const int col0 = pn * BM + wc * 32 + 8 * fq;
        EPI_FOR_ROWS { const int row = pm * BM + ai * HALF + wr * 64 + m * 16 + fr;
            EPI_FOR_BJ { const int col = col0 + bj * HALF;
                const u32x4 gw = *(const u32x4*)(P + (size_t)row * INW + OFF_GATE + br * 1024 + col);
                float* tp = TOT + (size_t)row * 1024 + col;
                f32x4 t0 = {0.f, 0.f, 0.f, 0.f}, t1 = {0.f, 0.f, 0.f, 0.f};
                if (br > 0) { t0 = *(const f32x4*)tp; t1 = *(const f32x4*)(tp + 4); }
                const f32x4 v0 = acc[ai][bj][m][0], v1 = acc[ai][bj][m][1];
                t0[0] += bflo(gw.x) * v0[0]; t0[1] += bfhi(gw.x) * v0[1]; t0[2] += bflo(gw.y) * v0[2]; t0[3] += bfhi(gw.y) * v0[3];
                t1[0] += bflo(gw.z) * v1[0]; t1[1] += bfhi(gw.z) * v1[1]; t1[2] += bflo(gw.w) * v1[2]; t1[3] += bfhi(gw.w) * v1[3];
                if (br < 3) { *(f32x4*)tp = t0; *(f32x4*)(tp + 4) = t1; }
                else { u32x4 w; w.x = cvt_pk_bf16(t0[0], t0[1]); w.y = cvt_pk_bf16(t0[2], t0[3]); w.z = cvt_pk_bf16(t1[0], t1[1]); w.w = cvt_pk_bf16(t1[2], t1[3]);
                    *(u32x4*)(O + (size_t)row * 1024 + col) = w; } } }
    }
};
struct EpiF32 {
    static constexpr bool PERM = false, AFTER_DRAIN = false, CHAIN = false;
    float* Y; int ldc;
    __device__ __forceinline__ void operator()(EPI_ARGS) const {
        const int col0 = u.pn * BM + wc * 32 + 4 * fq;
        EPI_FOR_ROWS { const int row = u.pm * BM + ai * HALF + wr * 64 + m * 16 + fr; float* rowp = Y + (size_t)row * ldc + col0;
            EPI_FOR_BJ { _Pragma("unroll") for (int n = 0; n < 2; ++n) *(f32x4*)(rowp + bj * HALF + n * 16) = acc[ai][bj][m][n]; } }
    }
};
struct EpiGateChain {
    static constexpr bool PERM = true, AFTER_DRAIN = false, CHAIN = true;
    const bf16_t* P; bf16_t* O;
    __device__ __forceinline__ void operator()(f32x4 (&acc)[2][2][4][2], const Unit& u, int wr, int wc, int fr, int fq) const {
        const int br = u.pn >> 2, pn = u.pn & 3, pm = u.pm & 63;
        const int col0 = pn * BM + wc * 32 + 8 * fq;
        EPI_FOR_ROWS { const int row = pm * BM + ai * HALF + wr * 64 + m * 16 + fr;
            EPI_FOR_BJ { const int col = col0 + bj * HALF;
                const bf16_t* gp = P + (size_t)row * INW + OFF_GATE + br * 1024 + col;
                const u32x4 gc = *(const u32x4*)gp;
                f32x4 v0 = acc[ai][bj][m][0], v1 = acc[ai][bj][m][1];
                v0[0] *= bflo(gc.x); v0[1] *= bfhi(gc.x); v0[2] *= bflo(gc.y); v0[3] *= bfhi(gc.y);
                v1[0] *= bflo(gc.z); v1[1] *= bfhi(gc.z); v1[2] *= bflo(gc.w); v1[3] *= bfhi(gc.w);
                if (br < 3) { const u32x4 gn = *(const u32x4*)(gp + 1024);
                    v0[0] *= __builtin_amdgcn_rcpf(fmaxf(bflo(gn.x), 1e-30f)); v0[1] *= __builtin_amdgcn_rcpf(fmaxf(bfhi(gn.x), 1e-30f)); v0[2] *= __builtin_amdgcn_rcpf(fmaxf(bflo(gn.y), 1e-30f)); v0[3] *= __builtin_amdgcn_rcpf(fmaxf(bfhi(gn.y), 1e-30f));
                    v1[0] *= __builtin_amdgcn_rcpf(fmaxf(bflo(gn.z), 1e-30f)); v1[1] *= __builtin_amdgcn_rcpf(fmaxf(bfhi(gn.z), 1e-30f)); v1[2] *= __builtin_amdgcn_rcpf(fmaxf(bflo(gn.w), 1e-30f)); v1[3] *= __builtin_amdgcn_rcpf(fmaxf(bfhi(gn.w), 1e-30f));
                    acc[ai][bj][m][0] = v0; acc[ai][bj][m][1] = v1; }
                else { u32x4 w; w.x = cvt_pk_bf16(v0[0], v0[1]); w.y = cvt_pk_bf16(v0[2], v0[3]); w.z = cvt_pk_bf16(v1[0], v1[1]); w.w = cvt_pk_bf16(v1[2], v1[3]);
                    *(u32x4*)(O + (size_t)row * 1024 + col) = w;
                    acc[ai][bj][m][0] = (f32x4){0.f, 0.f, 0.f, 0.f}; acc[ai][bj][m][1] = (f32x4){0.f, 0.f, 0.f, 0.f}; } } }
    }
};
struct BranchOrder {
    int G, c;
    __device__ bool next(int i, Unit& u) const { const int r = i >> 2, br = i & 3, T = r * G + c; if (T >= 256) return false; u.pm = br * 64 + (T >> 2); u.pn = br * 4 + (T & 3); return true; }
    __device__ __forceinline__ void a_ready(const Unit&) const {}
    __device__ __forceinline__ void done(const Unit&) const {}
};
template <class Epi, class Sched, bool ALIGN_EPI = false, bool SP2 = false>
__device__ __forceinline__ void gemm_phase(PG8_LAS unsigned char* lds, const Gemm g, const Sched& S, const Epi& E) {
    int tid_ = threadIdx.x; asm volatile("" : "+v"(tid_)); const int tid = tid_, wid = __builtin_amdgcn_readfirstlane(tid >> 6), lane = tid & 63, wr = wid >> 2, wc = wid & 3, fr = lane & 15, fq = lane >> 4;
    const int K = g.K, nt = K / BK;
    unsigned voffA[2], voffB[2];
#pragma unroll
    for (int i = 0; i < 2; ++i) { int R, C; stage_rc(tid * 16 + i * 8192, R, C); const int Rb = Epi::PERM ? ((R & ~31) + perm32(R & 31)) : R;
        voffA[i] = (unsigned)(R * g.lda + C) * 2u; voffB[i] = (unsigned)(Rb * K + C) * 2u; }
    const size_t kstep = (size_t)(BK * 2);
    const size_t hstepA = (size_t)HALF * g.lda * 2, hstepB = (size_t)HALF * K * 2;
    const size_t tstepA = 2 * hstepA, tstepB = 2 * hstepB;
    const unsigned ldsw = (unsigned)wid * 1024u;
    const int aoff = lds_byte(wr * 64 + fr, fq * 8), boff = lds_byte(wc * 32 + fr, fq * 8);
#define PG8_SA(b, h) (((b) * 2 + (h)) * HTB)
#define PG8_SB(b, h) ((4 + (b) * 2 + (h)) * HTB)
#define PG8_STAGE(bufoff, gbase, voff) do { _Pragma("unroll") for (int _i = 0; _i < 2; ++_i) \
        __builtin_amdgcn_global_load_lds((const unsigned*)((const char*)(gbase) + (voff)[_i]), (PG8_LAS unsigned*)(lds + (bufoff) + ldsw + _i * 8192), 16, 0, 0); } while (0)
#define PG8_LDA(dst, b, h) do { _Pragma("unroll") for (int m = 0; m < 4; ++m) _Pragma("unroll") for (int k = 0; k < 2; ++k) dst[m][k] = *(const PG8_LAS bf16x8*)(lds + PG8_SA(b, h) + aoff + m * 2048 + k * 1024); } while (0)
#define PG8_LDB(dst, b, h) do { _Pragma("unroll") for (int n = 0; n < 2; ++n) _Pragma("unroll") for (int k = 0; k < 2; ++k) dst[n][k] = *(const PG8_LAS bf16x8*)(lds + PG8_SB(b, h) + boff + n * 2048 + k * 1024); } while (0)
#define PG8_MMA(ai, bj, At, Bt) do { __builtin_amdgcn_s_setprio(1); _Pragma("unroll") for (int m = 0; m < 4; ++m) _Pragma("unroll") for (int n = 0; n < 2; ++n) _Pragma("unroll") for (int k = 0; k < 2; ++k) \
        acc[ai][bj][m][n] = __builtin_amdgcn_mfma_f32_16x16x32_bf16(Bt[n][k], At[m][k], acc[ai][bj][m][n], 0, 0, 0); __builtin_amdgcn_s_setprio(0); } while (0)
#define PG8_WAIT_V(n) asm volatile("s_waitcnt vmcnt(" #n ")" ::: "memory")
#define PG8_WAIT_L(n) asm volatile("s_waitcnt lgkmcnt(" #n ")" ::: "memory")
#define PG8_BAR __builtin_amdgcn_s_barrier()
#define PG8_SCHED __builtin_amdgcn_sched_barrier(0)
    Unit cur, nxt; int ui = 0;
    if (!S.next(0, cur)) return;
    f32x4 acc[2][2][4][2];
#pragma unroll
    for (int a = 0; a < 2; ++a)
#pragma unroll
        for (int b = 0; b < 2; ++b)
#pragma unroll
            for (int m = 0; m < 4; ++m)
#pragma unroll
                for (int n = 0; n < 2; ++n) acc[a][b][m][n] = (f32x4){0.f, 0.f, 0.f, 0.f};
    bf16x8 At[4][2], B0[2][2], B1[2][2];
    const char* cA = (const char*)g.A + (size_t)cur.pm * tstepA; const char* cB = (const char*)g.Bt + (size_t)cur.pn * tstepB;
    S.a_ready(cur);
    if constexpr (SP2) {
        PG8_STAGE(PG8_SB(0, 0), cB, voffB); PG8_STAGE(PG8_SB(0, 1), cB + hstepB, voffB); PG8_STAGE(PG8_SA(0, 0), cA, voffA); PG8_STAGE(PG8_SA(0, 1), cA + hstepA, voffA);
        if (wr == 1) PG8_BAR;
        PG8_WAIT_V(2); PG8_BAR;
        PG8_STAGE(PG8_SB(1, 0), cB + kstep, voffB); PG8_STAGE(PG8_SA(1, 0), cA + kstep, voffA); PG8_STAGE(PG8_SB(1, 1), cB + hstepB + kstep, voffB);
        PG8_WAIT_V(6); PG8_BAR;
    } else {
        PG8_STAGE(PG8_SB(0, 0), cB, voffB); PG8_STAGE(PG8_SA(0, 0), cA, voffA); PG8_STAGE(PG8_SB(0, 1), cB + hstepB, voffB); PG8_STAGE(PG8_SA(0, 1), cA + hstepA, voffA);
        if (wr == 1) PG8_BAR;
        PG8_WAIT_V(4); PG8_BAR;
        PG8_STAGE(PG8_SB(1, 0), cB + kstep, voffB); PG8_STAGE(PG8_SA(1, 0), cA + kstep, voffA); PG8_STAGE(PG8_SB(1, 1), cB + hstepB + kstep, voffB);
        PG8_WAIT_V(6); PG8_BAR;
    }
    for (;;) {
        const bool has_next = S.next(ui + 1, nxt);
        const char* nA = has_next ? (const char*)g.A + (size_t)nxt.pm * tstepA : cA; const char* nB = has_next ? (const char*)g.Bt + (size_t)nxt.pn * tstepB : cB;
        for (int t = 0; t < nt; t += 2) {
            const bool last = (t == nt - 2);
            const char* a1 = cA + (size_t)(t + 1) * kstep;
            const char* a2 = last ? nA : cA + (size_t)(t + 2) * kstep; const char* b2 = last ? nB : cB + (size_t)(t + 2) * kstep;
            const char* a3 = a2 + kstep; const char* b3 = b2 + kstep;
            if (last && has_next) S.a_ready(nxt);
            if constexpr (SP2) {
            PG8_LDB(B0, 0, 0); PG8_LDB(B1, 0, 1); PG8_SCHED; PG8_LDA(At, 0, 0); PG8_STAGE(PG8_SA(1, 1), a1 + hstepA, voffA);
            PG8_WAIT_V(8); PG8_WAIT_L(0); PG8_BAR; PG8_MMA(0, 0, At, B0); PG8_MMA(0, 1, At, B1); PG8_BAR; PG8_SCHED;
            PG8_LDA(At, 0, 1); PG8_STAGE(PG8_SB(0, 0), b2, voffB); PG8_STAGE(PG8_SB(0, 1), b2 + hstepB, voffB); PG8_STAGE(PG8_SA(0, 0), a2, voffA);
            PG8_WAIT_V(8); PG8_WAIT_L(0); PG8_BAR; PG8_MMA(1, 0, At, B0); PG8_MMA(1, 1, At, B1); PG8_BAR; PG8_SCHED;
            PG8_LDB(B0, 1, 0); PG8_LDB(B1, 1, 1); PG8_SCHED; PG8_LDA(At, 1, 0); PG8_STAGE(PG8_SA(0, 1), a2 + hstepA, voffA);
            PG8_WAIT_V(8); PG8_WAIT_L(0); PG8_BAR; PG8_MMA(0, 0, At, B0); PG8_MMA(0, 1, At, B1); PG8_BAR; PG8_SCHED;
            PG8_LDA(At, 1, 1); PG8_STAGE(PG8_SB(1, 0), b3, voffB); PG8_STAGE(PG8_SB(1, 1), b3 + hstepB, voffB); PG8_STAGE(PG8_SA(1, 0), a3, voffA);
            PG8_WAIT_V(8); PG8_WAIT_L(0); PG8_BAR; PG8_MMA(1, 0, At, B0); PG8_MMA(1, 1, At, B1); PG8_BAR; PG8_SCHED;
            } else {
            PG8_LDB(B0, 0, 0); PG8_SCHED; PG8_LDA(At, 0, 0); PG8_STAGE(PG8_SA(1, 1), a1 + hstepA, voffA);
            PG8_WAIT_L(8); PG8_BAR; PG8_WAIT_L(0); PG8_MMA(0, 0, At, B0); PG8_BAR; PG8_SCHED;
            PG8_LDB(B1, 0, 1); PG8_STAGE(PG8_SB(0, 0), b2, voffB);
            PG8_BAR; PG8_WAIT_L(0); PG8_MMA(0, 1, At, B1); PG8_BAR;
            PG8_LDA(At, 0, 1); PG8_STAGE(PG8_SA(0, 0), a2, voffA);
            PG8_BAR; PG8_WAIT_L(0); PG8_MMA(1, 0, At, B0); PG8_BAR; PG8_SCHED;
            PG8_STAGE(PG8_SB(0, 1), b2 + hstepB, voffB);
            PG8_WAIT_V(6); PG8_BAR; PG8_MMA(1, 1, At, B1); PG8_BAR;
            PG8_LDB(B0, 1, 0); PG8_SCHED; PG8_LDA(At, 1, 0); PG8_STAGE(PG8_SA(0, 1), a2 + hstepA, voffA);
            PG8_WAIT_L(8); PG8_BAR; PG8_WAIT_L(0); PG8_MMA(0, 0, At, B0); PG8_BAR; PG8_SCHED;
            PG8_LDB(B1, 1, 1); PG8_STAGE(PG8_SB(1, 0), b3, voffB);
            PG8_BAR; PG8_WAIT_L(0); PG8_MMA(0, 1, At, B1); PG8_BAR;
            PG8_LDA(At, 1, 1); PG8_STAGE(PG8_SA(1, 0), a3, voffA);
            PG8_BAR; PG8_WAIT_L(0); PG8_MMA(1, 0, At, B0); PG8_BAR; PG8_SCHED;
            PG8_STAGE(PG8_SB(1, 1), b3 + hstepB, voffB);
            PG8_WAIT_V(6); PG8_BAR; PG8_MMA(1, 1, At, B1); PG8_BAR;
            }
        }
        if constexpr (ALIGN_EPI) { if (wr == 0) PG8_BAR; }
        if constexpr (!Epi::AFTER_DRAIN) { E(acc, cur, wr, wc, fr, fq); S.done(cur); }
        if (!has_next) break;
        if constexpr (!Epi::CHAIN) {
#pragma unroll
        for (int a = 0; a < 2; ++a)
#pragma unroll
            for (int b = 0; b < 2; ++b)
#pragma unroll
                for (int m = 0; m < 4; ++m)
#pragma unroll
                    for (int n = 0; n < 2; ++n) acc[a][b][m][n] = (f32x4){0.f, 0.f, 0.f, 0.f};
        }
        cur = nxt; cA = nA; cB = nB; ++ui;
        if constexpr (ALIGN_EPI) { if (wr == 1) PG8_BAR; }
    }
    PG8_WAIT_V(0);
    if constexpr (!ALIGN_EPI) { if (wr == 0) PG8_BAR; }
    PG8_BAR;
    if constexpr (Epi::AFTER_DRAIN) { E.fused(acc, cur, wr, wc, fr, fq, lds, wid, lane); S.done(cur); }
#undef PG8_SA
#undef PG8_SB
#undef PG8_STAGE
#undef PG8_LDA
#undef PG8_LDB
#undef PG8_MMA
#undef PG8_WAIT_V
#undef PG8_WAIT_L
#undef PG8_BAR
#undef PG8_SCHED
}
}

constexpr size_t MiB = 1u << 20, KiB = 1u << 10;
constexpr size_t WS_CTL = 0, CTL_BYTES = 1 * MiB;
constexpr size_t WS_WIN = 1 * MiB, WS_WUP = 22 * MiB, WS_WOUT = 26 * MiB, WS_WCQ = 28 * MiB, WS_WCKV = 29 * MiB, WS_WCO = 31 * MiB, WS_WFF1 = 32 * MiB, WS_WFF2 = 40 * MiB, WS_WGLU = 48 * MiB;
constexpr size_t WS_POOLT = 48 * MiB + 512 * KiB, WS_WST = WS_POOLT + 256 * KiB, WS_AB = WS_WST + 256 * KiB, WS_BBT = WS_AB + 256 * KiB, WS_CM = WS_BBT + 256 * KiB;
constexpr size_t WS_MEMN = 50 * MiB, WS_KV = 54 * MiB, WS_LSE = 58 * MiB, WS_H = 60 * MiB, WS_MERGED = 124 * MiB, WS_TOT = 188 * MiB, WS_BR = 252 * MiB, WS_PROJ = 316 * MiB, WS_END = 652 * MiB;
constexpr size_t WS_Y = WS_PROJ, WS_Q = 444 * MiB, WS_O = 476 * MiB, WS_HID = WS_PROJ, WS_YFF = WS_MERGED;
static_assert(WS_CM + 256 * KiB <= WS_MEMN && WS_PROJ + (size_t)MH * INW * 2 <= WS_END && WS_HID + (size_t)M * DFF * 2 <= WS_END && WS_YFF + (size_t)M * D * 4 <= WS_BR, "ws map");
constexpr int LDS_BYTES = 147456;

#define LAS __attribute__((address_space(3)))
typedef unsigned short bf16;
typedef unsigned v4u __attribute__((ext_vector_type(4)));
typedef unsigned v2u __attribute__((ext_vector_type(2)));
typedef float f32x4 __attribute__((ext_vector_type(4)));
typedef short bf16x8 __attribute__((ext_vector_type(8)));
using pg8::bflo; using pg8::bfhi; using pg8::sigm; using pg8::gelu_t;
__device__ __forceinline__ unsigned f2bf(float f) { unsigned u = __builtin_bit_cast(unsigned, f); return (u + 0x7fffu + ((u >> 16) & 1u)) >> 16; }
__device__ __forceinline__ unsigned pk2(float lo, float hi) { return f2bf(lo) | (f2bf(hi) << 16); }
__device__ __forceinline__ float bf2f(bf16 b) { return __builtin_bit_cast(float, (unsigned)b << 16); }
__device__ __forceinline__ float wave_sum(float v) {
#pragma unroll
    for (int o = 1; o < 64; o <<= 1) v += __shfl_xor(v, o);
    return v;
}
#define LDS_WAIT() asm volatile("s_waitcnt lgkmcnt(0)" ::: "memory")

struct Args { const float* in[35]; float* out; unsigned char* ws; };
enum { I_X = 0, I_MEM, I_RELB, I_GMIXPRE, I_GMIXPOST, I_WIN, I_GATEB, I_POOLW, I_POOLS, I_ARE, I_AIM, I_LOGDT, I_BRE, I_BIM, I_CRE, I_CIM, I_DSKIP, I_WGLU, I_BGLU,
       I_LNG, I_LNB, I_WS, I_BS, I_WUP, I_WOUT, I_GXPRE, I_GXPOST, I_GMEM, I_WCQ, I_WCKV, I_WCO, I_GFFPRE, I_GFFPOST, I_WFF1, I_WFF2 };

__device__ __forceinline__ void tr_item(const float* W, int K, int N, bf16* WT, LAS float* scr, int item, int lane) {
    const int nblk = N / 32, kb = item / nblk, nb = item % nblk, k0 = 64 * kb, n0 = 32 * nb;
#pragma unroll 8
    for (int i = 0; i < 32; ++i) { const int kk = 2 * i + (lane >> 5); scr[kk * 33 + (lane & 31)] = W[(size_t)(k0 + kk) * N + n0 + (lane & 31)]; }
    LDS_WAIT();
    const int c = lane & 7;
#pragma unroll
    for (int j = 0; j < 4; ++j) { const int n = (lane >> 3) + 8 * j; const LAS float* s = scr + (8 * c) * 33 + n;
        v4u o; o.x = pk2(s[0 * 33], s[1 * 33]); o.y = pk2(s[2 * 33], s[3 * 33]); o.z = pk2(s[4 * 33], s[5 * 33]); o.w = pk2(s[6 * 33], s[7 * 33]);
        *(v4u*)(WT + (size_t)(n0 + n) * K + k0 + 8 * c) = o; }
    LDS_WAIT();
}
__device__ __forceinline__ void rms_row_bf16(const float* xrow, const float* g, bf16* orow, int lane) {
    const f32x4* xr = (const f32x4*)xrow + lane; const f32x4* gr = (const f32x4*)g + lane;
    f32x4 v[4]; float s = 0.f;
#pragma unroll
    for (int j = 0; j < 4; ++j) { v[j] = xr[64 * j]; s += (v[j].x * v[j].x + v[j].y * v[j].y) + (v[j].z * v[j].z + v[j].w * v[j].w); }
    const float r = rsqrtf(wave_sum(s) * (1.f / D) + EPS);
    v2u* o8 = (v2u*)orow + lane;
#pragma unroll
    for (int j = 0; j < 4; ++j) { const f32x4 gv = gr[64 * j]; v2u w; w.x = pk2(v[j].x * r * gv.x, v[j].y * r * gv.y); w.y = pk2(v[j].z * r * gv.z, v[j].w * r * gv.w); o8[64 * j] = w; }
}
__device__ __forceinline__ void rowpass(const void* Xi, bool xi_f32, const bf16* Y, const float* gpost, const float* gpre, void* Xo, bool xo_f32, bf16* Hh, int gw, int NGW, int lane) {
    for (int row = gw; row < M; row += NGW) {
        const v2u* yr = (const v2u*)(Y + (size_t)row * D) + lane;
        f32x4 y[4], x[4]; float s = 0.f;
        if (xi_f32) { const f32x4* xr = (const f32x4*)((const float*)Xi + (size_t)row * D) + lane;
#pragma unroll
            for (int j = 0; j < 4; ++j) x[j] = xr[64 * j]; }
        else { const v2u* xr = (const v2u*)((const bf16*)Xi + (size_t)row * D) + lane;
#pragma unroll
            for (int j = 0; j < 4; ++j) { const v2u xw = xr[64 * j]; x[j] = (f32x4){bflo(xw.x), bfhi(xw.x), bflo(xw.y), bfhi(xw.y)}; } }
#pragma unroll
        for (int j = 0; j < 4; ++j) { const v2u yw = yr[64 * j]; y[j] = (f32x4){bflo(yw.x), bfhi(yw.x), bflo(yw.y), bfhi(yw.y)}; s += (y[j].x * y[j].x + y[j].y * y[j].y) + (y[j].z * y[j].z + y[j].w * y[j].w); }
        const float r = rsqrtf(wave_sum(s) * (1.f / D) + EPS); float s2 = 0.f;
#pragma unroll
        for (int j = 0; j < 4; ++j) { const f32x4 gv = ((const f32x4*)gpost)[lane + 64 * j]; x[j] = x[j] + y[j] * r * gv;
            s2 += (x[j].x * x[j].x + x[j].y * x[j].y) + (x[j].z * x[j].z + x[j].w * x[j].w); }
        if (xo_f32) { f32x4* xo = (f32x4*)((float*)Xo + (size_t)row * D) + lane;
#pragma unroll
            for (int j = 0; j < 4; ++j) xo[64 * j] = x[j]; }
        else { v2u* xo = (v2u*)((bf16*)Xo + (size_t)row * D) + lane;
#pragma unroll
            for (int j = 0; j < 4; ++j) { v2u w; w.x = pk2(x[j].x, x[j].y); w.y = pk2(x[j].z, x[j].w); xo[64 * j] = w; } }
        if (gpre) { const float r2 = rsqrtf(wave_sum(s2) * (1.f / D) + EPS); v2u* o8 = (v2u*)(Hh + (size_t)row * D) + lane;
#pragma unroll
            for (int j = 0; j < 4; ++j) { const f32x4 gv = ((const f32x4*)gpre)[lane + 64 * j]; v2u w; w.x = pk2(x[j].x * r2 * gv.x, x[j].y * r2 * gv.y); w.y = pk2(x[j].z * r2 * gv.z, x[j].w * r2 * gv.w); o8[64 * j] = w; } }
    }
}
__device__ __forceinline__ int t5_bucket(int n) {
    if (n < 16) return n;
    return 16 + (n >= 22) + (n >= 30) + (n >= 40) + (n >= 54) + (n >= 73) + (n >= 99) + (n >= 134) + (n >= 182) + (n >= 246) + (n >= 332) + (n >= 450) + (n >= 609) + (n >= 825) + (n >= 1117) + (n >= 1513);
}
__device__ __forceinline__ double dexp_small(double x) {
    double t = 1.0, s = 1.0;
#pragma unroll
    for (int k = 1; k <= 16; ++k) { t *= x / (double)k; s += t; }
    return s;
}
__device__ __forceinline__ double dexp(double x) { double e = dexp_small(x * (1.0 / 32.0)); e *= e; e *= e; e *= e; e *= e; e *= e; return e; }
__device__ __forceinline__ void dsincos(double x, double& sn, double& cs) {
    const double TWO_PI = 6.283185307179586476925286766559;
    x -= TWO_PI * __builtin_rint(x * (1.0 / TWO_PI));
    const double r = x * 0.125, r2 = r * r;
    double st = r, ct = 1.0, s = r, c = 1.0;
#pragma unroll
    for (int k = 1; k <= 8; ++k) { ct *= -r2 / (double)((2 * k - 1) * (2 * k)); st *= -r2 / (double)((2 * k) * (2 * k + 1)); c += ct; s += st; }
#pragma unroll
    for (int k = 0; k < 3; ++k) { const double s2 = 2.0 * s * c, c2 = c * c - s * s; s = s2; c = c2; }
    sn = s; cs = c;
}
typedef short v4i16_t __attribute__((ext_vector_type(4)));
#define MFMA16(bfrag, afrag, c) __builtin_amdgcn_mfma_f32_16x16x32_bf16((bfrag), (afrag), (c), 0, 0, 0)
__device__ __forceinline__ void attn_naive(bf16* P, float* LSE, const float* relb, int gw, int NGW, int lane) {
    for (int uidx = gw; uidx < MH * 24; uidx += NGW) {
        const int r = uidx / 24, gh = uidx % 24, g = gh >> 3, h = gh & 7;
        const int t = r & (S - 1), dil = g == 0 ? 1 : (g == 1 ? 4 : 16);
        const int nd = min(t / dil, 128);
        bf16* prow = P + (size_t)r * INW + OFF_ATT + g * 512 + h * 64 + lane;
        const float q = bf2f(*prow);
        float mx = -1e30f, ss = 0.f, o = 0.f;
        for (int dist = 0; dist <= nd; ++dist) {
            const bf16* kp = prow - (size_t)dist * dil * INW;
            const float kv = bf2f(kp[1536]), vv = bf2f(kp[3072]);
            const float sc = wave_sum(q * kv) * 0.125f + relb[t5_bucket(dist * dil) * 24 + gh];
            const float mn = fmaxf(mx, sc), corr = __expf(mx - mn), p = __expf(sc - mn);
            ss = ss * corr + p; o = o * corr + p * vv; mx = mn;
        }
        *prow = (bf16)f2bf(o / ss);
        if (lane == 0) LSE[((size_t)g * MH + r) * 8 + h] = mx + __logf(ss);
    }
}
__device__ __forceinline__ void attn_merge(const bf16* __restrict__ P, const float* __restrict__ LSE, bf16* __restrict__ BR1, int gt, int NGT) {
#pragma unroll 4
    for (int e = gt; e < MH * 64; e += NGT) {
        const int r = e >> 6, ch = e & 63, h = ch >> 3;
        const float l0 = LSE[((size_t)0 * MH + r) * 8 + h], l1 = LSE[((size_t)1 * MH + r) * 8 + h], l2 = LSE[((size_t)2 * MH + r) * 8 + h];
        const float mx = fmaxf(l0, fmaxf(l1, l2));
        float w0 = __expf(l0 - mx), w1 = __expf(l1 - mx), w2 = __expf(l2 - mx); const float inv = 1.f / (w0 + w1 + w2); w0 *= inv; w1 *= inv; w2 *= inv;
        const bf16* base = P + (size_t)r * INW + OFF_ATT + ch * 8;
        const v4u a0 = *(const v4u*)base, a1 = *(const v4u*)(base + 512), a2 = *(const v4u*)(base + 1024);
        v4u o;
        o.x = pk2(w0 * bflo(a0.x) + w1 * bflo(a1.x) + w2 * bflo(a2.x), w0 * bfhi(a0.x) + w1 * bfhi(a1.x) + w2 * bfhi(a2.x));
        o.y = pk2(w0 * bflo(a0.y) + w1 * bflo(a1.y) + w2 * bflo(a2.y), w0 * bfhi(a0.y) + w1 * bfhi(a1.y) + w2 * bfhi(a2.y));
        o.z = pk2(w0 * bflo(a0.z) + w1 * bflo(a1.z) + w2 * bflo(a2.z), w0 * bfhi(a0.z) + w1 * bfhi(a1.z) + w2 * bfhi(a2.z));
        o.w = pk2(w0 * bflo(a0.w) + w1 * bflo(a1.w) + w2 * bflo(a2.w), w0 * bfhi(a0.w) + w1 * bfhi(a1.w) + w2 * bfhi(a2.w));
        *(v4u*)(BR1 + (size_t)r * 512 + ch * 8) = o;
    }
}
__device__ __forceinline__ void ssm_naive(bf16* P, const float* AB, const bf16* BBT, const bf16* CM, const float* dskip, int gw, int NGW, int lane) {
    for (int uidx = gw; uidx < 4 * 32; uidx += NGW) {
        const int bl = uidx >> 5, g = uidx & 31;
        float bbr[16], bbi[16], cr[16], ci[16];
#pragma unroll
        for (int c = 0; c < 16; ++c) { bbr[c] = bf2f(BBT[(g * 128 + lane) * 16 + c]); bbi[c] = bf2f(BBT[(g * 128 + 64 + lane) * 16 + c]);
            cr[c] = bf2f(CM[(g * 16 + c) * 128 + lane]); ci[c] = bf2f(CM[(g * 16 + c) * 128 + 64 + lane]); }
        const float ar = AB[(g * 64 + lane) * 2], ai = AB[(g * 64 + lane) * 2 + 1];
        const float dsk = dskip[g * 16 + (lane & 15)];
        float hr = 0.f, hi = 0.f;
        for (int t = 0; t < S; ++t) {
            bf16* up = P + (size_t)(bl * S + t) * INW + OFF_SSM + g * 16;
            const v4u u0 = *(const v4u*)up, u1 = *(const v4u*)(up + 8);
            const float ul = bf2f(up[lane & 15]);
            float u[16] = {bflo(u0.x), bfhi(u0.x), bflo(u0.y), bfhi(u0.y), bflo(u0.z), bfhi(u0.z), bflo(u0.w), bfhi(u0.w),
                           bflo(u1.x), bfhi(u1.x), bflo(u1.y), bfhi(u1.y), bflo(u1.z), bfhi(u1.z), bflo(u1.w), bfhi(u1.w)};
            float bur = 0.f, bui = 0.f;
#pragma unroll
            for (int c = 0; c < 16; ++c) { bur += bbr[c] * u[c]; bui += bbi[c] * u[c]; }
            const float nhr = ar * hr - ai * hi + bur, nhi = ar * hi + ai * hr + bui; hr = nhr; hi = nhi;
            float ym = 0.f;
#pragma unroll
            for (int c = 0; c < 16; ++c) { const float yc = wave_sum(cr[c] * hr + ci[c] * hi); if (lane == c) ym = yc; }
            if (lane < 16) up[lane] = (bf16)f2bf(gelu_t(ym + ul * dsk));
        }
    }
}
__device__ __forceinline__ void sgu_unit(LAS unsigned char* lds, const bf16* P, const bf16* WST, const float* lng, const float* lnb, const float* bs, bf16* BR3, int unit, int tid, int lane, int wave) {
    const int g = unit & 3, n = (unit >> 2) & 31, bl = unit >> 7;
    const int r0 = bl * S + n * 128;
    LAS float* stats = (LAS float*)lds; LAS bf16* VnT = (LAS bf16*)(lds + 1024);
    const int fr = lane & 15, fq = lane >> 4, tq = fr >> 2, tp = fr & 3, t = 16 * wave + fr, nks = (wave >> 1) + 1;
    v4u xs[16], vn[4]; bf16x8 wf[4]; v2u uw[8];
#pragma unroll
    for (int rr = 0; rr < 16; ++rr) xs[rr] = *(const v4u*)(P + (size_t)(r0 + 16 * wave + rr) * INW + OFF_SGU + 512 + lane * 8);
#pragma unroll
    for (int it = 0; it < 4; ++it) { const int idx = tid + 512 * it, s = idx >> 4, ch = (idx & 15) * 8; vn[it] = *(const v4u*)(P + (size_t)(r0 + s) * INW + OFF_SGU + 512 + g * 128 + ch); }
#pragma unroll
    for (int ks = 0; ks < 4; ++ks) wf[ks] = *(const bf16x8*)(WST + ((size_t)g * 128 + t) * 128 + 32 * ks + 8 * fq);
#pragma unroll
    for (int nt = 0; nt < 8; ++nt) uw[nt] = *(const v2u*)(P + (size_t)(r0 + t) * INW + OFF_SGU + g * 128 + 16 * nt + 4 * fq);
    const float bst = bs[g * 128 + t];
#pragma unroll
    for (int rr = 0; rr < 16; ++rr) { const int row = 16 * wave + rr; const v4u x = xs[rr];
        float v[8] = {bflo(x.x), bfhi(x.x), bflo(x.y), bfhi(x.y), bflo(x.z), bfhi(x.z), bflo(x.w), bfhi(x.w)};
        float s = 0.f;
#pragma unroll
        for (int j = 0; j < 8; ++j) s += v[j];
        const float mean = wave_sum(s) * (1.f / 512.f); float q = 0.f;
#pragma unroll
        for (int j = 0; j < 8; ++j) { const float d = v[j] - mean; q += d * d; }
        const float rstd = rsqrtf(wave_sum(q) * (1.f / 512.f) + EPS);
        if (lane == 0) { stats[row * 2] = mean; stats[row * 2 + 1] = rstd; } }
    __syncthreads();
#pragma unroll
    for (int it = 0; it < 4; ++it) { const int idx = tid + 512 * it, s = idx >> 4, ch = (idx & 15) * 8;
        const v4u x = vn[it];
        const float mean = stats[s * 2], rstd = stats[s * 2 + 1];
        float v[8] = {bflo(x.x), bfhi(x.x), bflo(x.y), bfhi(x.y), bflo(x.z), bfhi(x.z), bflo(x.w), bfhi(x.w)};
        const f32x4 g0 = *(const f32x4*)(lng + g * 128 + ch), g1 = *(const f32x4*)(lng + g * 128 + ch + 4), b0 = *(const f32x4*)(lnb + g * 128 + ch), b1 = *(const f32x4*)(lnb + g * 128 + ch + 4);
#pragma unroll
        for (int j = 0; j < 4; ++j) { v[j] = (v[j] - mean) * rstd * g0[j] + b0[j]; v[4 + j] = (v[4 + j] - mean) * rstd * g1[j] + b1[j]; }
        v4u w; w.x = pk2(v[0], v[1]); w.y = pk2(v[2], v[3]); w.z = pk2(v[4], v[5]); w.w = pk2(v[6], v[7]);
        *(LAS v4u*)(VnT + s * 136 + ch) = w;
    }
    __syncthreads();
    { f32x4 acc[8];
#pragma unroll
      for (int nt = 0; nt < 8; ++nt) acc[nt] = (f32x4){0.f, 0.f, 0.f, 0.f};
#pragma unroll
      for (int ks = 0; ks < 4; ++ks) if (ks < nks) {
#pragma unroll
          for (int nt = 0; nt < 8; ++nt) {
              const v4i16_t lo = __builtin_amdgcn_ds_read_tr16_b64_v4i16((LAS v4i16_t*)(VnT + (32 * ks + 8 * fq + tq) * 136 + 16 * nt + 4 * tp));
              const v4i16_t hi = __builtin_amdgcn_ds_read_tr16_b64_v4i16((LAS v4i16_t*)(VnT + (32 * ks + 8 * fq + 4 + tq) * 136 + 16 * nt + 4 * tp));
              const bf16x8 vf = {lo[0], lo[1], lo[2], lo[3], hi[0], hi[1], hi[2], hi[3]};
              acc[nt] = MFMA16(vf, wf[ks], acc[nt]); } }
#pragma unroll
      for (int nt = 0; nt < 8; ++nt) { const int c = 16 * nt + 4 * fq;
          v2u o; o.x = pk2(bflo(uw[nt].x) * (acc[nt][0] + bst), bfhi(uw[nt].x) * (acc[nt][1] + bst)); o.y = pk2(bflo(uw[nt].y) * (acc[nt][2] + bst), bfhi(uw[nt].y) * (acc[nt][3] + bst));
          *(v2u*)(BR3 + (size_t)(r0 + t) * 512 + g * 128 + c) = o; } }
    __syncthreads();
}
__device__ __forceinline__ void pool_unit(LAS unsigned char* lds, const bf16* P, const bf16* poolt, const float* pscale, bf16* BR0, int unit, int tid, int lane, int wave) {
    const int gi = unit & 3, tt = (unit >> 2) & 31, bl = unit >> 7;
    const int t0 = tt * 128, r0 = bl * S + t0, w = 2 << gi;
    LAS bf16* raw = (LAS bf16*)lds; LAS bf16* Pt = (LAS bf16*)(lds + 36864);
    const int fr = lane & 15, fq = lane >> 4;
    v4u rx[5];
#pragma unroll
    for (int it = 0; it < 5; ++it) { const int idx = tid + 512 * it, j = idx >> 4, ch = (idx & 15) * 8;
        rx[it] = (v4u){0u, 0u, 0u, 0u};
        if (idx < 144 * 16 && t0 - 16 + j >= 0) rx[it] = *(const v4u*)(P + (size_t)(r0 - 16 + j) * INW + gi * 128 + ch); }
    bf16x8 wfa[2][8];
#pragma unroll
    for (int ks = 0; ks < 2; ++ks)
#pragma unroll
        for (int nt = 0; nt < 8; ++nt) wfa[ks][nt] = *(const bf16x8*)(poolt + ((size_t)gi * 128 + 16 * nt + fr) * 128 + 32 * ks + 8 * fq);
#pragma unroll
    for (int it = 0; it < 5; ++it) { const int idx = tid + 512 * it, j = idx >> 4, ch = (idx & 15) * 8; if (idx < 144 * 16) *(LAS v4u*)(raw + j * 128 + ch) = rx[it]; }
    __syncthreads();
    { const int c = tid & 127, tq = tid >> 7, tb0 = tq * 32; const float rc = 1.f / (float)w;
      float s = 0.f;
      for (int j = 0; j < w; ++j) s += bf2f(raw[(16 + tb0 - j) * 128 + c]);
      for (int i = 0; i < 32; ++i) { const int t = tb0 + i; const int cnt = min(t0 + t + 1, w);
          const float cur = bf2f(raw[(16 + t) * 128 + c]);
          const float mean = (cnt == w) ? s * rc : s / (float)cnt;
          Pt[t * 136 + c] = (bf16)f2bf(mean - cur);
          s += bf2f(raw[(17 + t) * 128 + c]) - bf2f(raw[(17 + t - w) * 128 + c]); } }
    __syncthreads();
    { const int t = 16 * wave + fr;
      f32x4 acc[8];
#pragma unroll
      for (int nt = 0; nt < 8; ++nt) acc[nt] = (f32x4){0.f, 0.f, 0.f, 0.f};
#pragma unroll
      for (int ks = 0; ks < 4; ++ks) { const bf16x8 pf = *(const LAS bf16x8*)(Pt + t * 136 + 32 * ks + 8 * fq);
#pragma unroll
          for (int nt = 0; nt < 8; ++nt) { const bf16x8 wf = ks < 2 ? wfa[ks & 1][nt] : *(const bf16x8*)(poolt + ((size_t)gi * 128 + 16 * nt + fr) * 128 + 32 * ks + 8 * fq); acc[nt] = MFMA16(wf, pf, acc[nt]); } }
#pragma unroll
      for (int nt = 0; nt < 8; ++nt) { const int d = 16 * nt + 4 * fq; const f32x4 sc = *(const f32x4*)(pscale + gi * 128 + d);
          v2u o; o.x = pk2(acc[nt][0] * sc[0], acc[nt][1] * sc[1]); o.y = pk2(acc[nt][2] * sc[2], acc[nt][3] * sc[3]);
          *(v2u*)(BR0 + (size_t)(r0 + t) * 512 + gi * 128 + d) = o; } }
    __syncthreads();
}
__device__ __forceinline__ void xattn_naive(const bf16* Q, const bf16* KV, bf16* O, int gw, int NGW, int lane) {
    for (int uidx = gw; uidx < M * 4; uidx += NGW) {
        const int T = uidx >> 2, h = uidx & 3, b = T / S;
        const unsigned qw = *(const unsigned*)(Q + (size_t)T * 512 + h * 128 + 2 * lane);
        const float q0 = bflo(qw), q1 = bfhi(qw);
        float mx = -1e30f, ss = 0.f, o0 = 0.f, o1 = 0.f;
        for (int j = 0; j < NMEM; ++j) {
            const bf16* kr = KV + (size_t)(b * NMEM + j) * 1024 + h * 128 + 2 * lane;
            const unsigned kw = *(const unsigned*)kr, vw = *(const unsigned*)(kr + 512);
            const float sc = wave_sum(q0 * bflo(kw) + q1 * bfhi(kw));
            const float mn = fmaxf(mx, sc), corr = __expf(mx - mn), p = __expf(sc - mn);
            ss = ss * corr + p; o0 = o0 * corr + p * bflo(vw); o1 = o1 * corr + p * bfhi(vw); mx = mn;
        }
        const float inv = 1.f / ss;
        *(unsigned*)(O + (size_t)T * 512 + h * 128 + 2 * lane) = pk2(o0 * inv, o1 * inv);
    }
}
__device__ __forceinline__ void ssm_unit(LAS unsigned char* lds, bf16* P, const float* ABp, const bf16* BBTp, const bf16* CMp, const float* dskip, int unit, int tid, int lane, int wave) {
    const int bl = unit >> 5, g = unit & 31, fr = lane & 15, fq = lane >> 4;
    LAS float* bu = (LAS float*)(lds + wave * 16896);
    LAS bf16* hb = (LAS bf16*)(lds + wave * 16896);
    LAS float* ends = (LAS float*)(lds + 135168);
    const bf16x8 z8 = {0, 0, 0, 0, 0, 0, 0, 0};
    bf16x8 bbf[8], cmf[4];
#pragma unroll
    for (int nt = 0; nt < 8; ++nt) bbf[nt] = fq < 2 ? *(const bf16x8*)(BBTp + (size_t)(g * 128 + 16 * nt + fr) * 16 + 8 * fq) : z8;
#pragma unroll
    for (int ks = 0; ks < 4; ++ks) cmf[ks] = *(const bf16x8*)(CMp + (size_t)(g * 16 + fr) * 128 + 32 * ks + 8 * fq);
    const float ar = ABp[(g * 64 + lane) * 2], ai = ABp[(g * 64 + lane) * 2 + 1];
    float pr = ar, pi = ai;
#pragma unroll
    for (int i = 0; i < 5; ++i) { const float nr = pr * pr - pi * pi, ni = 2.f * pr * pi; pr = nr; pi = ni; }
    const f32x4 dsk = *(const f32x4*)(dskip + g * 16 + 4 * fq);
    float cr = 0.f, ci = 0.f;
    bf16x8 uf[2]; v2u uep[2], uepn[2];
#pragma unroll
    for (int mt = 0; mt < 2; ++mt) { const bf16* up = P + (size_t)(bl * S + wave * 32 + 16 * mt + fr) * INW + OFF_SSM + g * 16;
        uf[mt] = fq < 2 ? *(const bf16x8*)(up + 8 * fq) : z8; uep[mt] = *(const v2u*)(up + 4 * fq); }
    for (int ms = 0; ms < 16; ++ms) {
        const int rbase = bl * S + ms * 256 + wave * 32;
#pragma unroll
        for (int mt = 0; mt < 2; ++mt)
#pragma unroll
            for (int nt = 0; nt < 8; ++nt) { f32x4 acc = {0.f, 0.f, 0.f, 0.f}; acc = MFMA16(bbf[nt], uf[mt], acc);
                *(LAS f32x4*)(bu + (16 * mt + fr) * 132 + 16 * nt + 4 * fq) = acc; }
        { const int rn = bl * S + min(ms + 1, 15) * 256 + wave * 32;
#pragma unroll
          for (int mt = 0; mt < 2; ++mt) { const bf16* up = P + (size_t)(rn + 16 * mt + fr) * INW + OFF_SSM + g * 16;
              uf[mt] = fq < 2 ? *(const bf16x8*)(up + 8 * fq) : z8; uepn[mt] = *(const v2u*)(up + 4 * fq); } }
        LDS_WAIT();
        float hr = 0.f, hi = 0.f;
#pragma unroll 8
        for (int t = 0; t < 32; ++t) { const float br = bu[t * 132 + lane], bi = bu[t * 132 + 64 + lane];
            const float nhr = ar * hr - ai * hi + br, nhi = ar * hi + ai * hr + bi; hr = nhr; hi = nhi; }
        ends[wave * 128 + lane] = hr; ends[wave * 128 + 64 + lane] = hi;
        __syncthreads();
        float sr = cr, si = ci, myr = cr, myi = ci;
#pragma unroll
        for (int w = 0; w < 8; ++w) { if (w == wave) { myr = sr; myi = si; }
            const float er = ends[w * 128 + lane], ei = ends[w * 128 + 64 + lane];
            const float nsr = pr * sr - pi * si + er, nsi = pr * si + pi * sr + ei; sr = nsr; si = nsi; }
        cr = sr; ci = si;
        hr = myr; hi = myi;
#pragma unroll 8
        for (int t = 0; t < 32; ++t) { const float br = bu[t * 132 + lane], bi = bu[t * 132 + 64 + lane];
            const float nhr = ar * hr - ai * hi + br, nhi = ar * hi + ai * hr + bi; hr = nhr; hi = nhi;
            asm volatile("" ::: "memory");
            hb[t * 136 + lane] = (bf16)f2bf(hr); hb[t * 136 + 64 + lane] = (bf16)f2bf(hi);
            asm volatile("" ::: "memory"); }
        LDS_WAIT();
#pragma unroll
        for (int mt = 0; mt < 2; ++mt) { f32x4 acc = {0.f, 0.f, 0.f, 0.f};
#pragma unroll
            for (int ks = 0; ks < 4; ++ks) { const bf16x8 hf_ = *(const LAS bf16x8*)(hb + (16 * mt + fr) * 136 + 32 * ks + 8 * fq); acc = MFMA16(cmf[ks], hf_, acc); }
            const float y0 = gelu_t(acc[0] + bflo(uep[mt].x) * dsk[0]), y1 = gelu_t(acc[1] + bfhi(uep[mt].x) * dsk[1]);
            const float y2 = gelu_t(acc[2] + bflo(uep[mt].y) * dsk[2]), y3 = gelu_t(acc[3] + bfhi(uep[mt].y) * dsk[3]);
            v2u o; o.x = pk2(y0, y1); o.y = pk2(y2, y3);
            *(v2u*)(P + (size_t)(rbase + 16 * mt + fr) * INW + OFF_SSM + g * 16 + 4 * fq) = o; }
        uep[0] = uepn[0]; uep[1] = uepn[1];
        __syncthreads();
    }
}
template <int HD> struct AttnRegs { v4u kx[256 * (HD / 8) / 512], vx[256 * (HD / 8) / 512]; bf16x8 qf[HD / 32]; };
template <int HD>
__device__ __forceinline__ void attn_issue(AttnRegs<HD>& R, const bf16* Qp, size_t qstride, const bf16* Kp, const bf16* Vp, size_t kstride, int kfirst, int tid, int lane, int wave) {
    constexpr int CPR = HD / 8, NIT = 256 * CPR / 512, KST = HD / 32;
#pragma unroll
    for (int it = 0; it < NIT; ++it) { const int idx = tid + 512 * it, kk = idx / CPR, cc = idx % CPR;
        R.kx[it] = (v4u){0u, 0u, 0u, 0u}; R.vx[it] = (v4u){0u, 0u, 0u, 0u};
        if (kk >= kfirst) { R.kx[it] = *(const v4u*)(Kp + (ptrdiff_t)kk * (ptrdiff_t)kstride + cc * 8); R.vx[it] = *(const v4u*)(Vp + (ptrdiff_t)kk * (ptrdiff_t)kstride + cc * 8); } }
    const int qi = 16 * wave + (lane & 15), fq = lane >> 4;
#pragma unroll
    for (int ks = 0; ks < KST; ++ks) R.qf[ks] = *(const bf16x8*)(Qp + (size_t)qi * qstride + 32 * ks + 8 * fq);
}
template <int HD, bool DIL>
__device__ __forceinline__ void attn_stage(LAS unsigned char* lds, const AttnRegs<HD>& R, const float* relb, int dil, int gh, int tid) {
    constexpr int PITCH = HD + 8, CPR = HD / 8, NIT = 256 * CPR / 512;
    LAS bf16* Ks = (LAS bf16*)lds; LAS bf16* Vs = (LAS bf16*)(lds + 256 * PITCH * 2); LAS float* tb = (LAS float*)(lds + 2 * 256 * PITCH * 2);
#pragma unroll
    for (int it = 0; it < NIT; ++it) { const int idx = tid + 512 * it, kk = idx / CPR, cc = idx % CPR;
        *(LAS v4u*)(Ks + kk * PITCH + cc * 8) = R.kx[it]; *(LAS v4u*)(Vs + kk * PITCH + cc * 8) = R.vx[it]; }
    if (DIL) { if (tid < 256) { const int dist = tid - 64; tb[tid] = (dist >= 0 && dist <= 128) ? relb[t5_bucket(dist * dil) * 24 + gh] : 0.f; } }
}
template <int HD, bool DIL>
__device__ __forceinline__ void attn_compute(LAS unsigned char* lds, const bf16x8 (&qf)[HD / 32], int kfirst, bf16* Op, size_t ostride, float* lsep, int dil, int tid, int lane, int wave) {
    constexpr int PITCH = HD + 8, KST = HD / 32, NDT = HD / 16, NT = DIL ? 10 : 16, NK2 = NT / 2;
    const int ntb = DIL ? (wave & ~1) : 0;
    LAS bf16* Ks = (LAS bf16*)lds; LAS bf16* Vs = (LAS bf16*)(lds + 256 * PITCH * 2); LAS float* tb = (LAS float*)(lds + 2 * 256 * PITCH * 2);
    const int fr = lane & 15, fq = lane >> 4;
    const int qi = 16 * wave + fr;
    f32x4 sacc[NT];
#pragma unroll
    for (int nt = 0; nt < NT; ++nt) { f32x4 acc = {0.f, 0.f, 0.f, 0.f};
#pragma unroll
        for (int ks = 0; ks < KST; ++ks) { const bf16x8 kf = *(const LAS bf16x8*)(Ks + (16 * (ntb + nt) + fr) * PITCH + 32 * ks + 8 * fq); acc = MFMA16(kf, qf[ks], acc); }
        sacc[nt] = acc; }
    const LAS float* tbl = tb + (33 + qi - 16 * ntb - 4 * fq);
    float mx = -1e30f;
#pragma unroll
    for (int nt = 0; nt < NT; ++nt)
#pragma unroll
        for (int j = 0; j < 4; ++j) { float s = sacc[nt][j];
            if (DIL) { const int kk = 16 * (ntb + nt) + 4 * fq + j, dist = 128 + qi - kk; const bool ok = (dist >= 0) && (dist <= 128) && (kk >= kfirst);
                const float bv = tbl[159 - (16 * nt + j)];
                s = ok ? fmaf(s, 0.125f, bv) : -1e30f; }
            sacc[nt][j] = s; mx = fmaxf(mx, s); }
    mx = fmaxf(mx, __shfl_xor(mx, 16)); mx = fmaxf(mx, __shfl_xor(mx, 32));
    float sum = 0.f;
    bf16x8 pf[NK2];
#pragma unroll
    for (int k2 = 0; k2 < NK2; ++k2) { float p[8];
#pragma unroll
        for (int j = 0; j < 4; ++j) { p[j] = __expf(sacc[2 * k2][j] - mx); p[4 + j] = __expf(sacc[2 * k2 + 1][j] - mx); }
#pragma unroll
        for (int j = 0; j < 8; ++j) sum += p[j];
        v4u w; w.x = pk2(p[0], p[1]); w.y = pk2(p[2], p[3]); w.z = pk2(p[4], p[5]); w.w = pk2(p[6], p[7]);
        pf[k2] = __builtin_bit_cast(bf16x8, w); }
    sum += __shfl_xor(sum, 16); sum += __shfl_xor(sum, 32);
    const float inv = 1.f / sum;
    const int tq = fr >> 2, tp = fr & 3;
#pragma unroll
    for (int dt = 0; dt < NDT; ++dt) { f32x4 oacc = {0.f, 0.f, 0.f, 0.f};
#pragma unroll
        for (int k2 = 0; k2 < NK2; ++k2) {
            const v4i16_t lo = __builtin_amdgcn_ds_read_tr16_b64_v4i16((LAS v4i16_t*)(Vs + (16 * ntb + 32 * k2 + 4 * fq + tq) * PITCH + 16 * dt + 4 * tp));
            const v4i16_t hi = __builtin_amdgcn_ds_read_tr16_b64_v4i16((LAS v4i16_t*)(Vs + (16 * ntb + 32 * k2 + 16 + 4 * fq + tq) * PITCH + 16 * dt + 4 * tp));
            const bf16x8 vf = {lo[0], lo[1], lo[2], lo[3], hi[0], hi[1], hi[2], hi[3]};
            oacc = MFMA16(vf, pf[k2], oacc); }
        v2u o; o.x = pk2(oacc[0] * inv, oacc[1] * inv); o.y = pk2(oacc[2] * inv, oacc[3] * inv);
        *(v2u*)(Op + (size_t)qi * ostride + 16 * dt + 4 * fq) = o; }
    if (DIL) { if (fq == 0) lsep[(size_t)qi * 8 * dil] = mx + __logf(sum); }
    __syncthreads();
}
struct DilU { bf16* Qp; const bf16* Kp; size_t stride; float* lsep; int kfirst, dil, gh; };
__device__ __forceinline__ DilU dil_decode(int v, bf16* PROJp, float* LSEp) {
    const int h = v & 7, j32 = (v >> 3) & 31, bg = v >> 8, g = bg % 3, bl = bg / 3, dil = g == 0 ? 1 : (g == 1 ? 4 : 16), res = j32 % dil, n = j32 / dil;
    const int rq0 = bl * S + 128 * n * dil + res;
    DilU d; d.Qp = PROJp + (size_t)rq0 * INW + OFF_ATT + g * 512 + h * 64; d.Kp = d.Qp + 1536 - (ptrdiff_t)128 * dil * INW; d.stride = (size_t)dil * INW;
    d.lsep = LSEp + ((size_t)g * MH + rq0) * 8 + h; d.kfirst = n == 0 ? 128 : 0; d.dil = dil; d.gh = g * 8 + h; return d;
}
__device__ __forceinline__ const float* kin(int k) { int kk = k; asm volatile("" : "+s"(kk)); return ((const float* const __attribute__((address_space(4)))*)__builtin_amdgcn_kernarg_segment_ptr())[kk]; }
typedef __attribute__((address_space(1))) unsigned gu32;
#define XB_TMO      128
#define XB_XCNT(j)  (256  + 64 * (j))
#define XB_XSUB(j)  (1280 + 64 * (j))
#define XB_XGEN(j)  (2304 + 64 * (j))
#define XB_TOP      3328
#define XB_TOPGEN   3392
#define XCD_BAR_WORDS 3456
#define XB_SPIN_CAP (1u << 18)

__device__ __forceinline__ unsigned xb_ld(unsigned* p)              { return __hip_atomic_load(p, __ATOMIC_RELAXED, __HIP_MEMORY_SCOPE_AGENT); }
__device__ __forceinline__ unsigned xb_add(unsigned* p, unsigned v) { return __hip_atomic_fetch_add(p, v, __ATOMIC_RELAXED, __HIP_MEMORY_SCOPE_AGENT); }
__device__ __forceinline__ unsigned xb_xcc_id() { return (unsigned)__builtin_amdgcn_s_getreg((3 << 11) | 20) & 0xFu; }
#define XB_SPIN(cond, bar) do { unsigned _sp = 0; while (cond) { __builtin_amdgcn_s_sleep(1); \
    if ((++_sp & 255u) == 0u) { if (xb_ld(&(bar)[XB_TMO])) break; if (_sp > XB_SPIN_CAP) { atomicAdd(&(bar)[XB_TMO], 1u); break; } } } } while (0)

struct XcdBarrier {
    unsigned* bar; unsigned x;
    volatile LAS unsigned* st;
};

__device__ __forceinline__ XcdBarrier xcd_barrier_post(unsigned* bar, volatile LAS unsigned* st) {
    XcdBarrier b; b.bar = bar; b.x = xb_xcc_id(); b.st = st;
    if (threadIdx.x == 0) (void)xb_add(&bar[XB_XCNT(b.x)], 1u);
    return b;
}
__device__ __forceinline__ void xcd_barrier_complete(unsigned* bar, unsigned x, unsigned& nloc, unsigned& nx) {
    const unsigned G = gridDim.x * gridDim.y * gridDim.z;
    unsigned sum, cnt, mine, sp = 0u;
    for (;;) {
        sum = 0u; cnt = 0u; mine = 0u;
#pragma unroll
        for (unsigned j = 0; j < 16; ++j) { const unsigned c = xb_ld(&bar[XB_XCNT(j)]); sum += c; cnt += (c > 0u) ? 1u : 0u; mine = (j == x) ? c : mine; }
        if (sum == G) break;
        __builtin_amdgcn_s_sleep(1);
        if ((++sp & 255u) == 0u) { if (xb_ld(&bar[XB_TMO])) break; if (sp > XB_SPIN_CAP) { atomicAdd(&bar[XB_TMO], 1u); break; } }
    }
    nloc = mine > 0u ? mine : 1u; nx = cnt > 0u ? cnt : 1u;
}

__device__ __forceinline__ void xcd_barrier(const XcdBarrier& b) {
    asm volatile("s_waitcnt vmcnt(0)" ::: "memory");
    __syncthreads();
    if (threadIdx.x == 0) {
        unsigned* bar = b.bar;
        __builtin_amdgcn_s_waitcnt(0);
        unsigned nloc = b.st[0], nx = b.st[1];
        if (nloc == 0u) { xcd_barrier_complete(bar, b.x, nloc, nx); b.st[0] = nloc; b.st[1] = nx; }
        const unsigned old = xb_add(&bar[XB_XSUB(b.x)], 1u);
        const unsigned gen = old / nloc;
        if (old + 1u == (gen + 1u) * nloc) {
            __builtin_amdgcn_fence(__ATOMIC_RELEASE, "agent");
            asm volatile("s_waitcnt vmcnt(0)" ::: "memory");
            const unsigned og = xb_add(&bar[XB_TOP], 1u);
            const unsigned tg = og / nx;
            if (og + 1u == (tg + 1u) * nx) xb_add(&bar[XB_TOPGEN], 1u);
            else XB_SPIN(xb_ld(&bar[XB_TOPGEN]) == tg, bar);
            __builtin_amdgcn_fence(__ATOMIC_ACQUIRE, "agent");
            xb_add(&bar[XB_XGEN(b.x)], 1u);
            asm volatile("s_waitcnt vmcnt(0)" ::: "memory");
        } else {
            XB_SPIN(xb_ld(&bar[XB_XGEN(b.x)]) == gen, bar);
            __builtin_amdgcn_fence(__ATOMIC_ACQUIRE, "agent");
            asm volatile("s_waitcnt vmcnt(0)" ::: "memory");
        }
    }
    __syncthreads();
}

__global__ void __launch_bounds__(512, 2) mk_fwd(Args a) {
    extern __shared__ __attribute__((aligned(16))) unsigned char lds_raw[];
    cg::grid_group grid = cg::this_grid();
    LAS unsigned char* lds = (LAS unsigned char*)lds_raw;
    const int G = gridDim.x, bid = blockIdx.x, NGW = G * 8, NGT = G * 512;
#define PH_BEGIN unsigned char* ws = a.ws; asm volatile("" : "+s"(ws)); int tid = threadIdx.x; asm volatile("" : "+v"(tid)); int l = ll; asm volatile("" : "+s"(l)); \
    const int lane = tid & 63, wave = __builtin_amdgcn_readfirstlane(tid >> 6), gw = bid * 8 + wave, gt = bid * 512 + tid; (void)lane; (void)wave; (void)gw; (void)gt; (void)l; (void)ws;
#define WP(T, off) ((T*)(ws + (off)))
#define WIN_T WP(bf16, WS_WIN)
#define WUP_T WP(bf16, WS_WUP)
#define WOUT_T WP(bf16, WS_WOUT)
#define WCQ_T WP(bf16, WS_WCQ)
#define WCKV_T WP(bf16, WS_WCKV)
#define WCO_T WP(bf16, WS_WCO)
#define WFF1_T WP(bf16, WS_WFF1)
#define WFF2_T WP(bf16, WS_WFF2)
#define WGLU_T WP(bf16, WS_WGLU)
#define POOLT WP(bf16, WS_POOLT)
#define WST WP(bf16, WS_WST)
#define AB WP(float, WS_AB)
#define BBT WP(bf16, WS_BBT)
#define CM WP(bf16, WS_CM)
#define MEMN WP(bf16, WS_MEMN)
#define KV WP(bf16, WS_KV)
#define LSE WP(float, WS_LSE)
#define Hn WP(bf16, WS_H)
#define MERGED WP(bf16, WS_MERGED)
#define TOT WP(float, WS_TOT)
#define BR WP(bf16, WS_BR)
#define PROJ WP(bf16, WS_PROJ)
#define Y WP(bf16, WS_Y)
#define Qb WP(bf16, WS_Q)
#define Ob WP(bf16, WS_O)
#define HID WP(bf16, WS_HID)
#define YFF WP(bf16, WS_YFF)
#define X (a.out)
#define XS WP(bf16, WS_TOT)
#define IN(k) kin(k)
    volatile LAS unsigned* MISC = (volatile LAS unsigned*)(lds + LDS_BYTES - 64);
    if (threadIdx.x < 16) MISC[threadIdx.x] = 0u;
    __syncthreads();
    XcdBarrier xb = xcd_barrier_post((unsigned*)(a.ws + WS_CTL) + 4096, MISC + 8);
    grid.sync();
    for (int ll = 0; ll < DEPTH; ++ll) {
        { PH_BEGIN
            LAS float* scr = (LAS float*)(lds + wave * 16384);
            const float* w_in = IN(I_WIN) + (size_t)l * D * INW; const float* w_up = IN(I_WUP) + (size_t)l * 4 * 512 * 1024; const float* w_out = IN(I_WOUT) + (size_t)l * D * D;
            const float* w_cq = IN(I_WCQ) + (size_t)l * D * 512; const float* w_ckv = IN(I_WCKV) + (size_t)l * D * 1024; const float* w_co = IN(I_WCO) + (size_t)l * 512 * D;
            const float* w_ff1 = IN(I_WFF1) + (size_t)l * D * DFF; const float* w_ff2 = IN(I_WFF2) + (size_t)l * DFF * D; const float* w_glu = IN(I_WGLU) + (size_t)l * 512 * 512;
            const float* pool_w = IN(I_POOLW) + (size_t)l * 4 * 128 * 128;
            constexpr int N_WIN = (D / 64) * (INW / 32), N_UP = (512 / 64) * (1024 / 32), N_OUT = (D / 64) * (D / 32), N_CQ = (D / 64) * (512 / 32), N_CKV = (D / 64) * (1024 / 32),
                          N_CO = (512 / 64) * (D / 32), N_FF1 = (D / 64) * (DFF / 32), N_FF2 = (DFF / 64) * (D / 32), N_GLU = (512 / 64) * (512 / 32), N_POOL = (128 / 64) * (128 / 32);
            constexpr int NITEMS = N_WIN + 4 * N_UP + N_OUT + N_CQ + N_CKV + N_CO + N_FF1 + N_FF2 + N_GLU + 4 * N_POOL;
            for (int it = gw; it < NITEMS; it += NGW) {
                int r = it;
                if (r < N_WIN) { tr_item(w_in, D, INW, WIN_T, scr, r, lane); continue; } r -= N_WIN;
                if (r < 4 * N_UP) { const int i = r / N_UP; tr_item(w_up + (size_t)i * 512 * 1024, 512, 1024, WUP_T + (size_t)i * 1024 * 512, scr, r % N_UP, lane); continue; } r -= 4 * N_UP;
                if (r < N_OUT) { tr_item(w_out, D, D, WOUT_T, scr, r, lane); continue; } r -= N_OUT;
                if (r < N_CQ) { tr_item(w_cq, D, 512, WCQ_T, scr, r, lane); continue; } r -= N_CQ;
                if (r < N_CKV) { tr_item(w_ckv, D, 1024, WCKV_T, scr, r, lane); continue; } r -= N_CKV;
                if (r < N_CO) { tr_item(w_co, 512, D, WCO_T, scr, r, lane); continue; } r -= N_CO;
                if (r < N_FF1) { tr_item(w_ff1, D, DFF, WFF1_T, scr, r, lane); continue; } r -= N_FF1;
                if (r < N_FF2) { tr_item(w_ff2, DFF, D, WFF2_T, scr, r, lane); continue; } r -= N_FF2;
                if (r < N_GLU) { tr_item(w_glu, 512, 512, WGLU_T, scr, r, lane); continue; } r -= N_GLU;
                { const int i = r / N_POOL; tr_item(pool_w + (size_t)i * 128 * 128, 128, 128, POOLT + (size_t)i * 128 * 128, scr, r % N_POOL, lane); }
            }
            const float* w_s = IN(I_WS) + (size_t)l * 4 * 128 * 128;
            for (int e = gt; e < 4 * 128 * 128; e += NGT) { const int t = (e >> 7) & 127, s = e & 127; WST[e] = (s <= t) ? (bf16)f2bf(w_s[e]) : (bf16)0; }
            for (int e = gt; e < 32 * 64; e += NGT) {
                const int g = e >> 6, p = e & 63;
                const float are = fminf(IN(I_ARE)[(size_t)l * 2048 + e], -1e-4f), aim = IN(I_AIM)[(size_t)l * 2048 + e];
                const double lr = (double)are, li = (double)aim, dt = dexp((double)IN(I_LOGDT)[l * 32 + g]);
                const double mag = dexp_small(lr * dt); double sn, cs; dsincos(li * dt, sn, cs);
                const double abr = mag * cs, abi = mag * sn, den = lr * lr + li * li;
                const double fr_ = ((abr - 1.0) * lr + abi * li) / den, fi_ = (abi * lr - (abr - 1.0) * li) / den;
                AB[e * 2] = (float)abr; AB[e * 2 + 1] = (float)abi;
                const float* br_ = IN(I_BRE) + ((size_t)l * 2048 + e) * 16; const float* bi_ = IN(I_BIM) + ((size_t)l * 2048 + e) * 16;
                for (int c = 0; c < 16; ++c) { const double brc = br_[c], bic = bi_[c];
                    BBT[(g * 128 + p) * 16 + c] = (bf16)f2bf((float)(fr_ * brc - fi_ * bic)); BBT[(g * 128 + 64 + p) * 16 + c] = (bf16)f2bf((float)(fr_ * bic + fi_ * brc));
                    CM[(g * 16 + c) * 128 + p] = (bf16)f2bf(IN(I_CRE)[((size_t)l * 512 + g * 16 + c) * 64 + p]); CM[(g * 16 + c) * 128 + 64 + p] = (bf16)f2bf(-IN(I_CIM)[((size_t)l * 512 + g * 16 + c) * 64 + p]); }
            }
            for (int row = gw; row < NB * NMEM; row += NGW) rms_row_bf16(IN(I_MEM) + (size_t)row * D, IN(I_GMEM) + (size_t)l * D, MEMN + (size_t)row * D, lane);
            if (l == 0) for (int row = gw; row < M; row += NGW) rms_row_bf16(IN(I_X) + (size_t)row * D, IN(I_GMIXPRE), Hn + (size_t)row * D, lane);
        }
        xcd_barrier(xb);
        { PH_BEGIN
          pg8::Gemm g{MEMN, WCKV_T, NB * NMEM, 1024, D, D}; pg8::StaticOrder So; So.init(NB * NMEM, 1024, G, (bid + G / 2) % G);
          pg8::EpiPlain<0> E{KV, 1024, 1.f};
          pg8::gemm_phase<pg8::EpiPlain<0>, pg8::StaticOrder, true, true>(lds, g, So, E); }
        for (int hh = 0; hh < 2; ++hh) {
            { PH_BEGIN int hf = hh; asm volatile("" : "+s"(hf));
              pg8::Gemm g{Hn + (size_t)hf * MH * D, WIN_T, MH, INW, D, D}; pg8::StaticOrder So; So.init(MH, INW, G, bid);
              pg8::EpiProj E{PROJ, IN(I_GATEB) + (size_t)l * 4 * D};
              pg8::gemm_phase<pg8::EpiProj, pg8::StaticOrder, true, true>(lds, g, So, E); }
            xcd_barrier(xb);
            { PH_BEGIN int hf = hh; asm volatile("" : "+s"(hf));
                unsigned* ctr = (unsigned*)(ws + WS_CTL) + 8192 + (l * 2 + hf) * 64;
                volatile LAS int* nxt = (volatile LAS int*)(lds + LDS_BYTES - 64 + 16);
                if (tid == 0) { nxt[0] = (int)atomicAdd(ctr, 1u); nxt[1] = (int)atomicAdd(ctr, 1u); }
                __syncthreads();
                int u = nxt[0], un = nxt[1];
                __syncthreads();
                while (u < 1152) {
                    unsigned unn = 0u; if (tid == 0) unn = atomicAdd(ctr, 1u);
                    if (u < 128) ssm_unit(lds, PROJ, AB, BBT, CM, IN(I_DSKIP) + (size_t)l * 512, u, tid, lane, wave);
                    else if (u < 640) sgu_unit(lds, PROJ, WST, IN(I_LNG) + (size_t)l * 512, IN(I_LNB) + (size_t)l * 512, IN(I_BS) + (size_t)l * 512, BR + (size_t)3 * MH * 512, u - 128, tid, lane, wave);
                    else pool_unit(lds, PROJ, POOLT, IN(I_POOLS) + (size_t)l * 512, BR, u - 640, tid, lane, wave);
                    if (tid == 0) nxt[0] = (int)unn;
                    __syncthreads();
                    u = un; un = nxt[0];
                    __syncthreads();
                }
                if (u < 4224) {
                    AttnRegs<64> R;
                    { const DilU d = dil_decode(u - 1152, PROJ, LSE); attn_issue<64>(R, d.Qp, d.stride, d.Kp, d.Kp + 1536, d.stride, d.kfirst, tid, lane, wave); }
                    while (u < 4224) {
                        unsigned unn = 0u; if (tid == 0) unn = atomicAdd(ctr, 1u);
                        const DilU d = dil_decode(u - 1152, PROJ, LSE);
                        attn_stage<64, true>(lds, R, IN(I_RELB), d.dil, d.gh, tid);
                        bf16x8 qf[2] = {R.qf[0], R.qf[1]};
                        __syncthreads();
                        if (un < 4224) { const DilU dn = dil_decode(un - 1152, PROJ, LSE); attn_issue<64>(R, dn.Qp, dn.stride, dn.Kp, dn.Kp + 1536, dn.stride, dn.kfirst, tid, lane, wave); }
                        attn_compute<64, true>(lds, qf, d.kfirst, d.Qp, d.stride, d.lsep, d.dil, tid, lane, wave);
                        if (tid == 0) nxt[0] = (int)unn;
                        __syncthreads();
                        u = un; un = nxt[0];
                        __syncthreads();
                    }
                }
            }
            xcd_barrier(xb);
            { PH_BEGIN
                attn_merge(PROJ, LSE, BR + (size_t)1 * MH * 512, gt, NGT);
                pg8::Gemm g{PROJ + OFF_SSM, WGLU_T, MH, 512, 512, INW}; pg8::StaticOrder So; So.init(MH, 512, G, bid);
                pg8::EpiGlu E{PROJ, BR + (size_t)2 * MH * 512, IN(I_BGLU) + (size_t)l * 512};
                pg8::gemm_phase<pg8::EpiGlu, pg8::StaticOrder, true, true>(lds, g, So, E);
            }
            xcd_barrier(xb);
            { PH_BEGIN int hf = hh; asm volatile("" : "+s"(hf));
              pg8::Gemm g{BR, WUP_T, 4 * MH, 4 * 1024, 512, 512}; pg8::BranchOrder So{G, bid};
              pg8::EpiGateChain E{PROJ, MERGED + (size_t)hf * MH * D};
              pg8::gemm_phase<pg8::EpiGateChain, pg8::BranchOrder, true, true>(lds, g, So, E); }
            xcd_barrier(xb);
        }
        { PH_BEGIN
          pg8::Gemm g{MERGED, WOUT_T, M, D, D, D}; pg8::StaticOrder So; So.init(M, D, G, bid);
          pg8::EpiPlain<0> E{Y, D, 1.f};
          pg8::gemm_phase<pg8::EpiPlain<0>, pg8::StaticOrder, true, true>(lds, g, So, E); }
        xcd_barrier(xb);
        { PH_BEGIN rowpass(l == 0 ? (const void*)IN(I_X) : (const void*)XS, l == 0, Y, IN(I_GMIXPOST) + (size_t)l * D, IN(I_GXPRE) + (size_t)l * D, XS, false, Hn, gw, NGW, lane); }
        xcd_barrier(xb);
        { PH_BEGIN
          pg8::Gemm g{Hn, WCQ_T, M, 512, D, D}; pg8::StaticOrder So; So.init(M, 512, G, bid);
          pg8::EpiPlain<0> E{Qb, 512, 0.08838834764831845f};
          pg8::gemm_phase<pg8::EpiPlain<0>, pg8::StaticOrder, true, true>(lds, g, So, E); }
        xcd_barrier(xb);
        { PH_BEGIN
          for (int bu = bid; bu < 256; bu += G) {
              const int bh = bu >> 3, b = bh >> 2, h = bh & 3, tile0 = b * 32 + (bu & 7) * 4;
              const bf16* Kp = KV + (size_t)b * NMEM * 1024 + h * 128;
              bf16x8 qf[4];
              { AttnRegs<128> R; attn_issue<128>(R, Qb + (size_t)tile0 * 128 * 512 + h * 128, 512, Kp, Kp + 512, 1024, 0, tid, lane, wave);
                attn_stage<128, false>(lds, R, nullptr, 1, 0, tid);
#pragma unroll
                for (int ks = 0; ks < 4; ++ks) qf[ks] = R.qf[ks]; }
              __syncthreads();
              for (int k = 0; k < 4; ++k) { const int tile = tile0 + k, tn = tile0 + min(k + 1, 3);
                  bf16x8 qn[4];
#pragma unroll
                  for (int ks = 0; ks < 4; ++ks) qn[ks] = *(const bf16x8*)(Qb + (size_t)(tn * 128 + 16 * wave + (lane & 15)) * 512 + h * 128 + 32 * ks + 8 * (lane >> 4));
                  attn_compute<128, false>(lds, qf, 0, Ob + (size_t)tile * 128 * 512 + h * 128, 512, nullptr, 1, tid, lane, wave);
#pragma unroll
                  for (int ks = 0; ks < 4; ++ks) qf[ks] = qn[ks]; } } }
        xcd_barrier(xb);
        { PH_BEGIN
          pg8::Gemm g{Ob, WCO_T, M, D, 512, 512}; pg8::StaticOrder So; So.init(M, D, G, bid);
          pg8::EpiPlain<0> E{Y, D, 1.f};
          pg8::gemm_phase<pg8::EpiPlain<0>, pg8::StaticOrder, true, true>(lds, g, So, E); }
        xcd_barrier(xb);
        { PH_BEGIN rowpass(XS, false, Y, IN(I_GXPOST) + (size_t)l * D, IN(I_GFFPRE) + (size_t)l * D, XS, false, Hn, gw, NGW, lane); }
        xcd_barrier(xb);
        { PH_BEGIN
          pg8::Gemm g{Hn, WFF1_T, M, DFF, D, D}; pg8::StaticOrder So; So.init(M, DFF, G, bid);
          pg8::EpiPlain<1> E{HID, DFF, 1.f};
          pg8::gemm_phase<pg8::EpiPlain<1>, pg8::StaticOrder, true, true>(lds, g, So, E); }
        xcd_barrier(xb);
        { PH_BEGIN
          pg8::Gemm g{HID, WFF2_T, M, D, DFF, DFF}; pg8::StaticOrder So; So.init(M, D, G, bid);
          pg8::EpiPlain<0> E{YFF, D, 1.f};
          pg8::gemm_phase<pg8::EpiPlain<0>, pg8::StaticOrder, true, true>(lds, g, So, E); }
        xcd_barrier(xb);
        { PH_BEGIN rowpass(XS, false, YFF, IN(I_GFFPOST) + (size_t)l * D, (l + 1 < DEPTH) ? IN(I_GMIXPRE) + (size_t)(l + 1) * D : nullptr, (l + 1 < DEPTH) ? (void*)XS : (void*)X, !(l + 1 < DEPTH), Hn, gw, NGW, lane); }
        xcd_barrier(xb);
    }
}

extern "C" void kernel_launch(void* const* d_in, const int* in_sizes, int n_in, void* d_out, int out_size, void* d_ws, size_t ws_size, hipStream_t stream) {
    static int grid = 0;
    if (grid == 0) {
        if (n_in != 35 || in_sizes[0] != M * D || out_size != M * D || ws_size < WS_END) { fprintf(stderr, "kernel_launch: unexpected problem (n_in %d, ws %zu, need %zu)\n", n_in, ws_size, (size_t)WS_END); grid = -1; return; }
        int dev = 0, cus = 0, per_cu = 0;
        (void)hipGetDevice(&dev); (void)hipDeviceGetAttribute(&cus, hipDeviceAttributeMultiprocessorCount, dev);
        if (hipFuncSetAttribute((const void*)mk_fwd, hipFuncAttributeMaxDynamicSharedMemorySize, LDS_BYTES) != hipSuccess) { fprintf(stderr, "kernel_launch: hipFuncSetAttribute failed\n"); grid = -1; return; }
        if (hipOccupancyMaxActiveBlocksPerMultiprocessor(&per_cu, (const void*)mk_fwd, 512, LDS_BYTES) != hipSuccess || per_cu < 1) per_cu = 1;
        (void)hipGetLastError();
        grid = cus * 1;
        if (grid <= 0) grid = 256;
    }
    if (grid < 0) return;
    if (hipMemsetAsync((char*)d_ws + WS_CTL, 0, 65536, stream) != hipSuccess) { fprintf(stderr, "memset failed\n"); return; }
    Args a{};
    for (int i = 0; i < 35; ++i) a.in[i] = (const float*)d_in[i];
    a.out = (float*)d_out; a.ws = (unsigned char*)d_ws;
    void* args[] = {&a};
    hipError_t e = hipLaunchCooperativeKernel((const void*)mk_fwd, dim3(grid), dim3(512), args, LDS_BYTES, stream);
    if (e != hipSuccess) fprintf(stderr, "cooperative launch failed: %s (grid %d)\n", hipGetErrorString(e), grid);
}
```

```cpp
#include <hip/hip_runtime.h>
#include <hip/hip_cooperative_groups.h>
#include <cstdio>
#include <cstdint>
namespace cg = cooperative_groups;

constexpr int NB = 8, S = 4096, D = 1024, M = NB * S, MH = M / 2, DEPTH = 4, NMEM = 256;
constexpr int INW = 10752, OFF_ATT = 512, OFF_SSM = 5120, OFF_SGU = 5632, OFF_GATE = 6656;
constexpr int DFF = 4096;
constexpr float EPS = 1e-6f;

namespace pg8 {
#define PG8_LAS __attribute__((address_space(3)))
typedef unsigned short bf16_t;
typedef short bf16x8 __attribute__((ext_vector_type(8)));
typedef float f32x4 __attribute__((ext_vector_type(4)));
typedef unsigned u32x4 __attribute__((ext_vector_type(4)));
constexpr int BM = 256, BK = 64, HALF = 128, HTB = HALF * BK * 2  , STAGE_BYTES = 8 * HTB, NXCD = 8, WGM = 8;

__host__ __device__ __forceinline__ int lds_byte(int r, int c) { const int st = (r >> 4) * 2 + (c >> 5), rr = r & 15, cc = c & 31, ob = rr * 64 + cc * 2; return st * 1024 + (ob ^ (((ob >> 9) & 1) << 5)); }
__host__ __device__ __forceinline__ void stage_rc(int b, int& R, int& C) { const int st = b / 1024, sb = b % 1024, swz = sb ^ (((sb >> 9) & 1) << 5); R = (st >> 1) * 16 + swz / 64; C = (st & 1) * 32 + (swz % 64) / 2; }
__host__ __device__ __forceinline__ int perm32(int rho) { const int n = rho >> 4, i = rho & 15; return 8 * (i >> 2) + 4 * n + (i & 3); }

struct Unit { int pm, pn; };
struct Gemm { const bf16_t* A; const bf16_t* Bt; int M, N, K, lda; };

struct StaticOrder {
    int nM, nN, nwg, G, c;
    __host__ __device__ void init(int M, int N, int G_, int c_) { nM = M / BM; nN = N / BM; nwg = nM * nN; G = G_; c = c_; }
    __host__ __device__ bool next(int i, Unit& u) const {
        const long L = (long)i * G + c; if (L >= nwg) return false;
        int wgid = (int)L; { const int q = nwg / NXCD, r = nwg % NXCD, xcd = wgid % NXCD, off = wgid / NXCD; wgid = (xcd < r ? xcd * (q + 1) : r * (q + 1) + (xcd - r) * q) + off; }
        const int nig = WGM * nN, gid = wgid / nig, fm = gid * WGM, gsz = (nM - fm) < WGM ? (nM - fm) : WGM;
        u.pm = fm + ((wgid % nig) % gsz); u.pn = (wgid % nig) / gsz; return true;
    }
    __device__ __forceinline__ void a_ready(const Unit&) const {}
    __device__ __forceinline__ void done(const Unit&) const {}
};
__device__ __forceinline__ unsigned cvt_pk_bf16(float lo, float hi) { unsigned r; asm volatile("v_cvt_pk_bf16_f32 %0, %1, %2" : "=v"(r) : "v"(lo), "v"(hi)); return r; }
__device__ __forceinline__ float bflo(unsigned w) { return __builtin_bit_cast(float, w << 16); }
__device__ __forceinline__ float bfhi(unsigned w) { return __builtin_bit_cast(float, w & 0xffff0000u); }
__device__ __forceinline__ float sigm(float x) { return __builtin_amdgcn_rcpf(1.f + __expf(-x)); }
__device__ __forceinline__ float gelu_t(float x) { const float z = 1.5957691216057308f * (x + 0.044715f * x * x * x); return x * __builtin_amdgcn_rcpf(1.f + __expf(-z)); }

#define EPI_ARGS const f32x4 (&acc)[2][2][4][2], const Unit& u, int wr, int wc, int fr, int fq
#define EPI_FOR_ROWS _Pragma("unroll") for (int ai = 0; ai < 2; ++ai) _Pragma("unroll") for (int m = 0; m < 4; ++m)
#define EPI_FOR_BJ _Pragma("unroll") for (int bj = 0; bj < 2; ++bj)

struct EpiProj {
    static constexpr bool PERM = true, AFTER_DRAIN = false, CHAIN = false;
    bf16_t* O; const float* gb;
    __device__ __forceinline__ void operator()(EPI_ARGS) const {
        const int colt = u.pn * BM; const int mode = colt >= OFF_GATE ? 2 : (colt >= OFF_SGU ? 1 : 0);
        const int col0 = colt + wc * 32 + 8 * fq;
        f32x4 bv[2][2];
        EPI_FOR_BJ { _Pragma("unroll") for (int n = 0; n < 2; ++n) bv[bj][n] = (mode == 2) ? *(const f32x4*)(gb + (col0 - OFF_GATE) + bj * HALF + 4 * n) : (f32x4){0.f, 0.f, 0.f, 0.f}; }
        EPI_FOR_ROWS { const int row = u.pm * BM + ai * HALF + wr * 64 + m * 16 + fr; bf16_t* rowp = O + (size_t)row * INW + col0;
            EPI_FOR_BJ { f32x4 v0 = acc[ai][bj][m][0] + bv[bj][0], v1 = acc[ai][bj][m][1] + bv[bj][1];
                if (mode == 2) { _Pragma("unroll") for (int j = 0; j < 4; ++j) { v0[j] = sigm(v0[j]); v1[j] = sigm(v1[j]); } }
                else if (mode == 1) { _Pragma("unroll") for (int j = 0; j < 4; ++j) { v0[j] = gelu_t(v0[j]); v1[j] = gelu_t(v1[j]); } }
                u32x4 w; w.x = cvt_pk_bf16(v0[0], v0[1]); w.y = cvt_pk_bf16(v0[2], v0[3]); w.z = cvt_pk_bf16(v1[0], v1[1]); w.w = cvt_pk_bf16(v1[2], v1[3]);
                *(u32x4*)(rowp + bj * HALF) = w; } }
    }
};
template <int ACT  > struct EpiPlain {
    static constexpr bool PERM = true, AFTER_DRAIN = false, CHAIN = false;
    bf16_t* O; int ldc; float scale;
    __device__ __forceinline__ void operator()(EPI_ARGS) const {
        const int col0 = u.pn * BM + wc * 32 + 8 * fq;
        EPI_FOR_ROWS { const int row = u.pm * BM + ai * HALF + wr * 64 + m * 16 + fr; bf16_t* rowp = O + (size_t)row * ldc + col0;
            EPI_FOR_BJ { f32x4 v0 = acc[ai][bj][m][0], v1 = acc[ai][bj][m][1];
                if (ACT == 1) { _Pragma("unroll") for (int j = 0; j < 4; ++j) { const float a = fmaxf(v0[j], 0.f), b = fmaxf(v1[j], 0.f); v0[j] = a * a; v1[j] = b * b; } }
                v0 = v0 * scale; v1 = v1 * scale;
                u32x4 w; w.x = cvt_pk_bf16(v0[0], v0[1]); w.y = cvt_pk_bf16(v0[2], v0[3]); w.z = cvt_pk_bf16(v1[0], v1[1]); w.w = cvt_pk_bf16(v1[2], v1[3]);
                *(u32x4*)(rowp + bj * HALF) = w; } }
    }
};
struct EpiGlu {
    static constexpr bool PERM = true, AFTER_DRAIN = false, CHAIN = false;
    const bf16_t* G; bf16_t* O; const float* bias;
    __device__ __forceinline__ void operator()(EPI_ARGS) const {
        const int col0 = u.pn * BM + wc * 32 + 8 * fq;
        f32x4 bv[2][2];
        EPI_FOR_BJ { _Pragma("unroll") for (int n = 0; n < 2; ++n) bv[bj][n] = *(const f32x4*)(bias + col0 + bj * HALF + 4 * n); }
        EPI_FOR_ROWS { const int row = u.pm * BM + ai * HALF + wr * 64 + m * 16 + fr;
            EPI_FOR_BJ { const u32x4 gw = *(const u32x4*)(G + (size_t)row * INW + OFF_SSM + col0 + bj * HALF);
                f32x4 v0 = acc[ai][bj][m][0] + bv[bj][0], v1 = acc[ai][bj][m][1] + bv[bj][1];
                v0[0] = bflo(gw.x) * sigm(v0[0]); v0[1] = bfhi(gw.x) * sigm(v0[1]); v0[2] = bflo(gw.y) * sigm(v0[2]); v0[3] = bfhi(gw.y) * sigm(v0[3]);
                v1[0] = bflo(gw.z) * sigm(v1[0]); v1[1] = bfhi(gw.z) * sigm(v1[1]); v1[2] = bflo(gw.w) * sigm(v1[2]); v1[3] = bfhi(gw.w) * sigm(v1[3]);
                u32x4 w; w.x = cvt_pk_bf16(v0[0], v0[1]); w.y = cvt_pk_bf16(v0[2], v0[3]); w.z = cvt_pk_bf16(v1[0], v1[1]); w.w = cvt_pk_bf16(v1[2], v1[3]);
                *(u32x4*)(O + (size_t)row * 512 + col0 + bj * HALF) = w; } }
    }
};
struct EpiGateAcc {
    static constexpr bool PERM = true, AFTER_DRAIN = false, CHAIN = false;
    const bf16_t* P; float* TOT; bf16_t* O;
    __device__ __forceinline__ void operator()(EPI_ARGS) const {
        const int br = u.pn >> 2, pn = u.pn & 3, pm = u.pm & 63;
        const int col0 = pn * BM + wc * 32 + 8 * fq;
        EPI_FOR_ROWS { const int row = pm * BM + ai * HALF + wr * 64 + m * 16 + fr;
            EPI_FOR_BJ { const int col = col0 + bj * HALF;
                const u32x4 gw = *(const u32x4*)(P + (size_t)row * INW + OFF_GATE + br * 1024 + col);
                float* tp = TOT + (size_t)row * 1024 + col;
                f32x4 t0 = {0.f, 0.f, 0.f, 0.f}, t1 = {0.f, 0.f, 0.f, 0.f};
                if (br > 0) { t0 = *(const f32x4*)tp; t1 = *(const f32x4*)(tp + 4); }
                const f32x4 v0 = acc[ai][bj][m][0], v1 = acc[ai][bj][m][1];
                t0[0] += bflo(gw.x) * v0[0]; t0[1] += bfhi(gw.x) * v0[1]; t0[2] += bflo(gw.y) * v0[2]; t0[3] += bfhi(gw.y) * v0[3];
                t1[0] += bflo(gw.z) * v1[0]; t1[1] += bfhi(gw.z) * v1[1]; t1[2] += bflo(gw.w) * v1[2]; t1[3] += bfhi(gw.w) * v1[3];
                if (br < 3) { *(f32x4*)tp = t0; *(f32x4*)(tp + 4) = t1; }
                else { u32x4 w; w.x = cvt_pk_bf16(t0[0], t0[1]); w.y = cvt_pk_bf16(t0[2], t0[3]); w.z = cvt_pk_bf16(t1[0], t1[1]); w.w = cvt_pk_bf16(t1[2], t1[3]);
                    *(u32x4*)(O + (size_t)row * 1024 + col) = w; } } }
    }
};
struct EpiF32 {
    static constexpr bool PERM = false, AFTER_DRAIN = false, CHAIN = false;
    float* Y; int ldc;
    __device__ __forceinline__ void operator()(EPI_ARGS) const {
        const int col0 = u.pn * BM + wc * 32 + 4 * fq;
        EPI_FOR_ROWS { const int row = u.pm * BM + ai * HALF + wr * 64 + m * 16 + fr; float* rowp = Y + (size_t)row * ldc + col0;
            EPI_FOR_BJ { _Pragma("unroll") for (int n = 0; n < 2; ++n) *(f32x4*)(rowp + bj * HALF + n * 16) = acc[ai][bj][m][n]; } }
    }
};
struct EpiGateChain {
    static constexpr bool PERM = true, AFTER_DRAIN = false, CHAIN = true;
    const bf16_t* P; bf16_t* O;
    __device__ __forceinline__ void operator()(f32x4 (&acc)[2][2][4][2], const Unit& u, int wr, int wc, int fr, int fq) const {
        const int br = u.pn >> 2, pn = u.pn & 3, pm = u.pm & 63;
        const int col0 = pn * BM + wc * 32 + 8 * fq;
        EPI_FOR_ROWS { const int row = pm * BM + ai * HALF + wr * 64 + m * 16 + fr;
            EPI_FOR_BJ { const int col = col0 + bj * HALF;
                const bf16_t* gp = P + (size_t)row * INW + OFF_GATE + br * 1024 + col;
                const u32x4 gc = *(const u32x4*)gp;
                f32x4 v0 = acc[ai][bj][m][0], v1 = acc[ai][bj][m][1];
                v0[0] *= bflo(gc.x); v0[1] *= bfhi(gc.x); v0[2] *= bflo(gc.y); v0[3] *= bfhi(gc.y);
                v1[0] *= bflo(gc.z); v1[1] *= bfhi(gc.z); v1[2] *= bflo(gc.w); v1[3] *= bfhi(gc.w);
                if (br < 3) { const u32x4 gn = *(const u32x4*)(gp + 1024);
                    v0[0] *= __builtin_amdgcn_rcpf(fmaxf(bflo(gn.x), 1e-30f)); v0[1] *= __builtin_amdgcn_rcpf(fmaxf(bfhi(gn.x), 1e-30f)); v0[2] *= __builtin_amdgcn_rcpf(fmaxf(bflo(gn.y), 1e-30f)); v0[3] *= __builtin_amdgcn_rcpf(fmaxf(bfhi(gn.y), 1e-30f));
                    v1[0] *= __builtin_amdgcn_rcpf(fmaxf(bflo(gn.z), 1e-30f)); v1[1] *= __builtin_amdgcn_rcpf(fmaxf(bfhi(gn.z), 1e-30f)); v1[2] *= __builtin_amdgcn_rcpf(fmaxf(bflo(gn.w), 1e-30f)); v1[3] *= __builtin_amdgcn_rcpf(fmaxf(bfhi(gn.w), 1e-30f));
                    acc[ai][bj][m][0] = v0; acc[ai][bj][m][1] = v1; }
                else { u32x4 w; w.x = cvt_pk_bf16(v0[0], v0[1]); w.y = cvt_pk_bf16(v0[2], v0[3]); w.z = cvt_pk_bf16(v1[0], v1[1]); w.w = cvt_pk_bf16(v1[2], v1[3]);
                    *(u32x4*)(O + (size_t)row * 1024 + col) = w;
                    acc[ai][bj][m][0] = (f32x4){0.f, 0.f, 0.f, 0.f}; acc[ai][bj][m][1] = (f32x4){0.f, 0.f, 0.f, 0.f}; } } }
    }
};
struct BranchOrder {
    int G, c;
    __device__ bool next(int i, Unit& u) const { const int r = i >> 2, br = i & 3, T = r * G + c; if (T >= 256) return false; u.pm = br * 64 + (T >> 2); u.pn = br * 4 + (T & 3); return true; }
    __device__ __forceinline__ void a_ready(const Unit&) const {}
    __device__ __forceinline__ void done(const Unit&) const {}
};
template <class Epi, class Sched, bool ALIGN_EPI = false, bool SP2 = false>
__device__ __forceinline__ void gemm_phase(PG8_LAS unsigned char* lds, const Gemm g, const Sched& S, const Epi& E) {
    int tid_ = threadIdx.x; asm volatile("" : "+v"(tid_)); const int tid = tid_, wid = __builtin_amdgcn_readfirstlane(tid >> 6), lane = tid & 63, wr = wid >> 2, wc = wid & 3, fr = lane & 15, fq = lane >> 4;
    const int K = g.K, nt = K / BK;
    unsigned voffA[2], voffB[2];
#pragma unroll
    for (int i = 0; i < 2; ++i) { int R, C; stage_rc(tid * 16 + i * 8192, R, C); const int Rb = Epi::PERM ? ((R & ~31) + perm32(R & 31)) : R;
        voffA[i] = (unsigned)(R * g.lda + C) * 2u; voffB[i] = (unsigned)(Rb * K + C) * 2u; }
    const size_t kstep = (size_t)(BK * 2);
    const size_t hstepA = (size_t)HALF * g.lda * 2, hstepB = (size_t)HALF * K * 2;
    const size_t tstepA = 2 * hstepA, tstepB = 2 * hstepB;
    const unsigned ldsw = (unsigned)wid * 1024u;
    const int aoff = lds_byte(wr * 64 + fr, fq * 8), boff = lds_byte(wc * 32 + fr, fq * 8);
#define PG8_SA(b, h) (((b) * 2 + (h)) * HTB)
#define PG8_SB(b, h) ((4 + (b) * 2 + (h)) * HTB)
#define PG8_STAGE(bufoff, gbase, voff) do { _Pragma("unroll") for (int _i = 0; _i < 2; ++_i) \
        __builtin_amdgcn_global_load_lds((const unsigned*)((const char*)(gbase) + (voff)[_i]), (PG8_LAS unsigned*)(lds + (bufoff) + ldsw + _i * 8192), 16, 0, 0); } while (0)
#define PG8_LDA(dst, b, h) do { _Pragma("unroll") for (int m = 0; m < 4; ++m) _Pragma("unroll") for (int k = 0; k < 2; ++k) dst[m][k] = *(const PG8_LAS bf16x8*)(lds + PG8_SA(b, h) + aoff + m * 2048 + k * 1024); } while (0)
#define PG8_LDB(dst, b, h) do { _Pragma("unroll") for (int n = 0; n < 2; ++n) _Pragma("unroll") for (int k = 0; k < 2; ++k) dst[n][k] = *(const PG8_LAS bf16x8*)(lds + PG8_SB(b, h) + boff + n * 2048 + k * 1024); } while (0)
#define PG8_MMA(ai, bj, At, Bt) do { __builtin_amdgcn_s_setprio(1); _Pragma("unroll") for (int m = 0; m < 4; ++m) _Pragma("unroll") for (int n = 0; n < 2; ++n) _Pragma("unroll") for (int k = 0; k < 2; ++k) \
        acc[ai][bj][m][n] = __builtin_amdgcn_mfma_f32_16x16x32_bf16(Bt[n][k], At[m][k], acc[ai][bj][m][n], 0, 0, 0); __builtin_amdgcn_s_setprio(0); } while (0)
#define PG8_WAIT_V(n) asm volatile("s_waitcnt vmcnt(" #n ")" ::: "memory")
#define PG8_WAIT_L(n) asm volatile("s_waitcnt lgkmcnt(" #n ")" ::: "memory")
#define PG8_BAR __builtin_amdgcn_s_barrier()
#define PG8_SCHED __builtin_amdgcn_sched_barrier(0)
    Unit cur, nxt; int ui = 0;
    if (!S.next(0, cur)) return;
    f32x4 acc[2][2][4][2];
#pragma unroll
    for (int a = 0; a < 2; ++a)
#pragma unroll
        for (int b = 0; b < 2; ++b)
#pragma unroll
            for (int m = 0; m < 4; ++m)
#pragma unroll
                for (int n = 0; n < 2; ++n) acc[a][b][m][n] = (f32x4){0.f, 0.f, 0.f, 0.f};
    bf16x8 At[4][2], B0[2][2], B1[2][2];
    const char* cA = (const char*)g.A + (size_t)cur.pm * tstepA; const char* cB = (const char*)g.Bt + (size_t)cur.pn * tstepB;
    S.a_ready(cur);
    if constexpr (SP2) {
        PG8_STAGE(PG8_SB(0, 0), cB, voffB); PG8_STAGE(PG8_SB(0, 1), cB + hstepB, voffB); PG8_STAGE(PG8_SA(0, 0), cA, voffA); PG8_STAGE(PG8_SA(0, 1), cA + hstepA, voffA);
        if (wr == 1) PG8_BAR;
        PG8_WAIT_V(2); PG8_BAR;
        PG8_STAGE(PG8_SB(1, 0), cB + kstep, voffB); PG8_STAGE(PG8_SA(1, 0), cA + kstep, voffA); PG8_STAGE(PG8_SB(1, 1), cB + hstepB + kstep, voffB);
        PG8_WAIT_V(6); PG8_BAR;
    } else {
        PG8_STAGE(PG8_SB(0, 0), cB, voffB); PG8_STAGE(PG8_SA(0, 0), cA, voffA); PG8_STAGE(PG8_SB(0, 1), cB + hstepB, voffB); PG8_STAGE(PG8_SA(0, 1), cA + hstepA, voffA);
        if (wr == 1) PG8_BAR;
        PG8_WAIT_V(4); PG8_BAR;
        PG8_STAGE(PG8_SB(1, 0), cB + kstep, voffB); PG8_STAGE(PG8_SA(1, 0), cA + kstep, voffA); PG8_STAGE(PG8_SB(1, 1), cB + hstepB + kstep, voffB);
        PG8_WAIT_V(6); PG8_BAR;
    }
    for (;;) {
        const bool has_next = S.next(ui + 1, nxt);
        const char* nA = has_next ? (const char*)g.A + (size_t)nxt.pm * tstepA : cA; const char* nB = has_next ? (const char*)g.Bt + (size_t)nxt.pn * tstepB : cB;
        for (int t = 0; t < nt; t += 2) {
            const bool last = (t == nt - 2);
            const char* a1 = cA + (size_t)(t + 1) * kstep;
            const char* a2 = last ? nA : cA + (size_t)(t + 2) * kstep; const char* b2 = last ? nB : cB + (size_t)(t + 2) * kstep;
            const char* a3 = a2 + kstep; const char* b3 = b2 + kstep;
            if (last && has_next) S.a_ready(nxt);
            if constexpr (SP2) {
            PG8_LDB(B0, 0, 0); PG8_LDB(B1, 0, 1); PG8_SCHED; PG8_LDA(At, 0, 0); PG8_STAGE(PG8_SA(1, 1), a1 + hstepA, voffA);
            PG8_WAIT_V(8); PG8_WAIT_L(0); PG8_BAR; PG8_MMA(0, 0, At, B0); PG8_MMA(0, 1, At, B1); PG8_BAR; PG8_SCHED;
            PG8_LDA(At, 0, 1); PG8_STAGE(PG8_SB(0, 0), b2, voffB); PG8_STAGE(PG8_SB(0, 1), b2 + hstepB, voffB); PG8_STAGE(PG8_SA(0, 0), a2, voffA);
            PG8_WAIT_V(8); PG8_WAIT_L(0); PG8_BAR; PG8_MMA(1, 0, At, B0); PG8_MMA(1, 1, At, B1); PG8_BAR; PG8_SCHED;
            PG8_LDB(B0, 1, 0); PG8_LDB(B1, 1, 1); PG8_SCHED; PG8_LDA(At, 1, 0); PG8_STAGE(PG8_SA(0, 1), a2 + hstepA, voffA);
            PG8_WAIT_V(8); PG8_WAIT_L(0); PG8_BAR; PG8_MMA(0, 0, At, B0); PG8_MMA(0, 1, At, B1); PG8_BAR; PG8_SCHED;
            PG8_LDA(At, 1, 1); PG8_STAGE(PG8_SB(1, 0), b3, voffB); PG8_STAGE(PG8_SB(1, 1), b3 + hstepB, voffB); PG8_STAGE(PG8_SA(1, 0), a3, voffA);
            PG8_WAIT_V(8); PG8_WAIT_L(0); PG8_BAR; PG8_MMA(1, 0, At, B0); PG8_MMA(1, 1, At, B1); PG8_BAR; PG8_SCHED;
            } else {
            PG8_LDB(B0, 0, 0); PG8_SCHED; PG8_LDA(At, 0, 0); PG8_STAGE(PG8_SA(1, 1), a1 + hstepA, voffA);
            PG8_WAIT_L(8); PG8_BAR; PG8_WAIT_L(0); PG8_MMA(0, 0, At, B0); PG8_BAR; PG8_SCHED;
            PG8_LDB(B1, 0, 1); PG8_STAGE(PG8_SB(0, 0), b2, voffB);
            PG8_BAR; PG8_WAIT_L(0); PG8_MMA(0, 1, At, B1); PG8_BAR;
            PG8_LDA(At, 0, 1); PG8_STAGE(PG8_SA(0, 0), a2, voffA);
            PG8_BAR; PG8_WAIT_L(0); PG8_MMA(1, 0, At, B0); PG8_BAR; PG8_SCHED;
            PG8_STAGE(PG8_SB(0, 1), b2 + hstepB, voffB);
            PG8_WAIT_V(6); PG8_BAR; PG8_MMA(1, 1, At, B1); PG8_BAR;
            PG8_LDB(B0, 1, 0); PG8_SCHED; PG8_LDA(At, 1, 0); PG8_STAGE(PG8_SA(0, 1), a2 + hstepA, voffA);
            PG8_WAIT_L(8); PG8_BAR; PG8_WAIT_L(0); PG8_MMA(0, 0, At, B0); PG8_BAR; PG8_SCHED;
            PG8_LDB(B1, 1, 1); PG8_STAGE(PG8_SB(1, 0), b3, voffB);
            PG8_BAR; PG8_WAIT_L(0); PG8_MMA(0, 1, At, B1); PG8_BAR;
            PG8_LDA(At, 1, 1); PG8_STAGE(PG8_SA(1, 0), a3, voffA);
            PG8_BAR; PG8_WAIT_L(0); PG8_MMA(1, 0, At, B0); PG8_BAR; PG8_SCHED;
            PG8_STAGE(PG8_SB(1, 1), b3 + hstepB, voffB);
            PG8_WAIT_V(6); PG8_BAR; PG8_MMA(1, 1, At, B1); PG8_BAR;
            }
        }
        if constexpr (ALIGN_EPI) { if (wr == 0) PG8_BAR; }
        if constexpr (!Epi::AFTER_DRAIN) { E(acc, cur, wr, wc, fr, fq); S.done(cur); }
        if (!has_next) break;
        if constexpr (!Epi::CHAIN) {
#pragma unroll
        for (int a = 0; a < 2; ++a)
#pragma unroll
            for (int b = 0; b < 2; ++b)
#pragma unroll
                for (int m = 0; m < 4; ++m)
#pragma unroll
                    for (int n = 0; n < 2; ++n) acc[a][b][m][n] = (f32x4){0.f, 0.f, 0.f, 0.f};
        }
        cur = nxt; cA = nA; cB = nB; ++ui;
        if constexpr (ALIGN_EPI) { if (wr == 1) PG8_BAR; }
    }
    PG8_WAIT_V(0);
    if constexpr (!ALIGN_EPI) { if (wr == 0) PG8_BAR; }
    PG8_BAR;
    if constexpr (Epi::AFTER_DRAIN) { E.fused(acc, cur, wr, wc, fr, fq, lds, wid, lane); S.done(cur); }
#undef PG8_SA
#undef PG8_SB
#undef PG8_STAGE
#undef PG8_LDA
#undef PG8_LDB
#undef PG8_MMA
#undef PG8_WAIT_V
#undef PG8_WAIT_L
#undef PG8_BAR
#undef PG8_SCHED
}
}

constexpr size_t MiB = 1u << 20, KiB = 1u << 10;
constexpr size_t WS_CTL = 0, CTL_BYTES = 1 * MiB;
constexpr size_t WS_WIN = 1 * MiB, WS_WUP = 22 * MiB, WS_WOUT = 26 * MiB, WS_WCQ = 28 * MiB, WS_WCKV = 29 * MiB, WS_WCO = 31 * MiB, WS_WFF1 = 32 * MiB, WS_WFF2 = 40 * MiB, WS_WGLU = 48 * MiB;
constexpr size_t WS_POOLT = 48 * MiB + 512 * KiB, WS_WST = WS_POOLT + 256 * KiB, WS_AB = WS_WST + 256 * KiB, WS_BBT = WS_AB + 256 * KiB, WS_CM = WS_BBT + 256 * KiB;
constexpr size_t WS_MEMN = 50 * MiB, WS_KV = 54 * MiB, WS_LSE = 58 * MiB, WS_H = 60 * MiB, WS_MERGED = 124 * MiB, WS_TOT = 188 * MiB, WS_BR = 252 * MiB, WS_PROJ = 316 * MiB, WS_END = 652 * MiB;
constexpr size_t WS_Y = WS_PROJ, WS_Q = 444 * MiB, WS_O = 476 * MiB, WS_HID = WS_PROJ, WS_YFF = WS_MERGED;
static_assert(WS_CM + 256 * KiB <= WS_MEMN && WS_PROJ + (size_t)MH * INW * 2 <= WS_END && WS_HID + (size_t)M * DFF * 2 <= WS_END && WS_YFF + (size_t)M * D * 4 <= WS_BR, "ws map");
constexpr int LDS_BYTES = 147456;

#define LAS __attribute__((address_space(3)))
typedef unsigned short bf16;
typedef unsigned v4u __attribute__((ext_vector_type(4)));
typedef unsigned v2u __attribute__((ext_vector_type(2)));
typedef float f32x4 __attribute__((ext_vector_type(4)));
typedef short bf16x8 __attribute__((ext_vector_type(8)));
using pg8::bflo; using pg8::bfhi; using pg8::sigm; using pg8::gelu_t;
__device__ __forceinline__ unsigned f2bf(float f) { unsigned u = __builtin_bit_cast(unsigned, f); return (u + 0x7fffu + ((u >> 16) & 1u)) >> 16; }
__device__ __forceinline__ unsigned pk2(float lo, float hi) { return f2bf(lo) | (f2bf(hi) << 16); }
__device__ __forceinline__ float bf2f(bf16 b) { return __builtin_bit_cast(float, (unsigned)b << 16); }
__device__ __forceinline__ float wave_sum(float v) {
#pragma unroll
    for (int o = 1; o < 64; o <<= 1) v += __shfl_xor(v, o);
    return v;
}
#define LDS_WAIT() asm volatile("s_waitcnt lgkmcnt(0)" ::: "memory")

struct Args { const float* in[35]; float* out; unsigned char* ws; };
enum { I_X = 0, I_MEM, I_RELB, I_GMIXPRE, I_GMIXPOST, I_WIN, I_GATEB, I_POOLW, I_POOLS, I_ARE, I_AIM, I_LOGDT, I_BRE, I_BIM, I_CRE, I_CIM, I_DSKIP, I_WGLU, I_BGLU,
       I_LNG, I_LNB, I_WS, I_BS, I_WUP, I_WOUT, I_GXPRE, I_GXPOST, I_GMEM, I_WCQ, I_WCKV, I_WCO, I_GFFPRE, I_GFFPOST, I_WFF1, I_WFF2 };

__device__ __forceinline__ void tr_item(const float* W, int K, int N, bf16* WT, LAS float* scr, int item, int lane) {
    const int nblk = N / 32, kb = item / nblk, nb = item % nblk, k0 = 64 * kb, n0 = 32 * nb;
#pragma unroll 8
    for (int i = 0; i < 32; ++i) { const int kk = 2 * i + (lane >> 5); scr[kk * 33 + (lane & 31)] = W[(size_t)(k0 + kk) * N + n0 + (lane & 31)]; }
    LDS_WAIT();
    const int c = lane & 7;
#pragma unroll
    for (int j = 0; j < 4; ++j) { const int n = (lane >> 3) + 8 * j; const LAS float* s = scr + (8 * c) * 33 + n;
        v4u o; o.x = pk2(s[0 * 33], s[1 * 33]); o.y = pk2(s[2 * 33], s[3 * 33]); o.z = pk2(s[4 * 33], s[5 * 33]); o.w = pk2(s[6 * 33], s[7 * 33]);
        *(v4u*)(WT + (size_t)(n0 + n) * K + k0 + 8 * c) = o; }
    LDS_WAIT();
}
__device__ __forceinline__ void rms_row_bf16(const float* xrow, const float* g, bf16* orow, int lane) {
    const f32x4* xr = (const f32x4*)xrow + lane; const f32x4* gr = (const f32x4*)g + lane;
    f32x4 v[4]; float s = 0.f;
#pragma unroll
    for (int j = 0; j < 4; ++j) { v[j] = xr[64 * j]; s += (v[j].x * v[j].x + v[j].y * v[j].y) + (v[j].z * v[j].z + v[j].w * v[j].w); }
    const float r = rsqrtf(wave_sum(s) * (1.f / D) + EPS);
    v2u* o8 = (v2u*)orow + lane;
#pragma unroll
    for (int j = 0; j < 4; ++j) { const f32x4 gv = gr[64 * j]; v2u w; w.x = pk2(v[j].x * r * gv.x, v[j].y * r * gv.y); w.y = pk2(v[j].z * r * gv.z, v[j].w * r * gv.w); o8[64 * j] = w; }
}
__device__ __forceinline__ void rowpass(const float* Xi, const bf16* Y, const float* gpost, const float* gpre, float* Xo, bf16* Hh, int gw, int NGW, int lane) {
    constexpr int R = 4;
    f32x4 gp[4];
#pragma unroll
    for (int j = 0; j < 4; ++j) gp[j] = ((const f32x4*)gpost)[lane + 64 * j];
    for (int row0 = gw * R; row0 < M; row0 += NGW * R) {
        f32x4 y[R][4], x[R][4]; float s[R], s2[R];
#pragma unroll
        for (int q = 0; q < R; ++q) { const v2u* yr = (const v2u*)(Y + (size_t)(row0 + q) * D) + lane; const f32x4* xr = (const f32x4*)(Xi + (size_t)(row0 + q) * D) + lane;
#pragma unroll
            for (int j = 0; j < 4; ++j) { const v2u yw = yr[64 * j]; y[q][j] = (f32x4){bflo(yw.x), bfhi(yw.x), bflo(yw.y), bfhi(yw.y)}; x[q][j] = xr[64 * j]; } }
#pragma unroll
        for (int q = 0; q < R; ++q) { s[q] = 0.f;
#pragma unroll
            for (int j = 0; j < 4; ++j) s[q] += (y[q][j].x * y[q][j].x + y[q][j].y * y[q][j].y) + (y[q][j].z * y[q][j].z + y[q][j].w * y[q][j].w); }
#pragma unroll
        for (int o = 1; o < 64; o <<= 1) {
#pragma unroll
            for (int q = 0; q < R; ++q) s[q] += __shfl_xor(s[q], o); }
#pragma unroll
        for (int q = 0; q < R; ++q) { const float r = rsqrtf(s[q] * (1.f / D) + EPS); s2[q] = 0.f; f32x4* xo = (f32x4*)(Xo + (size_t)(row0 + q) * D) + lane;
#pragma unroll
            for (int j = 0; j < 4; ++j) { x[q][j] = x[q][j] + y[q][j] * r * gp[j]; xo[64 * j] = x[q][j];
                s2[q] += (x[q][j].x * x[q][j].x + x[q][j].y * x[q][j].y) + (x[q][j].z * x[q][j].z + x[q][j].w * x[q][j].w); } }
        if (gpre) {
#pragma unroll
            for (int o = 1; o < 64; o <<= 1) {
#pragma unroll
                for (int q = 0; q < R; ++q) s2[q] += __shfl_xor(s2[q], o); }
#pragma unroll
            for (int q = 0; q < R; ++q) { const float r2 = rsqrtf(s2[q] * (1.f / D) + EPS); v2u* o8 = (v2u*)(Hh + (size_t)(row0 + q) * D) + lane;
#pragma unroll
                for (int j = 0; j < 4; ++j) { const f32x4 gv = ((const f32x4*)gpre)[lane + 64 * j]; v2u w; w.x = pk2(x[q][j].x * r2 * gv.x, x[q][j].y * r2 * gv.y); w.y = pk2(x[q][j].z * r2 * gv.z, x[q][j].w * r2 * gv.w); o8[64 * j] = w; } } }
    }
}
__device__ __forceinline__ int t5_bucket(int n) {
    if (n < 16) return n;
    return 16 + (n >= 22) + (n >= 30) + (n >= 40) + (n >= 54) + (n >= 73) + (n >= 99) + (n >= 134) + (n >= 182) + (n >= 246) + (n >= 332) + (n >= 450) + (n >= 609) + (n >= 825) + (n >= 1117) + (n >= 1513);
}
__device__ __forceinline__ double dexp_small(double x) {
    double t = 1.0, s = 1.0;
#pragma unroll
    for (int k = 1; k <= 16; ++k) { t *= x / (double)k; s += t; }
    return s;
}
__device__ __forceinline__ double dexp(double x) { double e = dexp_small(x * (1.0 / 32.0)); e *= e; e *= e; e *= e; e *= e; e *= e; return e; }
__device__ __forceinline__ void dsincos(double x, double& sn, double& cs) {
    const double TWO_PI = 6.283185307179586476925286766559;
    x -= TWO_PI * __builtin_rint(x * (1.0 / TWO_PI));
    const double r = x * 0.125, r2 = r * r;
    double st = r, ct = 1.0, s = r, c = 1.0;
#pragma unroll
    for (int k = 1; k <= 8; ++k) { ct *= -r2 / (double)((2 * k - 1) * (2 * k)); st *= -r2 / (double)((2 * k) * (2 * k + 1)); c += ct; s += st; }
#pragma unroll
    for (int k = 0; k < 3; ++k) { const double s2 = 2.0 * s * c, c2 = c * c - s * s; s = s2; c = c2; }
    sn = s; cs = c;
}
typedef short v4i16_t __attribute__((ext_vector_type(4)));
#define MFMA16(bfrag, afrag, c) __builtin_amdgcn_mfma_f32_16x16x32_bf16((bfrag), (afrag), (c), 0, 0, 0)
__device__ __forceinline__ void attn_naive(bf16* P, float* LSE, const float* relb, int gw, int NGW, int lane) {
    for (int uidx = gw; uidx < MH * 24; uidx += NGW) {
        const int r = uidx / 24, gh = uidx % 24, g = gh >> 3, h = gh & 7;
        const int t = r & (S - 1), dil = g == 0 ? 1 : (g == 1 ? 4 : 16);
        const int nd = min(t / dil, 128);
        bf16* prow = P + (size_t)r * INW + OFF_ATT + g * 512 + h * 64 + lane;
        const float q = bf2f(*prow);
        float mx = -1e30f, ss = 0.f, o = 0.f;
        for (int dist = 0; dist <= nd; ++dist) {
            const bf16* kp = prow - (size_t)dist * dil * INW;
            const float kv = bf2f(kp[1536]), vv = bf2f(kp[3072]);
            const float sc = wave_sum(q * kv) * 0.125f + relb[t5_bucket(dist * dil) * 24 + gh];
            const float mn = fmaxf(mx, sc), corr = __expf(mx - mn), p = __expf(sc - mn);
            ss = ss * corr + p; o = o * corr + p * vv; mx = mn;
        }
        *prow = (bf16)f2bf(o / ss);
        if (lane == 0) LSE[((size_t)g * MH + r) * 8 + h] = mx + __logf(ss);
    }
}
__device__ __forceinline__ void attn_merge(const bf16* __restrict__ P, const float* __restrict__ LSE, bf16* __restrict__ BR1, int gt, int NGT) {
#pragma unroll 4
    for (int e = gt; e < MH * 64; e += NGT) {
        const int r = e >> 6, ch = e & 63, h = ch >> 3;
        const float l0 = LSE[((size_t)0 * MH + r) * 8 + h], l1 = LSE[((size_t)1 * MH + r) * 8 + h], l2 = LSE[((size_t)2 * MH + r) * 8 + h];
        const float mx = fmaxf(l0, fmaxf(l1, l2));
        float w0 = __expf(l0 - mx), w1 = __expf(l1 - mx), w2 = __expf(l2 - mx); const float inv = 1.f / (w0 + w1 + w2); w0 *= inv; w1 *= inv; w2 *= inv;
        const bf16* base = P + (size_t)r * INW + OFF_ATT + ch * 8;
        const v4u a0 = *(const v4u*)base, a1 = *(const v4u*)(base + 512), a2 = *(const v4u*)(base + 1024);
        v4u o;
        o.x = pk2(w0 * bflo(a0.x) + w1 * bflo(a1.x) + w2 * bflo(a2.x), w0 * bfhi(a0.x) + w1 * bfhi(a1.x) + w2 * bfhi(a2.x));
        o.y = pk2(w0 * bflo(a0.y) + w1 * bflo(a1.y) + w2 * bflo(a2.y), w0 * bfhi(a0.y) + w1 * bfhi(a1.y) + w2 * bfhi(a2.y));
        o.z = pk2(w0 * bflo(a0.z) + w1 * bflo(a1.z) + w2 * bflo(a2.z), w0 * bfhi(a0.z) + w1 * bfhi(a1.z) + w2 * bfhi(a2.z));
        o.w = pk2(w0 * bflo(a0.w) + w1 * bflo(a1.w) + w2 * bflo(a2.w), w0 * bfhi(a0.w) + w1 * bfhi(a1.w) + w2 * bfhi(a2.w));
        *(v4u*)(BR1 + (size_t)r * 512 + ch * 8) = o;
    }
}
__device__ __forceinline__ void ssm_naive(bf16* P, const float* AB, const bf16* BBT, const bf16* CM, const float* dskip, int gw, int NGW, int lane) {
    for (int uidx = gw; uidx < 4 * 32; uidx += NGW) {
        const int bl = uidx >> 5, g = uidx & 31;
        float bbr[16], bbi[16], cr[16], ci[16];
#pragma unroll
        for (int c = 0; c < 16; ++c) { bbr[c] = bf2f(BBT[(g * 128 + lane) * 16 + c]); bbi[c] = bf2f(BBT[(g * 128 + 64 + lane) * 16 + c]);
            cr[c] = bf2f(CM[(g * 16 + c) * 128 + lane]); ci[c] = bf2f(CM[(g * 16 + c) * 128 + 64 + lane]); }
        const float ar = AB[(g * 64 + lane) * 2], ai = AB[(g * 64 + lane) * 2 + 1];
        const float dsk = dskip[g * 16 + (lane & 15)];
        float hr = 0.f, hi = 0.f;
        for (int t = 0; t < S; ++t) {
            bf16* up = P + (size_t)(bl * S + t) * INW + OFF_SSM + g * 16;
            const v4u u0 = *(const v4u*)up, u1 = *(const v4u*)(up + 8);
            const float ul = bf2f(up[lane & 15]);
            float u[16] = {bflo(u0.x), bfhi(u0.x), bflo(u0.y), bfhi(u0.y), bflo(u0.z), bfhi(u0.z), bflo(u0.w), bfhi(u0.w),
                           bflo(u1.x), bfhi(u1.x), bflo(u1.y), bfhi(u1.y), bflo(u1.z), bfhi(u1.z), bflo(u1.w), bfhi(u1.w)};
            float bur = 0.f, bui = 0.f;
#pragma unroll
            for (int c = 0; c < 16; ++c) { bur += bbr[c] * u[c]; bui += bbi[c] * u[c]; }
            const float nhr = ar * hr - ai * hi + bur, nhi = ar * hi + ai * hr + bui; hr = nhr; hi = nhi;
            float ym = 0.f;
#pragma unroll
            for (int c = 0; c < 16; ++c) { const float yc = wave_sum(cr[c] * hr + ci[c] * hi); if (lane == c) ym = yc; }
            if (lane < 16) up[lane] = (bf16)f2bf(gelu_t(ym + ul * dsk));
        }
    }
}
__device__ __forceinline__ void sgu_unit(LAS unsigned char* lds, const bf16* P, const bf16* WST, const float* lng, const float* lnb, const float* bs, bf16* BR3, int unit, int tid, int lane, int wave) {
    const int g = unit & 3, n = (unit >> 2) & 31, bl = unit >> 7;
    const int r0 = bl * S + n * 128;
    LAS float* stats = (LAS float*)lds; LAS bf16* VnT = (LAS bf16*)(lds + 1024);
    const int fr = lane & 15, fq = lane >> 4, tq = fr >> 2, tp = fr & 3, t = 16 * wave + fr, nks = (wave >> 1) + 1;
    v4u xs[16], vn[4]; bf16x8 wf[4]; v2u uw[8];
#pragma unroll
    for (int rr = 0; rr < 16; ++rr) xs[rr] = *(const v4u*)(P + (size_t)(r0 + 16 * wave + rr) * INW + OFF_SGU + 512 + lane * 8);
#pragma unroll
    for (int it = 0; it < 4; ++it) { const int idx = tid + 512 * it, s = idx >> 4, ch = (idx & 15) * 8; vn[it] = *(const v4u*)(P + (size_t)(r0 + s) * INW + OFF_SGU + 512 + g * 128 + ch); }
#pragma unroll
    for (int ks = 0; ks < 4; ++ks) wf[ks] = *(const bf16x8*)(WST + ((size_t)g * 128 + t) * 128 + 32 * ks + 8 * fq);
#pragma unroll
    for (int nt = 0; nt < 8; ++nt) uw[nt] = *(const v2u*)(P + (size_t)(r0 + t) * INW + OFF_SGU + g * 128 + 16 * nt + 4 * fq);
    const float bst = bs[g * 128 + t];
#pragma unroll
    for (int rr = 0; rr < 16; ++rr) { const int row = 16 * wave + rr; const v4u x = xs[rr];
        float v[8] = {bflo(x.x), bfhi(x.x), bflo(x.y), bfhi(x.y), bflo(x.z), bfhi(x.z), bflo(x.w), bfhi(x.w)};
        float s = 0.f;
#pragma unroll
        for (int j = 0; j < 8; ++j) s += v[j];
        const float mean = wave_sum(s) * (1.f / 512.f); float q = 0.f;
#pragma unroll
        for (int j = 0; j < 8; ++j) { const float d = v[j] - mean; q += d * d; }
        const float rstd = rsqrtf(wave_sum(q) * (1.f / 512.f) + EPS);
        if (lane == 0) { stats[row * 2] = mean; stats[row * 2 + 1] = rstd; } }
    __syncthreads();
#pragma unroll
    for (int it = 0; it < 4; ++it) { const int idx = tid + 512 * it, s = idx >> 4, ch = (idx & 15) * 8;
        const v4u x = vn[it];
        const float mean = stats[s * 2], rstd = stats[s * 2 + 1];
        float v[8] = {bflo(x.x), bfhi(x.x), bflo(x.y), bfhi(x.y), bflo(x.z), bfhi(x.z), bflo(x.w), bfhi(x.w)};
        const f32x4 g0 = *(const f32x4*)(lng + g * 128 + ch), g1 = *(const f32x4*)(lng + g * 128 + ch + 4), b0 = *(const f32x4*)(lnb + g * 128 + ch), b1 = *(const f32x4*)(lnb + g * 128 + ch + 4);
#pragma unroll
        for (int j = 0; j < 4; ++j) { v[j] = (v[j] - mean) * rstd * g0[j] + b0[j]; v[4 + j] = (v[4 + j] - mean) * rstd * g1[j] + b1[j]; }
        v4u w; w.x = pk2(v[0], v[1]); w.y = pk2(v[2], v[3]); w.z = pk2(v[4], v[5]); w.w = pk2(v[6], v[7]);
        *(LAS v4u*)(VnT + s * 136 + ch) = w;
    }
    __syncthreads();
    { f32x4 acc[8];
#pragma unroll
      for (int nt = 0; nt < 8; ++nt) acc[nt] = (f32x4){0.f, 0.f, 0.f, 0.f};
#pragma unroll
      for (int ks = 0; ks < 4; ++ks) if (ks < nks) {
#pragma unroll
          for (int nt = 0; nt < 8; ++nt) {
              const v4i16_t lo = __builtin_amdgcn_ds_read_tr16_b64_v4i16((LAS v4i16_t*)(VnT + (32 * ks + 8 * fq + tq) * 136 + 16 * nt + 4 * tp));
              const v4i16_t hi = __builtin_amdgcn_ds_read_tr16_b64_v4i16((LAS v4i16_t*)(VnT + (32 * ks + 8 * fq + 4 + tq) * 136 + 16 * nt + 4 * tp));
              const bf16x8 vf = {lo[0], lo[1], lo[2], lo[3], hi[0], hi[1], hi[2], hi[3]};
              acc[nt] = MFMA16(vf, wf[ks], acc[nt]); } }
#pragma unroll
      for (int nt = 0; nt < 8; ++nt) { const int c = 16 * nt + 4 * fq;
          v2u o; o.x = pk2(bflo(uw[nt].x) * (acc[nt][0] + bst), bfhi(uw[nt].x) * (acc[nt][1] + bst)); o.y = pk2(bflo(uw[nt].y) * (acc[nt][2] + bst), bfhi(uw[nt].y) * (acc[nt][3] + bst));
          *(v2u*)(BR3 + (size_t)(r0 + t) * 512 + g * 128 + c) = o; } }
    __syncthreads();
}
__device__ __forceinline__ void pool_unit(LAS unsigned char* lds, const bf16* P, const bf16* poolt, const float* pscale, bf16* BR0, int unit, int tid, int lane, int wave) {
    const int gi = unit & 3, tt = (unit >> 2) & 31, bl = unit >> 7;
    const int t0 = tt * 128, r0 = bl * S + t0, w = 2 << gi;
    LAS bf16* raw = (LAS bf16*)lds; LAS bf16* Pt = (LAS bf16*)(lds + 36864);
    const int fr = lane & 15, fq = lane >> 4;
    v4u rx[5];
#pragma unroll
    for (int it = 0; it < 5; ++it) { const int idx = tid + 512 * it, j = idx >> 4, ch = (idx & 15) * 8;
        rx[it] = (v4u){0u, 0u, 0u, 0u};
        if (idx < 144 * 16 && t0 - 16 + j >= 0) rx[it] = *(const v4u*)(P + (size_t)(r0 - 16 + j) * INW + gi * 128 + ch); }
    bf16x8 wfa[2][8];
#pragma unroll
    for (int ks = 0; ks < 2; ++ks)
#pragma unroll
        for (int nt = 0; nt < 8; ++nt) wfa[ks][nt] = *(const bf16x8*)(poolt + ((size_t)gi * 128 + 16 * nt + fr) * 128 + 32 * ks + 8 * fq);
#pragma unroll
    for (int it = 0; it < 5; ++it) { const int idx = tid + 512 * it, j = idx >> 4, ch = (idx & 15) * 8; if (idx < 144 * 16) *(LAS v4u*)(raw + j * 128 + ch) = rx[it]; }
    __syncthreads();
    { const int c = tid & 127, tq = tid >> 7, tb0 = tq * 32; const float rc = 1.f / (float)w;
      float s = 0.f;
      for (int j = 0; j < w; ++j) s += bf2f(raw[(16 + tb0 - j) * 128 + c]);
      for (int i = 0; i < 32; ++i) { const int t = tb0 + i; const int cnt = min(t0 + t + 1, w);
          const float cur = bf2f(raw[(16 + t) * 128 + c]);
          const float mean = (cnt == w) ? s * rc : s / (float)cnt;
          Pt[t * 136 + c] = (bf16)f2bf(mean - cur);
          s += bf2f(raw[(17 + t) * 128 + c]) - bf2f(raw[(17 + t - w) * 128 + c]); } }
    __syncthreads();
    { const int t = 16 * wave + fr;
      f32x4 acc[8];
#pragma unroll
      for (int nt = 0; nt < 8; ++nt) acc[nt] = (f32x4){0.f, 0.f, 0.f, 0.f};
#pragma unroll
      for (int ks = 0; ks < 4; ++ks) { const bf16x8 pf = *(const LAS bf16x8*)(Pt + t * 136 + 32 * ks + 8 * fq);
#pragma unroll
          for (int nt = 0; nt < 8; ++nt) { const bf16x8 wf = ks < 2 ? wfa[ks & 1][nt] : *(const bf16x8*)(poolt + ((size_t)gi * 128 + 16 * nt + fr) * 128 + 32 * ks + 8 * fq); acc[nt] = MFMA16(wf, pf, acc[nt]); } }
#pragma unroll
      for (int nt = 0; nt < 8; ++nt) { const int d = 16 * nt + 4 * fq; const f32x4 sc = *(const f32x4*)(pscale + gi * 128 + d);
          v2u o; o.x = pk2(acc[nt][0] * sc[0], acc[nt][1] * sc[1]); o.y = pk2(acc[nt][2] * sc[2], acc[nt][3] * sc[3]);
          *(v2u*)(BR0 + (size_t)(r0 + t) * 512 + gi * 128 + d) = o; } }
    __syncthreads();
}
__device__ __forceinline__ void xattn_naive(const bf16* Q, const bf16* KV, bf16* O, int gw, int NGW, int lane) {
    for (int uidx = gw; uidx < M * 4; uidx += NGW) {
        const int T = uidx >> 2, h = uidx & 3, b = T / S;
        const unsigned qw = *(const unsigned*)(Q + (size_t)T * 512 + h * 128 + 2 * lane);
        const float q0 = bflo(qw), q1 = bfhi(qw);
        float mx = -1e30f, ss = 0.f, o0 = 0.f, o1 = 0.f;
        for (int j = 0; j < NMEM; ++j) {
            const bf16* kr = KV + (size_t)(b * NMEM + j) * 1024 + h * 128 + 2 * lane;
            const unsigned kw = *(const unsigned*)kr, vw = *(const unsigned*)(kr + 512);
            const float sc = wave_sum(q0 * bflo(kw) + q1 * bfhi(kw));
            const float mn = fmaxf(mx, sc), corr = __expf(mx - mn), p = __expf(sc - mn);
            ss = ss * corr + p; o0 = o0 * corr + p * bflo(vw); o1 = o1 * corr + p * bfhi(vw); mx = mn;
        }
        const float inv = 1.f / ss;
        *(unsigned*)(O + (size_t)T * 512 + h * 128 + 2 * lane) = pk2(o0 * inv, o1 * inv);
    }
}
__device__ __forceinline__ void ssm_unit(LAS unsigned char* lds, bf16* P, const float* ABp, const bf16* BBTp, const bf16* CMp, const float* dskip, int unit, int tid, int lane, int wave) {
    const int bl = unit >> 5, g = unit & 31, fr = lane & 15, fq = lane >> 4;
    LAS float* bu = (LAS float*)(lds + wave * 16896);
    LAS bf16* hb = (LAS bf16*)(lds + wave * 16896);
    LAS float* ends = (LAS float*)(lds + 135168);
    const bf16x8 z8 = {0, 0, 0, 0, 0, 0, 0, 0};
    bf16x8 bbf[8], cmf[4];
#pragma unroll
    for (int nt = 0; nt < 8; ++nt) bbf[nt] = fq < 2 ? *(const bf16x8*)(BBTp + (size_t)(g * 128 + 16 * nt + fr) * 16 + 8 * fq) : z8;
#pragma unroll
    for (int ks = 0; ks < 4; ++ks) cmf[ks] = *(const bf16x8*)(CMp + (size_t)(g * 16 + fr) * 128 + 32 * ks + 8 * fq);
    const float ar = ABp[(g * 64 + lane) * 2], ai = ABp[(g * 64 + lane) * 2 + 1];
    float pr = ar, pi = ai;
#pragma unroll
    for (int i = 0; i < 5; ++i) { const float nr = pr * pr - pi * pi, ni = 2.f * pr * pi; pr = nr; pi = ni; }
    const f32x4 dsk = *(const f32x4*)(dskip + g * 16 + 4 * fq);
    float cr = 0.f, ci = 0.f;
    bf16x8 uf[2]; v2u uep[2], uepn[2];
#pragma unroll
    for (int mt = 0; mt < 2; ++mt) { const bf16* up = P + (size_t)(bl * S + wave * 32 + 16 * mt + fr) * INW + OFF_SSM + g * 16;
        uf[mt] = fq < 2 ? *(const bf16x8*)(up + 8 * fq) : z8; uep[mt] = *(const v2u*)(up + 4 * fq); }
    for (int ms = 0; ms < 16; ++ms) {
        const int rbase = bl * S + ms * 256 + wave * 32;
#pragma unroll
        for (int mt = 0; mt < 2; ++mt)
#pragma unroll
            for (int nt = 0; nt < 8; ++nt) { f32x4 acc = {0.f, 0.f, 0.f, 0.f}; acc = MFMA16(bbf[nt], uf[mt], acc);
                *(LAS f32x4*)(bu + (16 * mt + fr) * 132 + 16 * nt + 4 * fq) = acc; }
        { const int rn = bl * S + min(ms + 1, 15) * 256 + wave * 32;
#pragma unroll
          for (int mt = 0; mt < 2; ++mt) { const bf16* up = P + (size_t)(rn + 16 * mt + fr) * INW + OFF_SSM + g * 16;
              uf[mt] = fq < 2 ? *(const bf16x8*)(up + 8 * fq) : z8; uepn[mt] = *(const v2u*)(up + 4 * fq); } }
        LDS_WAIT();
        float hr = 0.f, hi = 0.f;
#pragma unroll 8
        for (int t = 0; t < 32; ++t) { const float br = bu[t * 132 + lane], bi = bu[t * 132 + 64 + lane];
            const float nhr = ar * hr - ai * hi + br, nhi = ar * hi + ai * hr + bi; hr = nhr; hi = nhi; }
        ends[wave * 128 + lane] = hr; ends[wave * 128 + 64 + lane] = hi;
        __syncthreads();
        float sr = cr, si = ci, myr = cr, myi = ci;
#pragma unroll
        for (int w = 0; w < 8; ++w) { if (w == wave) { myr = sr; myi = si; }
            const float er = ends[w * 128 + lane], ei = ends[w * 128 + 64 + lane];
            const float nsr = pr * sr - pi * si + er, nsi = pr * si + pi * sr + ei; sr = nsr; si = nsi; }
        cr = sr; ci = si;
        hr = myr; hi = myi;
#pragma unroll 8
        for (int t = 0; t < 32; ++t) { const float br = bu[t * 132 + lane], bi = bu[t * 132 + 64 + lane];
            const float nhr = ar * hr - ai * hi + br, nhi = ar * hi + ai * hr + bi; hr = nhr; hi = nhi;
            asm volatile("" ::: "memory");
            hb[t * 136 + lane] = (bf16)f2bf(hr); hb[t * 136 + 64 + lane] = (bf16)f2bf(hi);
            asm volatile("" ::: "memory"); }
        LDS_WAIT();
#pragma unroll
        for (int mt = 0; mt < 2; ++mt) { f32x4 acc = {0.f, 0.f, 0.f, 0.f};
#pragma unroll
            for (int ks = 0; ks < 4; ++ks) { const bf16x8 hf_ = *(const LAS bf16x8*)(hb + (16 * mt + fr) * 136 + 32 * ks + 8 * fq); acc = MFMA16(cmf[ks], hf_, acc); }
            const float y0 = gelu_t(acc[0] + bflo(uep[mt].x) * dsk[0]), y1 = gelu_t(acc[1] + bfhi(uep[mt].x) * dsk[1]);
            const float y2 = gelu_t(acc[2] + bflo(uep[mt].y) * dsk[2]), y3 = gelu_t(acc[3] + bfhi(uep[mt].y) * dsk[3]);
            v2u o; o.x = pk2(y0, y1); o.y = pk2(y2, y3);
            *(v2u*)(P + (size_t)(rbase + 16 * mt + fr) * INW + OFF_SSM + g * 16 + 4 * fq) = o; }
        uep[0] = uepn[0]; uep[1] = uepn[1];
        __syncthreads();
    }
}
template <int HD> struct AttnRegs { v4u kx[256 * (HD / 8) / 512], vx[256 * (HD / 8) / 512]; bf16x8 qf[HD / 32]; };
template <int HD>
__device__ __forceinline__ void attn_issue(AttnRegs<HD>& R, const bf16* Qp, size_t qstride, const bf16* Kp, const bf16* Vp, size_t kstride, int kfirst, int tid, int lane, int wave) {
    constexpr int CPR = HD / 8, NIT = 256 * CPR / 512, KST = HD / 32;
#pragma unroll
    for (int it = 0; it < NIT; ++it) { const int idx = tid + 512 * it, kk = idx / CPR, cc = idx % CPR;
        R.kx[it] = (v4u){0u, 0u, 0u, 0u}; R.vx[it] = (v4u){0u, 0u, 0u, 0u};
        if (kk >= kfirst) { R.kx[it] = *(const v4u*)(Kp + (ptrdiff_t)kk * (ptrdiff_t)kstride + cc * 8); R.vx[it] = *(const v4u*)(Vp + (ptrdiff_t)kk * (ptrdiff_t)kstride + cc * 8); } }
    const int qi = 16 * wave + (lane & 15), fq = lane >> 4;
#pragma unroll
    for (int ks = 0; ks < KST; ++ks) R.qf[ks] = *(const bf16x8*)(Qp + (size_t)qi * qstride + 32 * ks + 8 * fq);
}
template <int HD, bool DIL>
__device__ __forceinline__ void attn_stage(LAS unsigned char* lds, const AttnRegs<HD>& R, const float* relb, int dil, int gh, int tid) {
    constexpr int PITCH = HD + 8, CPR = HD / 8, NIT = 256 * CPR / 512;
    LAS bf16* Ks = (LAS bf16*)lds; LAS bf16* Vs = (LAS bf16*)(lds + 256 * PITCH * 2); LAS float* tb = (LAS float*)(lds + 2 * 256 * PITCH * 2);
#pragma unroll
    for (int it = 0; it < NIT; ++it) { const int idx = tid + 512 * it, kk = idx / CPR, cc = idx % CPR;
        *(LAS v4u*)(Ks + kk * PITCH + cc * 8) = R.kx[it]; *(LAS v4u*)(Vs + kk * PITCH + cc * 8) = R.vx[it]; }
    if (DIL) { if (tid < 256) { const int dist = tid - 64; tb[tid] = (dist >= 0 && dist <= 128) ? relb[t5_bucket(dist * dil) * 24 + gh] : 0.f; } }
}
template <int HD, bool DIL>
__device__ __forceinline__ void attn_compute(LAS unsigned char* lds, const bf16x8 (&qf)[HD / 32], int kfirst, bf16* Op, size_t ostride, float* lsep, int dil, int tid, int lane, int wave) {
    constexpr int PITCH = HD + 8, KST = HD / 32, NDT = HD / 16, NT = DIL ? 10 : 16, NK2 = NT / 2;
    const int ntb = DIL ? (wave & ~1) : 0;
    LAS bf16* Ks = (LAS bf16*)lds; LAS bf16* Vs = (LAS bf16*)(lds + 256 * PITCH * 2); LAS float* tb = (LAS float*)(lds + 2 * 256 * PITCH * 2);
    const int fr = lane & 15, fq = lane >> 4;
    const int qi = 16 * wave + fr;
    f32x4 sacc[NT];
#pragma unroll
    for (int nt = 0; nt < NT; ++nt) { f32x4 acc = {0.f, 0.f, 0.f, 0.f};
#pragma unroll
        for (int ks = 0; ks < KST; ++ks) { const bf16x8 kf = *(const LAS bf16x8*)(Ks + (16 * (ntb + nt) + fr) * PITCH + 32 * ks + 8 * fq); acc = MFMA16(kf, qf[ks], acc); }
        sacc[nt] = acc; }
    const LAS float* tbl = tb + (33 + qi - 16 * ntb - 4 * fq);
    float mx = -1e30f;
#pragma unroll
    for (int nt = 0; nt < NT; ++nt)
#pragma unroll
        for (int j = 0; j < 4; ++j) { float s = sacc[nt][j];
            if (DIL) { const int kk = 16 * (ntb + nt) + 4 * fq + j, dist = 128 + qi - kk; const bool ok = (dist >= 0) && (dist <= 128) && (kk >= kfirst);
                const float bv = tbl[159 - (16 * nt + j)];
                s = ok ? fmaf(s, 0.125f, bv) : -1e30f; }
            sacc[nt][j] = s; mx = fmaxf(mx, s); }
    mx = fmaxf(mx, __shfl_xor(mx, 16)); mx = fmaxf(mx, __shfl_xor(mx, 32));
    float sum = 0.f;
    bf16x8 pf[NK2];
#pragma unroll
    for (int k2 = 0; k2 < NK2; ++k2) { float p[8];
#pragma unroll
        for (int j = 0; j < 4; ++j) { p[j] = __expf(sacc[2 * k2][j] - mx); p[4 + j] = __expf(sacc[2 * k2 + 1][j] - mx); }
#pragma unroll
        for (int j = 0; j < 8; ++j) sum += p[j];
        v4u w; w.x = pk2(p[0], p[1]); w.y = pk2(p[2], p[3]); w.z = pk2(p[4], p[5]); w.w = pk2(p[6], p[7]);
        pf[k2] = __builtin_bit_cast(bf16x8, w); }
    sum += __shfl_xor(sum, 16); sum += __shfl_xor(sum, 32);
    const float inv = 1.f / sum;
    const int tq = fr >> 2, tp = fr & 3;
#pragma unroll
    for (int dt = 0; dt < NDT; ++dt) { f32x4 oacc = {0.f, 0.f, 0.f, 0.f};
#pragma unroll
        for (int k2 = 0; k2 < NK2; ++k2) {
            const v4i16_t lo = __builtin_amdgcn_ds_read_tr16_b64_v4i16((LAS v4i16_t*)(Vs + (16 * ntb + 32 * k2 + 4 * fq + tq) * PITCH + 16 * dt + 4 * tp));
            const v4i16_t hi = __builtin_amdgcn_ds_read_tr16_b64_v4i16((LAS v4i16_t*)(Vs + (16 * ntb + 32 * k2 + 16 + 4 * fq + tq) * PITCH + 16 * dt + 4 * tp));
            const bf16x8 vf = {lo[0], lo[1], lo[2], lo[3], hi[0], hi[1], hi[2], hi[3]};
            oacc = MFMA16(vf, pf[k2], oacc); }
        v2u o; o.x = pk2(oacc[0] * inv, oacc[1] * inv); o.y = pk2(oacc[2] * inv, oacc[3] * inv);
        *(v2u*)(Op + (size_t)qi * ostride + 16 * dt + 4 * fq) = o; }
    if (DIL) { if (fq == 0) lsep[(size_t)qi * 8 * dil] = mx + __logf(sum); }
    __syncthreads();
}
struct DilU { bf16* Qp; const bf16* Kp; size_t stride; float* lsep; int kfirst, dil, gh; };
__device__ __forceinline__ DilU dil_decode(int v, bf16* PROJp, float* LSEp) {
    const int h = v & 7, j32 = (v >> 3) & 31, bg = v >> 8, g = bg % 3, bl = bg / 3, dil = g == 0 ? 1 : (g == 1 ? 4 : 16), res = j32 % dil, n = j32 / dil;
    const int rq0 = bl * S + 128 * n * dil + res;
    DilU d; d.Qp = PROJp + (size_t)rq0 * INW + OFF_ATT + g * 512 + h * 64; d.Kp = d.Qp + 1536 - (ptrdiff_t)128 * dil * INW; d.stride = (size_t)dil * INW;
    d.lsep = LSEp + ((size_t)g * MH + rq0) * 8 + h; d.kfirst = n == 0 ? 128 : 0; d.dil = dil; d.gh = g * 8 + h; return d;
}
__device__ __forceinline__ const float* kin(int k) { int kk = k; asm volatile("" : "+s"(kk)); return ((const float* const __attribute__((address_space(4)))*)__builtin_amdgcn_kernarg_segment_ptr())[kk]; }
typedef __attribute__((address_space(1))) unsigned gu32;
#define XB_TMO      128
#define XB_XCNT(j)  (256  + 64 * (j))
#define XB_XSUB(j)  (1280 + 64 * (j))
#define XB_XGEN(j)  (2304 + 64 * (j))
#define XB_TOP      3328
#define XB_TOPGEN   3392
#define XCD_BAR_WORDS 3456
#define XB_SPIN_CAP (1u << 18)

__device__ __forceinline__ unsigned xb_ld(unsigned* p)              { return __hip_atomic_load(p, __ATOMIC_RELAXED, __HIP_MEMORY_SCOPE_AGENT); }
__device__ __forceinline__ unsigned xb_add(unsigned* p, unsigned v) { return __hip_atomic_fetch_add(p, v, __ATOMIC_RELAXED, __HIP_MEMORY_SCOPE_AGENT); }
__device__ __forceinline__ unsigned xb_xcc_id() { return (unsigned)__builtin_amdgcn_s_getreg((3 << 11) | 20) & 0xFu; }
#define XB_SPIN(cond, bar) do { unsigned _sp = 0; while (cond) { __builtin_amdgcn_s_sleep(1); \
    if ((++_sp & 255u) == 0u) { if (xb_ld(&(bar)[XB_TMO])) break; if (_sp > XB_SPIN_CAP) { atomicAdd(&(bar)[XB_TMO], 1u); break; } } } } while (0)

struct XcdBarrier {
    unsigned* bar; unsigned x;
    volatile LAS unsigned* st;
};

__device__ __forceinline__ XcdBarrier xcd_barrier_post(unsigned* bar, volatile LAS unsigned* st) {
    XcdBarrier b; b.bar = bar; b.x = xb_xcc_id(); b.st = st;
    if (threadIdx.x == 0) (void)xb_add(&bar[XB_XCNT(b.x)], 1u);
    return b;
}
__device__ __forceinline__ void xcd_barrier_complete(unsigned* bar, unsigned x, unsigned& nloc, unsigned& nx) {
    const unsigned G = gridDim.x * gridDim.y * gridDim.z;
    unsigned sum, cnt, mine, sp = 0u;
    for (;;) {
        sum = 0u; cnt = 0u; mine = 0u;
#pragma unroll
        for (unsigned j = 0; j < 16; ++j) { const unsigned c = xb_ld(&bar[XB_XCNT(j)]); sum += c; cnt += (c > 0u) ? 1u : 0u; mine = (j == x) ? c : mine; }
        if (sum == G) break;
        __builtin_amdgcn_s_sleep(1);
        if ((++sp & 255u) == 0u) { if (xb_ld(&bar[XB_TMO])) break; if (sp > XB_SPIN_CAP) { atomicAdd(&bar[XB_TMO], 1u); break; } }
    }
    nloc = mine > 0u ? mine : 1u; nx = cnt > 0u ? cnt : 1u;
}

__device__ __forceinline__ void xcd_barrier(const XcdBarrier& b) {
    asm volatile("s_waitcnt vmcnt(0)" ::: "memory");
    __syncthreads();
    if (threadIdx.x == 0) {
        unsigned* bar = b.bar;
        __builtin_amdgcn_s_waitcnt(0);
        unsigned nloc = b.st[0], nx = b.st[1];
        if (nloc == 0u) { xcd_barrier_complete(bar, b.x, nloc, nx); b.st[0] = nloc; b.st[1] = nx; }
        const unsigned old = xb_add(&bar[XB_XSUB(b.x)], 1u);
        const unsigned gen = old / nloc;
        if (old + 1u == (gen + 1u) * nloc) {
            __builtin_amdgcn_fence(__ATOMIC_RELEASE, "agent");
            asm volatile("s_waitcnt vmcnt(0)" ::: "memory");
            const unsigned og = xb_add(&bar[XB_TOP], 1u);
            const unsigned tg = og / nx;
            if (og + 1u == (tg + 1u) * nx) xb_add(&bar[XB_TOPGEN], 1u);
            else XB_SPIN(xb_ld(&bar[XB_TOPGEN]) == tg, bar);
            __builtin_amdgcn_fence(__ATOMIC_ACQUIRE, "agent");
            xb_add(&bar[XB_XGEN(b.x)], 1u);
            asm volatile("s_waitcnt vmcnt(0)" ::: "memory");
        } else {
            XB_SPIN(xb_ld(&bar[XB_XGEN(b.x)]) == gen, bar);
            __builtin_amdgcn_fence(__ATOMIC_ACQUIRE, "agent");
            asm volatile("s_waitcnt vmcnt(0)" ::: "memory");
        }
    }
    __syncthreads();
}

__global__ void __launch_bounds__(512, 2) mk_fwd(Args a) {
    extern __shared__ __attribute__((aligned(16))) unsigned char lds_raw[];
    cg::grid_group grid = cg::this_grid();
    LAS unsigned char* lds = (LAS unsigned char*)lds_raw;
    const int G = gridDim.x, bid = blockIdx.x, NGW = G * 8, NGT = G * 512;
#define PH_BEGIN unsigned char* ws = a.ws; asm volatile("" : "+s"(ws)); int tid = threadIdx.x; asm volatile("" : "+v"(tid)); int l = ll; asm volatile("" : "+s"(l)); \
    const int lane = tid & 63, wave = __builtin_amdgcn_readfirstlane(tid >> 6), gw = bid * 8 + wave, gt = bid * 512 + tid; (void)lane; (void)wave; (void)gw; (void)gt; (void)l; (void)ws;
#define WP(T, off) ((T*)(ws + (off)))
#define WIN_T WP(bf16, WS_WIN)
#define WUP_T WP(bf16, WS_WUP)
#define WOUT_T WP(bf16, WS_WOUT)
#define WCQ_T WP(bf16, WS_WCQ)
#define WCKV_T WP(bf16, WS_WCKV)
#define WCO_T WP(bf16, WS_WCO)
#define WFF1_T WP(bf16, WS_WFF1)
#define WFF2_T WP(bf16, WS_WFF2)
#define WGLU_T WP(bf16, WS_WGLU)
#define POOLT WP(bf16, WS_POOLT)
#define WST WP(bf16, WS_WST)
#define AB WP(float, WS_AB)
#define BBT WP(bf16, WS_BBT)
#define CM WP(bf16, WS_CM)
#define MEMN WP(bf16, WS_MEMN)
#define KV WP(bf16, WS_KV)
#define LSE WP(float, WS_LSE)
#define Hn WP(bf16, WS_H)
#define MERGED WP(bf16, WS_MERGED)
#define TOT WP(float, WS_TOT)
#define BR WP(bf16, WS_BR)
#define PROJ WP(bf16, WS_PROJ)
#define Y WP(bf16, WS_Y)
#define Qb WP(bf16, WS_Q)
#define Ob WP(bf16, WS_O)
#define HID WP(bf16, WS_HID)
#define YFF WP(bf16, WS_YFF)
#define X (a.out)
#define IN(k) kin(k)
    volatile LAS unsigned* MISC = (volatile LAS unsigned*)(lds + LDS_BYTES - 64);
    if (threadIdx.x < 16) MISC[threadIdx.x] = 0u;
    __syncthreads();
    XcdBarrier xb = xcd_barrier_post((unsigned*)(a.ws + WS_CTL) + 4096, MISC + 8);
    grid.sync();
    for (int ll = 0; ll < DEPTH; ++ll) {
        { PH_BEGIN
            LAS float* scr = (LAS float*)(lds + wave * 16384);
            const float* w_in = IN(I_WIN) + (size_t)l * D * INW; const float* w_up = IN(I_WUP) + (size_t)l * 4 * 512 * 1024; const float* w_out = IN(I_WOUT) + (size_t)l * D * D;
            const float* w_cq = IN(I_WCQ) + (size_t)l * D * 512; const float* w_ckv = IN(I_WCKV) + (size_t)l * D * 1024; const float* w_co = IN(I_WCO) + (size_t)l * 512 * D;
            const float* w_ff1 = IN(I_WFF1) + (size_t)l * D * DFF; const float* w_ff2 = IN(I_WFF2) + (size_t)l * DFF * D; const float* w_glu = IN(I_WGLU) + (size_t)l * 512 * 512;
            const float* pool_w = IN(I_POOLW) + (size_t)l * 4 * 128 * 128;
            constexpr int N_WIN = (D / 64) * (INW / 32), N_UP = (512 / 64) * (1024 / 32), N_OUT = (D / 64) * (D / 32), N_CQ = (D / 64) * (512 / 32), N_CKV = (D / 64) * (1024 / 32),
                          N_CO = (512 / 64) * (D / 32), N_FF1 = (D / 64) * (DFF / 32), N_FF2 = (DFF / 64) * (D / 32), N_GLU = (512 / 64) * (512 / 32), N_POOL = (128 / 64) * (128 / 32);
            constexpr int NITEMS = N_WIN + 4 * N_UP + N_OUT + N_CQ + N_CKV + N_CO + N_FF1 + N_FF2 + N_GLU + 4 * N_POOL;
            for (int it = gw; it < NITEMS; it += NGW) {
                int r = it;
                if (r < N_WIN) { tr_item(w_in, D, INW, WIN_T, scr, r, lane); continue; } r -= N_WIN;
                if (r < 4 * N_UP) { const int i = r / N_UP; tr_item(w_up + (size_t)i * 512 * 1024, 512, 1024, WUP_T + (size_t)i * 1024 * 512, scr, r % N_UP, lane); continue; } r -= 4 * N_UP;
                if (r < N_OUT) { tr_item(w_out, D, D, WOUT_T, scr, r, lane); continue; } r -= N_OUT;
                if (r < N_CQ) { tr_item(w_cq, D, 512, WCQ_T, scr, r, lane); continue; } r -= N_CQ;
                if (r < N_CKV) { tr_item(w_ckv, D, 1024, WCKV_T, scr, r, lane); continue; } r -= N_CKV;
                if (r < N_CO) { tr_item(w_co, 512, D, WCO_T, scr, r, lane); continue; } r -= N_CO;
                if (r < N_FF1) { tr_item(w_ff1, D, DFF, WFF1_T, scr, r, lane); continue; } r -= N_FF1;
                if (r < N_FF2) { tr_item(w_ff2, DFF, D, WFF2_T, scr, r, lane); continue; } r -= N_FF2;
                if (r < N_GLU) { tr_item(w_glu, 512, 512, WGLU_T, scr, r, lane); continue; } r -= N_GLU;
                { const int i = r / N_POOL; tr_item(pool_w + (size_t)i * 128 * 128, 128, 128, POOLT + (size_t)i * 128 * 128, scr, r % N_POOL, lane); }
            }
            const float* w_s = IN(I_WS) + (size_t)l * 4 * 128 * 128;
            for (int e = gt; e < 4 * 128 * 128; e += NGT) { const int t = (e >> 7) & 127, s = e & 127; WST[e] = (s <= t) ? (bf16)f2bf(w_s[e]) : (bf16)0; }
            for (int e = gt; e < 32 * 64; e += NGT) {
                const int g = e >> 6, p = e & 63;
                const float are = fminf(IN(I_ARE)[(size_t)l * 2048 + e], -1e-4f), aim = IN(I_AIM)[(size_t)l * 2048 + e];
                const double lr = (double)are, li = (double)aim, dt = dexp((double)IN(I_LOGDT)[l * 32 + g]);
                const double mag = dexp_small(lr * dt); double sn, cs; dsincos(li * dt, sn, cs);
                const double abr = mag * cs, abi = mag * sn, den = lr * lr + li * li;
                const double fr_ = ((abr - 1.0) * lr + abi * li) / den, fi_ = (abi * lr - (abr - 1.0) * li) / den;
                AB[e * 2] = (float)abr; AB[e * 2 + 1] = (float)abi;
                const float* br_ = IN(I_BRE) + ((size_t)l * 2048 + e) * 16; const float* bi_ = IN(I_BIM) + ((size_t)l * 2048 + e) * 16;
                for (int c = 0; c < 16; ++c) { const double brc = br_[c], bic = bi_[c];
                    BBT[(g * 128 + p) * 16 + c] = (bf16)f2bf((float)(fr_ * brc - fi_ * bic)); BBT[(g * 128 + 64 + p) * 16 + c] = (bf16)f2bf((float)(fr_ * bic + fi_ * brc));
                    CM[(g * 16 + c) * 128 + p] = (bf16)f2bf(IN(I_CRE)[((size_t)l * 512 + g * 16 + c) * 64 + p]); CM[(g * 16 + c) * 128 + 64 + p] = (bf16)f2bf(-IN(I_CIM)[((size_t)l * 512 + g * 16 + c) * 64 + p]); }
            }
            for (int row = gw; row < NB * NMEM; row += NGW) rms_row_bf16(IN(I_MEM) + (size_t)row * D, IN(I_GMEM) + (size_t)l * D, MEMN + (size_t)row * D, lane);
            if (l == 0) for (int row = gw; row < M; row += NGW) rms_row_bf16(IN(I_X) + (size_t)row * D, IN(I_GMIXPRE), Hn + (size_t)row * D, lane);
        }
        xcd_barrier(xb);
        { PH_BEGIN
          pg8::Gemm g{MEMN, WCKV_T, NB * NMEM, 1024, D, D}; pg8::StaticOrder So; So.init(NB * NMEM, 1024, G, (bid + G / 2) % G);
          pg8::EpiPlain<0> E{KV, 1024, 1.f};
          pg8::gemm_phase<pg8::EpiPlain<0>, pg8::StaticOrder, true, true>(lds, g, So, E); }
        for (int hh = 0; hh < 2; ++hh) {
            { PH_BEGIN int hf = hh; asm volatile("" : "+s"(hf));
              pg8::Gemm g{Hn + (size_t)hf * MH * D, WIN_T, MH, INW, D, D}; pg8::StaticOrder So; So.init(MH, INW, G, bid);
              pg8::EpiProj E{PROJ, IN(I_GATEB) + (size_t)l * 4 * D};
              pg8::gemm_phase<pg8::EpiProj, pg8::StaticOrder, true, true>(lds, g, So, E); }
            xcd_barrier(xb);
            { PH_BEGIN int hf = hh; asm volatile("" : "+s"(hf));
                unsigned* ctr = (unsigned*)(ws + WS_CTL) + 8192 + (l * 2 + hf) * 64;
                volatile LAS int* nxt = (volatile LAS int*)(lds + LDS_BYTES - 64 + 16);
                if (tid == 0) { nxt[0] = (int)atomicAdd(ctr, 1u); nxt[1] = (int)atomicAdd(ctr, 1u); }
                __syncthreads();
                int u = nxt[0], un = nxt[1];
                __syncthreads();
                while (u < 1152) {
                    unsigned unn = 0u; if (tid == 0) unn = atomicAdd(ctr, 1u);
                    if (u < 128) ssm_unit(lds, PROJ, AB, BBT, CM, IN(I_DSKIP) + (size_t)l * 512, u, tid, lane, wave);
                    else if (u < 640) sgu_unit(lds, PROJ, WST, IN(I_LNG) + (size_t)l * 512, IN(I_LNB) + (size_t)l * 512, IN(I_BS) + (size_t)l * 512, BR + (size_t)3 * MH * 512, u - 128, tid, lane, wave);
                    else pool_unit(lds, PROJ, POOLT, IN(I_POOLS) + (size_t)l * 512, BR, u - 640, tid, lane, wave);
                    if (tid == 0) nxt[0] = (int)unn;
                    __syncthreads();
                    u = un; un = nxt[0];
                    __syncthreads();
                }
                if (u < 4224) {
                    AttnRegs<64> R;
                    { const DilU d = dil_decode(u - 1152, PROJ, LSE); attn_issue<64>(R, d.Qp, d.stride, d.Kp, d.Kp + 1536, d.stride, d.kfirst, tid, lane, wave); }
                    while (u < 4224) {
                        unsigned unn = 0u; if (tid == 0) unn = atomicAdd(ctr, 1u);
                        const DilU d = dil_decode(u - 1152, PROJ, LSE);
                        attn_stage<64, true>(lds, R, IN(I_RELB), d.dil, d.gh, tid);
                        bf16x8 qf[2] = {R.qf[0], R.qf[1]};
                        __syncthreads();
                        if (un < 4224) { const DilU dn = dil_decode(un - 1152, PROJ, LSE); attn_issue<64>(R, dn.Qp, dn.stride, dn.Kp, dn.Kp + 1536, dn.stride, dn.kfirst, tid, lane, wave); }
                        attn_compute<64, true>(lds, qf, d.kfirst, d.Qp, d.stride, d.lsep, d.dil, tid, lane, wave);
                        if (tid == 0) nxt[0] = (int)unn;
                        __syncthreads();
                        u = un; un = nxt[0];
                        __syncthreads();
                    }
                }
            }
            xcd_barrier(xb);
            { PH_BEGIN
                attn_merge(PROJ, LSE, BR + (size_t)1 * MH * 512, gt, NGT);
                pg8::Gemm g{PROJ + OFF_SSM, WGLU_T, MH, 512, 512, INW}; pg8::StaticOrder So; So.init(MH, 512, G, bid);
                pg8::EpiGlu E{PROJ, BR + (size_t)2 * MH * 512, IN(I_BGLU) + (size_t)l * 512};
                pg8::gemm_phase<pg8::EpiGlu, pg8::StaticOrder, true, true>(lds, g, So, E);
            }
            xcd_barrier(xb);
            { PH_BEGIN int hf = hh; asm volatile("" : "+s"(hf));
              pg8::Gemm g{BR, WUP_T, 4 * MH, 4 * 1024, 512, 512}; pg8::BranchOrder So{G, bid};
              pg8::EpiGateChain E{PROJ, MERGED + (size_t)hf * MH * D};
              pg8::gemm_phase<pg8::EpiGateChain, pg8::BranchOrder, true, true>(lds, g, So, E); }
            xcd_barrier(xb);
        }
        { PH_BEGIN
          pg8::Gemm g{MERGED, WOUT_T, M, D, D, D}; pg8::StaticOrder So; So.init(M, D, G, bid);
          pg8::EpiPlain<0> E{Y, D, 1.f};
          pg8::gemm_phase<pg8::EpiPlain<0>, pg8::StaticOrder, true, true>(lds, g, So, E); }
        xcd_barrier(xb);
        { PH_BEGIN rowpass(l == 0 ? IN(I_X) : X, Y, IN(I_GMIXPOST) + (size_t)l * D, IN(I_GXPRE) + (size_t)l * D, X, Hn, gw, NGW, lane); }
        xcd_barrier(xb);
        { PH_BEGIN
          pg8::Gemm g{Hn, WCQ_T, M, 512, D, D}; pg8::StaticOrder So; So.init(M, 512, G, bid);
          pg8::EpiPlain<0> E{Qb, 512, 0.08838834764831845f};
          pg8::gemm_phase<pg8::EpiPlain<0>, pg8::StaticOrder, true, true>(lds, g, So, E); }
        xcd_barrier(xb);
        { PH_BEGIN
          for (int bu = bid; bu < 256; bu += G) {
              const int bh = bu >> 3, b = bh >> 2, h = bh & 3, tile0 = b * 32 + (bu & 7) * 4;
              const bf16* Kp = KV + (size_t)b * NMEM * 1024 + h * 128;
              bf16x8 qf[4];
              { AttnRegs<128> R; attn_issue<128>(R, Qb + (size_t)tile0 * 128 * 512 + h * 128, 512, Kp, Kp + 512, 1024, 0, tid, lane, wave);
                attn_stage<128, false>(lds, R, nullptr, 1, 0, tid);
#pragma unroll
                for (int ks = 0; ks < 4; ++ks) qf[ks] = R.qf[ks]; }
              __syncthreads();
              for (int k = 0; k < 4; ++k) { const int tile = tile0 + k, tn = tile0 + min(k + 1, 3);
                  bf16x8 qn[4];
#pragma unroll
                  for (int ks = 0; ks < 4; ++ks) qn[ks] = *(const bf16x8*)(Qb + (size_t)(tn * 128 + 16 * wave + (lane & 15)) * 512 + h * 128 + 32 * ks + 8 * (lane >> 4));
                  attn_compute<128, false>(lds, qf, 0, Ob + (size_t)tile * 128 * 512 + h * 128, 512, nullptr, 1, tid, lane, wave);
#pragma unroll
                  for (int ks = 0; ks < 4; ++ks) qf[ks] = qn[ks]; } } }
        xcd_barrier(xb);
        { PH_BEGIN
          pg8::Gemm g{Ob, WCO_T, M, D, 512, 512}; pg8::StaticOrder So; So.init(M, D, G, bid);
          pg8::EpiPlain<0> E{Y, D, 1.f};
          pg8::gemm_phase<pg8::EpiPlain<0>, pg8::StaticOrder, true, true>(lds, g, So, E); }
        xcd_barrier(xb);
        { PH_BEGIN rowpass(X, Y, IN(I_GXPOST) + (size_t)l * D, IN(I_GFFPRE) + (size_t)l * D, X, Hn, gw, NGW, lane); }
        xcd_barrier(xb);
        { PH_BEGIN
          pg8::Gemm g{Hn, WFF1_T, M, DFF, D, D}; pg8::StaticOrder So; So.init(M, DFF, G, bid);
          pg8::EpiPlain<1> E{HID, DFF, 1.f};
          pg8::gemm_phase<pg8::EpiPlain<1>, pg8::StaticOrder, true, true>(lds, g, So, E); }
        xcd_barrier(xb);
        { PH_BEGIN
          pg8::Gemm g{HID, WFF2_T, M, D, DFF, DFF}; pg8::StaticOrder So; So.init(M, D, G, bid);
          pg8::EpiPlain<0> E{YFF, D, 1.f};
          pg8::gemm_phase<pg8::EpiPlain<0>, pg8::StaticOrder, true, true>(lds, g, So, E); }
        xcd_barrier(xb);
        { PH_BEGIN rowpass(X, YFF, IN(I_GFFPOST) + (size_t)l * D, (l + 1 < DEPTH) ? IN(I_GMIXPRE) + (size_t)(l + 1) * D : nullptr, X, Hn, gw, NGW, lane); }
        xcd_barrier(xb);
    }
}

extern "C" void kernel_launch(void* const* d_in, const int* in_sizes, int n_in, void* d_out, int out_size, void* d_ws, size_t ws_size, hipStream_t stream) {
    static int grid = 0;
    if (grid == 0) {
        if (n_in != 35 || in_sizes[0] != M * D || out_size != M * D || ws_size < WS_END) { fprintf(stderr, "kernel_launch: unexpected problem (n_in %d, ws %zu, need %zu)\n", n_in, ws_size, (size_t)WS_END); grid = -1; return; }
        int dev = 0, cus = 0, per_cu = 0;
        (void)hipGetDevice(&dev); (void)hipDeviceGetAttribute(&cus, hipDeviceAttributeMultiprocessorCount, dev);
        if (hipFuncSetAttribute((const void*)mk_fwd, hipFuncAttributeMaxDynamicSharedMemorySize, LDS_BYTES) != hipSuccess) { fprintf(stderr, "kernel_launch: hipFuncSetAttribute failed\n"); grid = -1; return; }
        if (hipOccupancyMaxActiveBlocksPerMultiprocessor(&per_cu, (const void*)mk_fwd, 512, LDS_BYTES) != hipSuccess || per_cu < 1) per_cu = 1;
        (void)hipGetLastError();
        grid = cus * 1;
        if (grid <= 0) grid = 256;
    }
    if (grid < 0) return;
    if (hipMemsetAsync((char*)d_ws + WS_CTL, 0, 65536, stream) != hipSuccess) { fprintf(stderr, "memset failed\n"); return; }
    Args a{};
    for (int i = 0; i < 35; ++i) a.in[i] = (const float*)d_in[i];
    a.out = (float*)d_out; a.ws = (unsigned char*)d_ws;
    void* args[] = {&a};
    hipError_t e = hipLaunchCooperativeKernel((const void*)mk_fwd, dim3(grid), dim3(512), args, LDS_BYTES, stream);
    if (e != hipSuccess) fprintf(stderr, "cooperative launch failed: %s (grid %d)\n", hipGetErrorString(e), grid);
}
```

```cpp
#include <hip/hip_runtime.h>
#include <hip/hip_cooperative_groups.h>
#include <cstdio>
#include <cstdint>
namespace cg = cooperative_groups;

constexpr int NB = 8, S = 4096, D = 1024, M = NB * S, MH = M / 2, DEPTH = 4, NMEM = 256;
constexpr int INW = 10752, OFF_ATT = 512, OFF_SSM = 5120, OFF_SGU = 5632, OFF_GATE = 6656;
constexpr int DFF = 4096;
constexpr float EPS = 1e-6f;

namespace pg8 {
#define PG8_LAS __attribute__((address_space(3)))
typedef unsigned short bf16_t;
typedef short bf16x8 __attribute__((ext_vector_type(8)));
typedef float f32x4 __attribute__((ext_vector_type(4)));
typedef unsigned u32x4 __attribute__((ext_vector_type(4)));
constexpr int BM = 256, BK = 64, HALF = 128, HTB = HALF * BK * 2  , STAGE_BYTES = 8 * HTB, NXCD = 8, WGM = 8;

__host__ __device__ __forceinline__ int lds_byte(int r, int c) { const int st = (r >> 4) * 2 + (c >> 5), rr = r & 15, cc = c & 31, ob = rr * 64 + cc * 2; return st * 1024 + (ob ^ (((ob >> 9) & 1) << 5)); }
__host__ __device__ __forceinline__ void stage_rc(int b, int& R, int& C) { const int st = b / 1024, sb = b % 1024, swz = sb ^ (((sb >> 9) & 1) << 5); R = (st >> 1) * 16 + swz / 64; C = (st & 1) * 32 + (swz % 64) / 2; }
__host__ __device__ __forceinline__ int perm32(int rho) { const int n = rho >> 4, i = rho & 15; return 8 * (i >> 2) + 4 * n + (i & 3); }

struct Unit { int pm, pn; };
struct Gemm { const bf16_t* A; const bf16_t* Bt; int M, N, K, lda; };

struct StaticOrder {
    int nM, nN, nwg, G, c;
    __host__ __device__ void init(int M, int N, int G_, int c_) { nM = M / BM; nN = N / BM; nwg = nM * nN; G = G_; c = c_; }
    __host__ __device__ bool next(int i, Unit& u) const {
        const long L = (long)i * G + c; if (L >= nwg) return false;
        int wgid = (int)L; { const int q = nwg / NXCD, r = nwg % NXCD, xcd = wgid % NXCD, off = wgid / NXCD; wgid = (xcd < r ? xcd * (q + 1) : r * (q + 1) + (xcd - r) * q) + off; }
        const int nig = WGM * nN, gid = wgid / nig, fm = gid * WGM, gsz = (nM - fm) < WGM ? (nM - fm) : WGM;
        u.pm = fm + ((wgid % nig) % gsz); u.pn = (wgid % nig) / gsz; return true;
    }
    __device__ __forceinline__ void a_ready(const Unit&) const {}
    __device__ __forceinline__ void done(const Unit&) const {}
};
__device__ __forceinline__ unsigned cvt_pk_bf16(float lo, float hi) { unsigned r; asm volatile("v_cvt_pk_bf16_f32 %0, %1, %2" : "=v"(r) : "v"(lo), "v"(hi)); return r; }
__device__ __forceinline__ float bflo(unsigned w) { return __builtin_bit_cast(float, w << 16); }
__device__ __forceinline__ float bfhi(unsigned w) { return __builtin_bit_cast(float, w & 0xffff0000u); }
__device__ __forceinline__ float sigm(float x) { return __builtin_amdgcn_rcpf(1.f + __expf(-x)); }
__device__ __forceinline__ float gelu_t(float x) { const float z = 1.5957691216057308f * (x + 0.044715f * x * x * x); return x * __builtin_amdgcn_rcpf(1.f + __expf(-z)); }

#define EPI_ARGS const f32x4 (&acc)[2][2][4][2], const Unit& u, int wr, int wc, int fr, int fq
#define EPI_FOR_ROWS _Pragma("unroll") for (int ai = 0; ai < 2; ++ai) _Pragma("unroll") for (int m = 0; m < 4; ++m)
#define EPI_FOR_BJ _Pragma("unroll") for (int bj = 0; bj < 2; ++bj)

struct EpiProj {
    static constexpr bool PERM = true, AFTER_DRAIN = false, CHAIN = false;
    bf16_t* O; const float* gb;
    __device__ __forceinline__ void operator()(EPI_ARGS) const {
        const int colt = u.pn * BM; const int mode = colt >= OFF_GATE ? 2 : (colt >= OFF_SGU ? 1 : 0);
        const int col0 = colt + wc * 32 + 8 * fq;
        f32x4 bv[2][2];
        EPI_FOR_BJ { _Pragma("unroll") for (int n = 0; n < 2; ++n) bv[bj][n] = (mode == 2) ? *(const f32x4*)(gb + (col0 - OFF_GATE) + bj * HALF + 4 * n) : (f32x4){0.f, 0.f, 0.f, 0.f}; }
        EPI_FOR_ROWS { const int row = u.pm * BM + ai * HALF + wr * 64 + m * 16 + fr; bf16_t* rowp = O + (size_t)row * INW + col0;
            EPI_FOR_BJ { f32x4 v0 = acc[ai][bj][m][0] + bv[bj][0], v1 = acc[ai][bj][m][1] + bv[bj][1];
                if (mode == 2) { _Pragma("unroll") for (int j = 0; j < 4; ++j) { v0[j] = sigm(v0[j]); v1[j] = sigm(v1[j]); } }
                else if (mode == 1) { _Pragma("unroll") for (int j = 0; j < 4; ++j) { v0[j] = gelu_t(v0[j]); v1[j] = gelu_t(v1[j]); } }
                u32x4 w; w.x = cvt_pk_bf16(v0[0], v0[1]); w.y = cvt_pk_bf16(v0[2], v0[3]); w.z = cvt_pk_bf16(v1[0], v1[1]); w.w = cvt_pk_bf16(v1[2], v1[3]);
                *(u32x4*)(rowp + bj * HALF) = w; } }
    }
};
template <int ACT  > struct EpiPlain {
    static constexpr bool PERM = true, AFTER_DRAIN = false, CHAIN = false;
    bf16_t* O; int ldc; float scale;
    __device__ __forceinline__ void operator()(EPI_ARGS) const {
        const int col0 = u.pn * BM + wc * 32 + 8 * fq;
        EPI_FOR_ROWS { const int row = u.pm * BM + ai * HALF + wr * 64 + m * 16 + fr; bf16_t* rowp = O + (size_t)row * ldc + col0;
            EPI_FOR_BJ { f32x4 v0 = acc[ai][bj][m][0], v1 = acc[ai][bj][m][1];
                if (ACT == 1) { _Pragma("unroll") for (int j = 0; j < 4; ++j) { const float a = fmaxf(v0[j], 0.f), b = fmaxf(v1[j], 0.f); v0[j] = a * a; v1[j] = b * b; } }
                v0 = v0 * scale; v1 = v1 * scale;
                u32x4 w; w.x = cvt_pk_bf16(v0[0], v0[1]); w.y = cvt_pk_bf16(v0[2], v0[3]); w.z = cvt_pk_bf16(v1[0], v1[1]); w.w = cvt_pk_bf16(v1[2], v1[3]);
                *(u32x4*)(rowp + bj * HALF) = w; } }
    }
};
struct EpiGlu {
    static constexpr bool PERM = true, AFTER_DRAIN = false, CHAIN = false;
    const bf16_t* G; bf16_t* O; const float* bias;
    __device__ __forceinline__ void operator()(EPI_ARGS) const {
        const int col0 = u.pn * BM + wc * 32 + 8 * fq;
        f32x4 bv[2][2];
        EPI_FOR_BJ { _Pragma("unroll") for (int n = 0; n < 2; ++n) bv[bj][n] = *(const f32x4*)(bias + col0 + bj * HALF + 4 * n); }
        EPI_FOR_ROWS { const int row = u.pm * BM + ai * HALF + wr * 64 + m * 16 + fr;
            EPI_FOR_BJ { const u32x4 gw = *(const u32x4*)(G + (size_t)row * INW + OFF_SSM + col0 + bj * HALF);
                f32x4 v0 = acc[ai][bj][m][0] + bv[bj][0], v1 = acc[ai][bj][m][1] + bv[bj][1];
                v0[0] = bflo(gw.x) * sigm(v0[0]); v0[1] = bfhi(gw.x) * sigm(v0[1]); v0[2] = bflo(gw.y) * sigm(v0[2]); v0[3] = bfhi(gw.y) * sigm(v0[3]);
                v1[0] = bflo(gw.z) * sigm(v1[0]); v1[1] = bfhi(gw.z) * sigm(v1[1]); v1[2] = bflo(gw.w) * sigm(v1[2]); v1[3] = bfhi(gw.w) * sigm(v1[3]);
                u32x4 w; w.x = cvt_pk_bf16(v0[0], v0[1]); w.y = cvt_pk_bf16(v0[2], v0[3]); w.z = cvt_pk_bf16(v1[0], v1[1]); w.w = cvt_pk_bf16(v1[2], v1[3]);
                *(u32x4*)(O + (size_t)row * 512 + col0 + bj * HALF) = w; } }
    }
};
struct EpiGateAcc {
    static constexpr bool PERM = true, AFTER_DRAIN = false, CHAIN = false;
    const bf16_t* P; float* TOT; bf16_t* O;
    __device__ __forceinline__ void operator()(EPI_ARGS) const {
        const int br = u.pn >> 2, pn = u.pn & 3, pm = u.pm & 63;
        const int col0 = pn * BM + wc * 32 + 8 * fq;
        EPI_FOR_ROWS { const int row = pm * BM + ai * HALF + wr * 64 + m * 16 + fr;
            EPI_FOR_BJ { const int col = col0 + bj * HALF;
                const u32x4 gw = *(const u32x4*)(P + (size_t)row * INW + OFF_GATE + br * 1024 + col);
                float* tp = TOT + (size_t)row * 1024 + col;
                f32x4 t0 = {0.f, 0.f, 0.f, 0.f}, t1 = {0.f, 0.f, 0.f, 0.f};
                if (br > 0) { t0 = *(const f32x4*)tp; t1 = *(const f32x4*)(tp + 4); }
                const f32x4 v0 = acc[ai][bj][m][0], v1 = acc[ai][bj][m][1];
                t0[0] += bflo(gw.x) * v0[0]; t0[1] += bfhi(gw.x) * v0[1]; t0[2] += bflo(gw.y) * v0[2]; t0[3] += bfhi(gw.y) * v0[3];
                t1[0] += bflo(gw.z) * v1[0]; t1[1] += bfhi(gw.z) * v1[1]; t1[2] += bflo(gw.w) * v1[2]; t1[3] += bfhi(gw.w) * v1[3];
                if (br < 3) { *(f32x4*)tp = t0; *(f32x4*)(tp + 4) = t1; }
                else { u32x4 w; w.x = cvt_pk_bf16(t0[0], t0[1]); w.y = cvt_pk_bf16(t0[2], t0[3]); w.z = cvt_pk_bf16(t1[0], t1[1]); w.w = cvt_pk_bf16(t1[2], t1[3]);
                    *(u32x4*)(O + (size_t)row * 1024 + col) = w; } } }
    }
};
struct EpiF32 {
    static constexpr bool PERM = false, AFTER_DRAIN = false, CHAIN = false;
    float* Y; int ldc;
    __device__ __forceinline__ void operator()(EPI_ARGS) const {
        const int col0 = u.pn * BM + wc * 32 + 4 * fq;
        EPI_FOR_ROWS { const int row = u.pm * BM + ai * HALF + wr * 64 + m * 16 + fr; float* rowp = Y + (size_t)row * ldc + col0;
            EPI_FOR_BJ { _Pragma("unroll") for (int n = 0; n < 2; ++n) *(f32x4*)(rowp + bj * HALF + n * 16) = acc[ai][bj][m][n]; } }
    }
};
struct EpiGateChain {
    static constexpr bool PERM = true, AFTER_DRAIN = false, CHAIN = true;
    const bf16_t* P; bf16_t* O;
    __device__ __forceinline__ void operator()(f32x4 (&acc)[2][2][4][2], const Unit& u, int wr, int wc, int fr, int fq) const {
        const int br = u.pn >> 2, pn = u.pn & 3, pm = u.pm & 63;
        const int col0 = pn * BM + wc * 32 + 8 * fq;
        const int noff = br < 3 ? 1024 : 0;
        EPI_FOR_ROWS { const int row = pm * BM + ai * HALF + wr * 64 + m * 16 + fr;
            const bf16_t* gp = P + (size_t)row * INW + OFF_GATE + br * 1024 + col0;
            u32x4 gc[2], gn[2];
            EPI_FOR_BJ { gc[bj] = *(const u32x4*)(gp + bj * HALF); gn[bj] = *(const u32x4*)(gp + noff + bj * HALF); }
            EPI_FOR_BJ { f32x4 v0 = acc[ai][bj][m][0], v1 = acc[ai][bj][m][1];
                v0[0] *= bflo(gc[bj].x); v0[1] *= bfhi(gc[bj].x); v0[2] *= bflo(gc[bj].y); v0[3] *= bfhi(gc[bj].y);
                v1[0] *= bflo(gc[bj].z); v1[1] *= bfhi(gc[bj].z); v1[2] *= bflo(gc[bj].w); v1[3] *= bfhi(gc[bj].w);
                if (br < 3) {
                    v0[0] *= __builtin_amdgcn_rcpf(fmaxf(bflo(gn[bj].x), 1e-30f)); v0[1] *= __builtin_amdgcn_rcpf(fmaxf(bfhi(gn[bj].x), 1e-30f)); v0[2] *= __builtin_amdgcn_rcpf(fmaxf(bflo(gn[bj].y), 1e-30f)); v0[3] *= __builtin_amdgcn_rcpf(fmaxf(bfhi(gn[bj].y), 1e-30f));
                    v1[0] *= __builtin_amdgcn_rcpf(fmaxf(bflo(gn[bj].z), 1e-30f)); v1[1] *= __builtin_amdgcn_rcpf(fmaxf(bfhi(gn[bj].z), 1e-30f)); v1[2] *= __builtin_amdgcn_rcpf(fmaxf(bflo(gn[bj].w), 1e-30f)); v1[3] *= __builtin_amdgcn_rcpf(fmaxf(bfhi(gn[bj].w), 1e-30f));
                    acc[ai][bj][m][0] = v0; acc[ai][bj][m][1] = v1; }
                else { u32x4 w; w.x = cvt_pk_bf16(v0[0], v0[1]); w.y = cvt_pk_bf16(v0[2], v0[3]); w.z = cvt_pk_bf16(v1[0], v1[1]); w.w = cvt_pk_bf16(v1[2], v1[3]);
                    *(u32x4*)(O + (size_t)row * 1024 + col0 + bj * HALF) = w;
                    acc[ai][bj][m][0] = (f32x4){0.f, 0.f, 0.f, 0.f}; acc[ai][bj][m][1] = (f32x4){0.f, 0.f, 0.f, 0.f}; } } }
    }
};
struct BranchOrder {
    int G, c;
    __device__ bool next(int i, Unit& u) const { const int r = i >> 2, br = i & 3, T = r * G + c; if (T >= 256) return false; u.pm = br * 64 + (T >> 2); u.pn = br * 4 + (T & 3); return true; }
    __device__ __forceinline__ void a_ready(const Unit&) const {}
    __device__ __forceinline__ void done(const Unit&) const {}
};
template <class Epi, class Sched, bool ALIGN_EPI = false, bool SP2 = false>
__device__ __forceinline__ void gemm_phase(PG8_LAS unsigned char* lds, const Gemm g, const Sched& S, const Epi& E) {
    int tid_ = threadIdx.x; asm volatile("" : "+v"(tid_)); const int tid = tid_, wid = __builtin_amdgcn_readfirstlane(tid >> 6), lane = tid & 63, wr = wid >> 2, wc = wid & 3, fr = lane & 15, fq = lane >> 4;
    const int K = g.K, nt = K / BK;
    unsigned voffA[2], voffB[2];
#pragma unroll
    for (int i = 0; i < 2; ++i) { int R, C; stage_rc(tid * 16 + i * 8192, R, C); const int Rb = Epi::PERM ? ((R & ~31) + perm32(R & 31)) : R;
        voffA[i] = (unsigned)(R * g.lda + C) * 2u; voffB[i] = (unsigned)(Rb * K + C) * 2u; }
    const size_t kstep = (size_t)(BK * 2);
    const size_t hstepA = (size_t)HALF * g.lda * 2, hstepB = (size_t)HALF * K * 2;
    const size_t tstepA = 2 * hstepA, tstepB = 2 * hstepB;
    const unsigned ldsw = (unsigned)wid * 1024u;
    const int aoff = lds_byte(wr * 64 + fr, fq * 8), boff = lds_byte(wc * 32 + fr, fq * 8);
#define PG8_SA(b, h) (((b) * 2 + (h)) * HTB)
#define PG8_SB(b, h) ((4 + (b) * 2 + (h)) * HTB)
#define PG8_STAGE(bufoff, gbase, voff) do { _Pragma("unroll") for (int _i = 0; _i < 2; ++_i) \
        __builtin_amdgcn_global_load_lds((const unsigned*)((const char*)(gbase) + (voff)[_i]), (PG8_LAS unsigned*)(lds + (bufoff) + ldsw + _i * 8192), 16, 0, 0); } while (0)
#define PG8_LDA(dst, b, h) do { _Pragma("unroll") for (int m = 0; m < 4; ++m) _Pragma("unroll") for (int k = 0; k < 2; ++k) dst[m][k] = *(const PG8_LAS bf16x8*)(lds + PG8_SA(b, h) + aoff + m * 2048 + k * 1024); } while (0)
#define PG8_LDB(dst, b, h) do { _Pragma("unroll") for (int n = 0; n < 2; ++n) _Pragma("unroll") for (int k = 0; k < 2; ++k) dst[n][k] = *(const PG8_LAS bf16x8*)(lds + PG8_SB(b, h) + boff + n * 2048 + k * 1024); } while (0)
#define PG8_MMA(ai, bj, At, Bt) do { __builtin_amdgcn_s_setprio(1); _Pragma("unroll") for (int m = 0; m < 4; ++m) _Pragma("unroll") for (int n = 0; n < 2; ++n) _Pragma("unroll") for (int k = 0; k < 2; ++k) \
        acc[ai][bj][m][n] = __builtin_amdgcn_mfma_f32_16x16x32_bf16(Bt[n][k], At[m][k], acc[ai][bj][m][n], 0, 0, 0); __builtin_amdgcn_s_setprio(0); } while (0)
#define PG8_WAIT_V(n) asm volatile("s_waitcnt vmcnt(" #n ")" ::: "memory")
#define PG8_WAIT_L(n) asm volatile("s_waitcnt lgkmcnt(" #n ")" ::: "memory")
#define PG8_BAR __builtin_amdgcn_s_barrier()
#define PG8_SCHED __builtin_amdgcn_sched_barrier(0)
    Unit cur, nxt; int ui = 0;
    if (!S.next(0, cur)) return;
    f32x4 acc[2][2][4][2];
#pragma unroll
    for (int a = 0; a < 2; ++a)
#pragma unroll
        for (int b = 0; b < 2; ++b)
#pragma unroll
            for (int m = 0; m < 4; ++m)
#pragma unroll
                for (int n = 0; n < 2; ++n) acc[a][b][m][n] = (f32x4){0.f, 0.f, 0.f, 0.f};
    bf16x8 At[4][2], B0[2][2], B1[2][2];
    const char* cA = (const char*)g.A + (size_t)cur.pm * tstepA; const char* cB = (const char*)g.Bt + (size_t)cur.pn * tstepB;
    S.a_ready(cur);
    if constexpr (SP2) {
        PG8_STAGE(PG8_SB(0, 0), cB, voffB); PG8_STAGE(PG8_SB(0, 1), cB + hstepB, voffB); PG8_STAGE(PG8_SA(0, 0), cA, voffA); PG8_STAGE(PG8_SA(0, 1), cA + hstepA, voffA);
        if (wr == 1) PG8_BAR;
        PG8_WAIT_V(2); PG8_BAR;
        PG8_STAGE(PG8_SB(1, 0), cB + kstep, voffB); PG8_STAGE(PG8_SA(1, 0), cA + kstep, voffA); PG8_STAGE(PG8_SB(1, 1), cB + hstepB + kstep, voffB);
        PG8_WAIT_V(6); PG8_BAR;
    } else {
        PG8_STAGE(PG8_SB(0, 0), cB, voffB); PG8_STAGE(PG8_SA(0, 0), cA, voffA); PG8_STAGE(PG8_SB(0, 1), cB + hstepB, voffB); PG8_STAGE(PG8_SA(0, 1), cA + hstepA, voffA);
        if (wr == 1) PG8_BAR;
        PG8_WAIT_V(4); PG8_BAR;
        PG8_STAGE(PG8_SB(1, 0), cB + kstep, voffB); PG8_STAGE(PG8_SA(1, 0), cA + kstep, voffA); PG8_STAGE(PG8_SB(1, 1), cB + hstepB + kstep, voffB);
        PG8_WAIT_V(6); PG8_BAR;
    }
    for (;;) {
        const bool has_next = S.next(ui + 1, nxt);
        const char* nA = has_next ? (const char*)g.A + (size_t)nxt.pm * tstepA : cA; const char* nB = has_next ? (const char*)g.Bt + (size_t)nxt.pn * tstepB : cB;
        for (int t = 0; t < nt; t += 2) {
            const bool last = (t == nt - 2);
            const char* a1 = cA + (size_t)(t + 1) * kstep;
            const char* a2 = last ? nA : cA + (size_t)(t + 2) * kstep; const char* b2 = last ? nB : cB + (size_t)(t + 2) * kstep;
            const char* a3 = a2 + kstep; const char* b3 = b2 + kstep;
            if (last && has_next) S.a_ready(nxt);
            if constexpr (SP2) {
            PG8_LDB(B0, 0, 0); PG8_LDB(B1, 0, 1); PG8_SCHED; PG8_LDA(At, 0, 0); PG8_STAGE(PG8_SA(1, 1), a1 + hstepA, voffA);
            PG8_WAIT_V(8); PG8_WAIT_L(0); PG8_BAR; PG8_MMA(0, 0, At, B0); PG8_MMA(0, 1, At, B1); PG8_BAR; PG8_SCHED;
            PG8_LDA(At, 0, 1); PG8_STAGE(PG8_SB(0, 0), b2, voffB); PG8_STAGE(PG8_SB(0, 1), b2 + hstepB, voffB); PG8_STAGE(PG8_SA(0, 0), a2, voffA);
            PG8_WAIT_V(8); PG8_WAIT_L(0); PG8_BAR; PG8_MMA(1, 0, At, B0); PG8_MMA(1, 1, At, B1); PG8_BAR; PG8_SCHED;
            PG8_LDB(B0, 1, 0); PG8_LDB(B1, 1, 1); PG8_SCHED; PG8_LDA(At, 1, 0); PG8_STAGE(PG8_SA(0, 1), a2 + hstepA, voffA);
            PG8_WAIT_V(8); PG8_WAIT_L(0); PG8_BAR; PG8_MMA(0, 0, At, B0); PG8_MMA(0, 1, At, B1); PG8_BAR; PG8_SCHED;
            PG8_LDA(At, 1, 1); PG8_STAGE(PG8_SB(1, 0), b3, voffB); PG8_STAGE(PG8_SB(1, 1), b3 + hstepB, voffB); PG8_STAGE(PG8_SA(1, 0), a3, voffA);
            PG8_WAIT_V(8); PG8_WAIT_L(0); PG8_BAR; PG8_MMA(1, 0, At, B0); PG8_MMA(1, 1, At, B1); PG8_BAR; PG8_SCHED;
            } else {
            PG8_LDB(B0, 0, 0); PG8_SCHED; PG8_LDA(At, 0, 0); PG8_STAGE(PG8_SA(1, 1), a1 + hstepA, voffA);
            PG8_WAIT_L(8); PG8_BAR; PG8_WAIT_L(0); PG8_MMA(0, 0, At, B0); PG8_BAR; PG8_SCHED;
            PG8_LDB(B1, 0, 1); PG8_STAGE(PG8_SB(0, 0), b2, voffB);
            PG8_BAR; PG8_WAIT_L(0); PG8_MMA(0, 1, At, B1); PG8_BAR;
            PG8_LDA(At, 0, 1); PG8_STAGE(PG8_SA(0, 0), a2, voffA);
            PG8_BAR; PG8_WAIT_L(0); PG8_MMA(1, 0, At, B0); PG8_BAR; PG8_SCHED;
            PG8_STAGE(PG8_SB(0, 1), b2 + hstepB, voffB);
            PG8_WAIT_V(6); PG8_BAR; PG8_MMA(1, 1, At, B1); PG8_BAR;
            PG8_LDB(B0, 1, 0); PG8_SCHED; PG8_LDA(At, 1, 0); PG8_STAGE(PG8_SA(0, 1), a2 + hstepA, voffA);
            PG8_WAIT_L(8); PG8_BAR; PG8_WAIT_L(0); PG8_MMA(0, 0, At, B0); PG8_BAR; PG8_SCHED;
            PG8_LDB(B1, 1, 1); PG8_STAGE(PG8_SB(1, 0), b3, voffB);
            PG8_BAR; PG8_WAIT_L(0); PG8_MMA(0, 1, At, B1); PG8_BAR;
            PG8_LDA(At, 1, 1); PG8_STAGE(PG8_SA(1, 0), a3, voffA);
            PG8_BAR; PG8_WAIT_L(0); PG8_MMA(1, 0, At, B0); PG8_BAR; PG8_SCHED;
            PG8_STAGE(PG8_SB(1, 1), b3 + hstepB, voffB);
            PG8_WAIT_V(6); PG8_BAR; PG8_MMA(1, 1, At, B1); PG8_BAR;
            }
        }
        if constexpr (ALIGN_EPI) { if (wr == 0) PG8_BAR; }
        if constexpr (!Epi::AFTER_DRAIN) { E(acc, cur, wr, wc, fr, fq); S.done(cur); }
        if (!has_next) break;
        if constexpr (!Epi::CHAIN) {
#pragma unroll
        for (int a = 0; a < 2; ++a)
#pragma unroll
            for (int b = 0; b < 2; ++b)
#pragma unroll
                for (int m = 0; m < 4; ++m)
#pragma unroll
                    for (int n = 0; n < 2; ++n) acc[a][b][m][n] = (f32x4){0.f, 0.f, 0.f, 0.f};
        }
        cur = nxt; cA = nA; cB = nB; ++ui;
        if constexpr (ALIGN_EPI) { if (wr == 1) PG8_BAR; }
    }
    PG8_WAIT_V(0);
    if constexpr (!ALIGN_EPI) { if (wr == 0) PG8_BAR; }
    PG8_BAR;
    if constexpr (Epi::AFTER_DRAIN) { E.fused(acc, cur, wr, wc, fr, fq, lds, wid, lane); S.done(cur); }
#undef PG8_SA
#undef PG8_SB
#undef PG8_STAGE
#undef PG8_LDA
#undef PG8_LDB
#undef PG8_MMA
#undef PG8_WAIT_V
#undef PG8_WAIT_L
#undef PG8_BAR
#undef PG8_SCHED
}
}

constexpr size_t MiB = 1u << 20, KiB = 1u << 10;
constexpr size_t WS_CTL = 0, CTL_BYTES = 1 * MiB;
constexpr size_t WS_WIN = 1 * MiB, WS_WUP = 22 * MiB, WS_WOUT = 26 * MiB, WS_WCQ = 28 * MiB, WS_WCKV = 29 * MiB, WS_WCO = 31 * MiB, WS_WFF1 = 32 * MiB, WS_WFF2 = 40 * MiB, WS_WGLU = 48 * MiB;
constexpr size_t WS_POOLT = 48 * MiB + 512 * KiB, WS_WST = WS_POOLT + 256 * KiB, WS_AB = WS_WST + 256 * KiB, WS_BBT = WS_AB + 256 * KiB, WS_CM = WS_BBT + 256 * KiB;
constexpr size_t WS_MEMN = 50 * MiB, WS_KV = 54 * MiB, WS_LSE = 58 * MiB, WS_H = 60 * MiB, WS_MERGED = 124 * MiB, WS_TOT = 188 * MiB, WS_BR = 252 * MiB, WS_PROJ = 316 * MiB, WS_END = 652 * MiB;
constexpr size_t WS_Y = WS_PROJ, WS_Q = 444 * MiB, WS_O = 476 * MiB, WS_HID = WS_PROJ, WS_YFF = WS_MERGED;
static_assert(WS_CM + 256 * KiB <= WS_MEMN && WS_PROJ + (size_t)MH * INW * 2 <= WS_END && WS_HID + (size_t)M * DFF * 2 <= WS_END && WS_YFF + (size_t)M * D * 4 <= WS_BR, "ws map");
constexpr int LDS_BYTES = 147456;

#define LAS __attribute__((address_space(3)))
typedef unsigned short bf16;
typedef unsigned v4u __attribute__((ext_vector_type(4)));
typedef unsigned v2u __attribute__((ext_vector_type(2)));
typedef float f32x4 __attribute__((ext_vector_type(4)));
typedef short bf16x8 __attribute__((ext_vector_type(8)));
using pg8::bflo; using pg8::bfhi; using pg8::sigm; using pg8::gelu_t;
__device__ __forceinline__ unsigned f2bf(float f) { unsigned u = __builtin_bit_cast(unsigned, f); return (u + 0x7fffu + ((u >> 16) & 1u)) >> 16; }
__device__ __forceinline__ unsigned pk2(float lo, float hi) { return f2bf(lo) | (f2bf(hi) << 16); }
__device__ __forceinline__ float bf2f(bf16 b) { return __builtin_bit_cast(float, (unsigned)b << 16); }
__device__ __forceinline__ float wave_sum(float v) {
#pragma unroll
    for (int o = 1; o < 64; o <<= 1) v += __shfl_xor(v, o);
    return v;
}
#define LDS_WAIT() asm volatile("s_waitcnt lgkmcnt(0)" ::: "memory")

struct Args { const float* in[35]; float* out; unsigned char* ws; };
enum { I_X = 0, I_MEM, I_RELB, I_GMIXPRE, I_GMIXPOST, I_WIN, I_GATEB, I_POOLW, I_POOLS, I_ARE, I_AIM, I_LOGDT, I_BRE, I_BIM, I_CRE, I_CIM, I_DSKIP, I_WGLU, I_BGLU,
       I_LNG, I_LNB, I_WS, I_BS, I_WUP, I_WOUT, I_GXPRE, I_GXPOST, I_GMEM, I_WCQ, I_WCKV, I_WCO, I_GFFPRE, I_GFFPOST, I_WFF1, I_WFF2 };

__device__ __forceinline__ void tr_item(const float* W, int K, int N, bf16* WT, LAS float* scr, int item, int lane) {
    const int nblk = N / 32, kb = item / nblk, nb = item % nblk, k0 = 64 * kb, n0 = 32 * nb;
#pragma unroll 8
    for (int i = 0; i < 32; ++i) { const int kk = 2 * i + (lane >> 5); scr[kk * 33 + (lane & 31)] = W[(size_t)(k0 + kk) * N + n0 + (lane & 31)]; }
    LDS_WAIT();
    const int c = lane & 7;
#pragma unroll
    for (int j = 0; j < 4; ++j) { const int n = (lane >> 3) + 8 * j; const LAS float* s = scr + (8 * c) * 33 + n;
        v4u o; o.x = pk2(s[0 * 33], s[1 * 33]); o.y = pk2(s[2 * 33], s[3 * 33]); o.z = pk2(s[4 * 33], s[5 * 33]); o.w = pk2(s[6 * 33], s[7 * 33]);
        *(v4u*)(WT + (size_t)(n0 + n) * K + k0 + 8 * c) = o; }
    LDS_WAIT();
}
__device__ __forceinline__ void rms_row_bf16(const float* xrow, const float* g, bf16* orow, int lane) {
    const f32x4* xr = (const f32x4*)xrow + lane; const f32x4* gr = (const f32x4*)g + lane;
    f32x4 v[4]; float s = 0.f;
#pragma unroll
    for (int j = 0; j < 4; ++j) { v[j] = xr[64 * j]; s += (v[j].x * v[j].x + v[j].y * v[j].y) + (v[j].z * v[j].z + v[j].w * v[j].w); }
    const float r = rsqrtf(wave_sum(s) * (1.f / D) + EPS);
    v2u* o8 = (v2u*)orow + lane;
#pragma unroll
    for (int j = 0; j < 4; ++j) { const f32x4 gv = gr[64 * j]; v2u w; w.x = pk2(v[j].x * r * gv.x, v[j].y * r * gv.y); w.y = pk2(v[j].z * r * gv.z, v[j].w * r * gv.w); o8[64 * j] = w; }
}
__device__ __forceinline__ void rowpass(const float* Xi, const bf16* Y, const float* gpost, const float* gpre, float* Xo, bf16* Hh, int gw, int NGW, int lane) {
    constexpr int R = 4;
    f32x4 gp[4];
#pragma unroll
    for (int j = 0; j < 4; ++j) gp[j] = ((const f32x4*)gpost)[lane + 64 * j];
    for (int row0 = gw * R; row0 < M; row0 += NGW * R) {
        f32x4 y[R][4], x[R][4]; float s[R], s2[R];
#pragma unroll
        for (int q = 0; q < R; ++q) { const v2u* yr = (const v2u*)(Y + (size_t)(row0 + q) * D) + lane; const f32x4* xr = (const f32x4*)(Xi + (size_t)(row0 + q) * D) + lane;
#pragma unroll
            for (int j = 0; j < 4; ++j) { const v2u yw = yr[64 * j]; y[q][j] = (f32x4){bflo(yw.x), bfhi(yw.x), bflo(yw.y), bfhi(yw.y)}; x[q][j] = xr[64 * j]; } }
#pragma unroll
        for (int q = 0; q < R; ++q) { s[q] = 0.f;
#pragma unroll
            for (int j = 0; j < 4; ++j) s[q] += (y[q][j].x * y[q][j].x + y[q][j].y * y[q][j].y) + (y[q][j].z * y[q][j].z + y[q][j].w * y[q][j].w); }
#pragma unroll
        for (int o = 1; o < 64; o <<= 1) {
#pragma unroll
            for (int q = 0; q < R; ++q) s[q] += __shfl_xor(s[q], o); }
#pragma unroll
        for (int q = 0; q < R; ++q) { const float r = rsqrtf(s[q] * (1.f / D) + EPS); s2[q] = 0.f; f32x4* xo = (f32x4*)(Xo + (size_t)(row0 + q) * D) + lane;
#pragma unroll
            for (int j = 0; j < 4; ++j) { x[q][j] = x[q][j] + y[q][j] * r * gp[j]; xo[64 * j] = x[q][j];
                s2[q] += (x[q][j].x * x[q][j].x + x[q][j].y * x[q][j].y) + (x[q][j].z * x[q][j].z + x[q][j].w * x[q][j].w); } }
        if (gpre) {
#pragma unroll
            for (int o = 1; o < 64; o <<= 1) {
#pragma unroll
                for (int q = 0; q < R; ++q) s2[q] += __shfl_xor(s2[q], o); }
#pragma unroll
            for (int q = 0; q < R; ++q) { const float r2 = rsqrtf(s2[q] * (1.f / D) + EPS); v2u* o8 = (v2u*)(Hh + (size_t)(row0 + q) * D) + lane;
#pragma unroll
                for (int j = 0; j < 4; ++j) { const f32x4 gv = ((const f32x4*)gpre)[lane + 64 * j]; v2u w; w.x = pk2(x[q][j].x * r2 * gv.x, x[q][j].y * r2 * gv.y); w.y = pk2(x[q][j].z * r2 * gv.z, x[q][j].w * r2 * gv.w); o8[64 * j] = w; } } }
    }
}
__device__ __forceinline__ int t5_bucket(int n) {
    if (n < 16) return n;
    return 16 + (n >= 22) + (n >= 30) + (n >= 40) + (n >= 54) + (n >= 73) + (n >= 99) + (n >= 134) + (n >= 182) + (n >= 246) + (n >= 332) + (n >= 450) + (n >= 609) + (n >= 825) + (n >= 1117) + (n >= 1513);
}
__device__ __forceinline__ double dexp_small(double x) {
    double t = 1.0, s = 1.0;
#pragma unroll
    for (int k = 1; k <= 16; ++k) { t *= x / (double)k; s += t; }
    return s;
}
__device__ __forceinline__ double dexp(double x) { double e = dexp_small(x * (1.0 / 32.0)); e *= e; e *= e; e *= e; e *= e; e *= e; return e; }
__device__ __forceinline__ void dsincos(double x, double& sn, double& cs) {
    const double TWO_PI = 6.283185307179586476925286766559;
    x -= TWO_PI * __builtin_rint(x * (1.0 / TWO_PI));
    const double r = x * 0.125, r2 = r * r;
    double st = r, ct = 1.0, s = r, c = 1.0;
#pragma unroll
    for (int k = 1; k <= 8; ++k) { ct *= -r2 / (double)((2 * k - 1) * (2 * k)); st *= -r2 / (double)((2 * k) * (2 * k + 1)); c += ct; s += st; }
#pragma unroll
    for (int k = 0; k < 3; ++k) { const double s2 = 2.0 * s * c, c2 = c * c - s * s; s = s2; c = c2; }
    sn = s; cs = c;
}
typedef short v4i16_t __attribute__((ext_vector_type(4)));
#define MFMA16(bfrag, afrag, c) __builtin_amdgcn_mfma_f32_16x16x32_bf16((bfrag), (afrag), (c), 0, 0, 0)
__device__ __forceinline__ void attn_naive(bf16* P, float* LSE, const float* relb, int gw, int NGW, int lane) {
    for (int uidx = gw; uidx < MH * 24; uidx += NGW) {
        const int r = uidx / 24, gh = uidx % 24, g = gh >> 3, h = gh & 7;
        const int t = r & (S - 1), dil = g == 0 ? 1 : (g == 1 ? 4 : 16);
        const int nd = min(t / dil, 128);
        bf16* prow = P + (size_t)r * INW + OFF_ATT + g * 512 + h * 64 + lane;
        const float q = bf2f(*prow);
        float mx = -1e30f, ss = 0.f, o = 0.f;
        for (int dist = 0; dist <= nd; ++dist) {
            const bf16* kp = prow - (size_t)dist * dil * INW;
            const float kv = bf2f(kp[1536]), vv = bf2f(kp[3072]);
            const float sc = wave_sum(q * kv) * 0.125f + relb[t5_bucket(dist * dil) * 24 + gh];
            const float mn = fmaxf(mx, sc), corr = __expf(mx - mn), p = __expf(sc - mn);
            ss = ss * corr + p; o = o * corr + p * vv; mx = mn;
        }
        *prow = (bf16)f2bf(o / ss);
        if (lane == 0) LSE[((size_t)g * MH + r) * 8 + h] = mx + __logf(ss);
    }
}
__device__ __forceinline__ void attn_merge(const bf16* __restrict__ P, const float* __restrict__ LSE, bf16* __restrict__ BR1, int gt, int NGT) {
#pragma unroll 4
    for (int e = gt; e < MH * 64; e += NGT) {
        const int r = e >> 6, ch = e & 63, h = ch >> 3;
        const float l0 = LSE[((size_t)0 * MH + r) * 8 + h], l1 = LSE[((size_t)1 * MH + r) * 8 + h], l2 = LSE[((size_t)2 * MH + r) * 8 + h];
        const float mx = fmaxf(l0, fmaxf(l1, l2));
        float w0 = __expf(l0 - mx), w1 = __expf(l1 - mx), w2 = __expf(l2 - mx); const float inv = 1.f / (w0 + w1 + w2); w0 *= inv; w1 *= inv; w2 *= inv;
        const bf16* base = P + (size_t)r * INW + OFF_ATT + ch * 8;
        const v4u a0 = *(const v4u*)base, a1 = *(const v4u*)(base + 512), a2 = *(const v4u*)(base + 1024);
        v4u o;
        o.x = pk2(w0 * bflo(a0.x) + w1 * bflo(a1.x) + w2 * bflo(a2.x), w0 * bfhi(a0.x) + w1 * bfhi(a1.x) + w2 * bfhi(a2.x));
        o.y = pk2(w0 * bflo(a0.y) + w1 * bflo(a1.y) + w2 * bflo(a2.y), w0 * bfhi(a0.y) + w1 * bfhi(a1.y) + w2 * bfhi(a2.y));
        o.z = pk2(w0 * bflo(a0.z) + w1 * bflo(a1.z) + w2 * bflo(a2.z), w0 * bfhi(a0.z) + w1 * bfhi(a1.z) + w2 * bfhi(a2.z));
        o.w = pk2(w0 * bflo(a0.w) + w1 * bflo(a1.w) + w2 * bflo(a2.w), w0 * bfhi(a0.w) + w1 * bfhi(a1.w) + w2 * bfhi(a2.w));
        *(v4u*)(BR1 + (size_t)r * 512 + ch * 8) = o;
    }
}
__device__ __forceinline__ void ssm_naive(bf16* P, const float* AB, const bf16* BBT, const bf16* CM, const float* dskip, int gw, int NGW, int lane) {
    for (int uidx = gw; uidx < 4 * 32; uidx += NGW) {
        const int bl = uidx >> 5, g = uidx & 31;
        float bbr[16], bbi[16], cr[16], ci[16];
#pragma unroll
        for (int c = 0; c < 16; ++c) { bbr[c] = bf2f(BBT[(g * 128 + lane) * 16 + c]); bbi[c] = bf2f(BBT[(g * 128 + 64 + lane) * 16 + c]);
            cr[c] = bf2f(CM[(g * 16 + c) * 128 + lane]); ci[c] = bf2f(CM[(g * 16 + c) * 128 + 64 + lane]); }
        const float ar = AB[(g * 64 + lane) * 2], ai = AB[(g * 64 + lane) * 2 + 1];
        const float dsk = dskip[g * 16 + (lane & 15)];
        float hr = 0.f, hi = 0.f;
        for (int t = 0; t < S; ++t) {
            bf16* up = P + (size_t)(bl * S + t) * INW + OFF_SSM + g * 16;
            const v4u u0 = *(const v4u*)up, u1 = *(const v4u*)(up + 8);
            const float ul = bf2f(up[lane & 15]);
            float u[16] = {bflo(u0.x), bfhi(u0.x), bflo(u0.y), bfhi(u0.y), bflo(u0.z), bfhi(u0.z), bflo(u0.w), bfhi(u0.w),
                           bflo(u1.x), bfhi(u1.x), bflo(u1.y), bfhi(u1.y), bflo(u1.z), bfhi(u1.z), bflo(u1.w), bfhi(u1.w)};
            float bur = 0.f, bui = 0.f;
#pragma unroll
            for (int c = 0; c < 16; ++c) { bur += bbr[c] * u[c]; bui += bbi[c] * u[c]; }
            const float nhr = ar * hr - ai * hi + bur, nhi = ar * hi + ai * hr + bui; hr = nhr; hi = nhi;
            float ym = 0.f;
#pragma unroll
            for (int c = 0; c < 16; ++c) { const float yc = wave_sum(cr[c] * hr + ci[c] * hi); if (lane == c) ym = yc; }
            if (lane < 16) up[lane] = (bf16)f2bf(gelu_t(ym + ul * dsk));
        }
    }
}
__device__ __forceinline__ void sgu_unit(LAS unsigned char* lds, const bf16* P, const bf16* WST, const float* lng, const float* lnb, const float* bs, bf16* BR3, int unit, int tid, int lane, int wave) {
    const int g = unit & 3, n = (unit >> 2) & 31, bl = unit >> 7;
    const int r0 = bl * S + n * 128;
    LAS float* stats = (LAS float*)lds; LAS bf16* VnT = (LAS bf16*)(lds + 1024);
    const int fr = lane & 15, fq = lane >> 4, tq = fr >> 2, tp = fr & 3, t = 16 * wave + fr, nks = (wave >> 1) + 1;
    v4u xs[16], vn[4]; bf16x8 wf[4]; v2u uw[8];
#pragma unroll
    for (int rr = 0; rr < 16; ++rr) xs[rr] = *(const v4u*)(P + (size_t)(r0 + 16 * wave + rr) * INW + OFF_SGU + 512 + lane * 8);
#pragma unroll
    for (int it = 0; it < 4; ++it) { const int idx = tid + 512 * it, s = idx >> 4, ch = (idx & 15) * 8; vn[it] = *(const v4u*)(P + (size_t)(r0 + s) * INW + OFF_SGU + 512 + g * 128 + ch); }
#pragma unroll
    for (int ks = 0; ks < 4; ++ks) wf[ks] = *(const bf16x8*)(WST + ((size_t)g * 128 + t) * 128 + 32 * ks + 8 * fq);
#pragma unroll
    for (int nt = 0; nt < 8; ++nt) uw[nt] = *(const v2u*)(P + (size_t)(r0 + t) * INW + OFF_SGU + g * 128 + 16 * nt + 4 * fq);
    const float bst = bs[g * 128 + t];
#pragma unroll
    for (int rr = 0; rr < 16; ++rr) { const int row = 16 * wave + rr; const v4u x = xs[rr];
        float v[8] = {bflo(x.x), bfhi(x.x), bflo(x.y), bfhi(x.y), bflo(x.z), bfhi(x.z), bflo(x.w), bfhi(x.w)};
        float s = 0.f;
#pragma unroll
        for (int j = 0; j < 8; ++j) s += v[j];
        const float mean = wave_sum(s) * (1.f / 512.f); float q = 0.f;
#pragma unroll
        for (int j = 0; j < 8; ++j) { const float d = v[j] - mean; q += d * d; }
        const float rstd = rsqrtf(wave_sum(q) * (1.f / 512.f) + EPS);
        if (lane == 0) { stats[row * 2] = mean; stats[row * 2 + 1] = rstd; } }
    __syncthreads();
#pragma unroll
    for (int it = 0; it < 4; ++it) { const int idx = tid + 512 * it, s = idx >> 4, ch = (idx & 15) * 8;
        const v4u x = vn[it];
        const float mean = stats[s * 2], rstd = stats[s * 2 + 1];
        float v[8] = {bflo(x.x), bfhi(x.x), bflo(x.y), bfhi(x.y), bflo(x.z), bfhi(x.z), bflo(x.w), bfhi(x.w)};
        const f32x4 g0 = *(const f32x4*)(lng + g * 128 + ch), g1 = *(const f32x4*)(lng + g * 128 + ch + 4), b0 = *(const f32x4*)(lnb + g * 128 + ch), b1 = *(const f32x4*)(lnb + g * 128 + ch + 4);
#pragma unroll
        for (int j = 0; j < 4; ++j) { v[j] = (v[j] - mean) * rstd * g0[j] + b0[j]; v[4 + j] = (v[4 + j] - mean) * rstd * g1[j] + b1[j]; }
        v4u w; w.x = pk2(v[0], v[1]); w.y = pk2(v[2], v[3]); w.z = pk2(v[4], v[5]); w.w = pk2(v[6], v[7]);
        *(LAS v4u*)(VnT + s * 136 + ch) = w;
    }
    __syncthreads();
    { f32x4 acc[8];
#pragma unroll
      for (int nt = 0; nt < 8; ++nt) acc[nt] = (f32x4){0.f, 0.f, 0.f, 0.f};
#pragma unroll
      for (int ks = 0; ks < 4; ++ks) if (ks < nks) {
#pragma unroll
          for (int nt = 0; nt < 8; ++nt) {
              const v4i16_t lo = __builtin_amdgcn_ds_read_tr16_b64_v4i16((LAS v4i16_t*)(VnT + (32 * ks + 8 * fq + tq) * 136 + 16 * nt + 4 * tp));
              const v4i16_t hi = __builtin_amdgcn_ds_read_tr16_b64_v4i16((LAS v4i16_t*)(VnT + (32 * ks + 8 * fq + 4 + tq) * 136 + 16 * nt + 4 * tp));
              const bf16x8 vf = {lo[0], lo[1], lo[2], lo[3], hi[0], hi[1], hi[2], hi[3]};
              acc[nt] = MFMA16(vf, wf[ks], acc[nt]); } }
#pragma unroll
      for (int nt = 0; nt < 8; ++nt) { const int c = 16 * nt + 4 * fq;
          v2u o; o.x = pk2(bflo(uw[nt].x) * (acc[nt][0] + bst), bfhi(uw[nt].x) * (acc[nt][1] + bst)); o.y = pk2(bflo(uw[nt].y) * (acc[nt][2] + bst), bfhi(uw[nt].y) * (acc[nt][3] + bst));
          *(v2u*)(BR3 + (size_t)(r0 + t) * 512 + g * 128 + c) = o; } }
    __syncthreads();
}
__device__ __forceinline__ void pool_unit(LAS unsigned char* lds, const bf16* P, const bf16* poolt, const float* pscale, bf16* BR0, int unit, int tid, int lane, int wave) {
    const int gi = unit & 3, tt = (unit >> 2) & 31, bl = unit >> 7;
    const int t0 = tt * 128, r0 = bl * S + t0, w = 2 << gi;
    LAS bf16* raw = (LAS bf16*)lds; LAS bf16* Pt = (LAS bf16*)(lds + 36864);
    const int fr = lane & 15, fq = lane >> 4;
    v4u rx[5];
#pragma unroll
    for (int it = 0; it < 5; ++it) { const int idx = tid + 512 * it, j = idx >> 4, ch = (idx & 15) * 8;
        rx[it] = (v4u){0u, 0u, 0u, 0u};
        if (idx < 144 * 16 && t0 - 16 + j >= 0) rx[it] = *(const v4u*)(P + (size_t)(r0 - 16 + j) * INW + gi * 128 + ch); }
    bf16x8 wfa[2][8];
#pragma unroll
    for (int ks = 0; ks < 2; ++ks)
#pragma unroll
        for (int nt = 0; nt < 8; ++nt) wfa[ks][nt] = *(const bf16x8*)(poolt + ((size_t)gi * 128 + 16 * nt + fr) * 128 + 32 * ks + 8 * fq);
#pragma unroll
    for (int it = 0; it < 5; ++it) { const int idx = tid + 512 * it, j = idx >> 4, ch = (idx & 15) * 8; if (idx < 144 * 16) *(LAS v4u*)(raw + j * 128 + ch) = rx[it]; }
    __syncthreads();
    { const int c = tid & 127, tq = tid >> 7, tb0 = tq * 32; const float rc = 1.f / (float)w;
      float s = 0.f;
      for (int j = 0; j < w; ++j) s += bf2f(raw[(16 + tb0 - j) * 128 + c]);
      for (int i = 0; i < 32; ++i) { const int t = tb0 + i; const int cnt = min(t0 + t + 1, w);
          const float cur = bf2f(raw[(16 + t) * 128 + c]);
          const float mean = (cnt == w) ? s * rc : s / (float)cnt;
          Pt[t * 136 + c] = (bf16)f2bf(mean - cur);
          s += bf2f(raw[(17 + t) * 128 + c]) - bf2f(raw[(17 + t - w) * 128 + c]); } }
    __syncthreads();
    { const int t = 16 * wave + fr;
      f32x4 acc[8];
#pragma unroll
      for (int nt = 0; nt < 8; ++nt) acc[nt] = (f32x4){0.f, 0.f, 0.f, 0.f};
#pragma unroll
      for (int ks = 0; ks < 4; ++ks) { const bf16x8 pf = *(const LAS bf16x8*)(Pt + t * 136 + 32 * ks + 8 * fq);
#pragma unroll
          for (int nt = 0; nt < 8; ++nt) { const bf16x8 wf = ks < 2 ? wfa[ks & 1][nt] : *(const bf16x8*)(poolt + ((size_t)gi * 128 + 16 * nt + fr) * 128 + 32 * ks + 8 * fq); acc[nt] = MFMA16(wf, pf, acc[nt]); } }
#pragma unroll
      for (int nt = 0; nt < 8; ++nt) { const int d = 16 * nt + 4 * fq; const f32x4 sc = *(const f32x4*)(pscale + gi * 128 + d);
          v2u o; o.x = pk2(acc[nt][0] * sc[0], acc[nt][1] * sc[1]); o.y = pk2(acc[nt][2] * sc[2], acc[nt][3] * sc[3]);
          *(v2u*)(BR0 + (size_t)(r0 + t) * 512 + gi * 128 + d) = o; } }
    __syncthreads();
}
__device__ __forceinline__ void xattn_naive(const bf16* Q, const bf16* KV, bf16* O, int gw, int NGW, int lane) {
    for (int uidx = gw; uidx < M * 4; uidx += NGW) {
        const int T = uidx >> 2, h = uidx & 3, b = T / S;
        const unsigned qw = *(const unsigned*)(Q + (size_t)T * 512 + h * 128 + 2 * lane);
        const float q0 = bflo(qw), q1 = bfhi(qw);
        float mx = -1e30f, ss = 0.f, o0 = 0.f, o1 = 0.f;
        for (int j = 0; j < NMEM; ++j) {
            const bf16* kr = KV + (size_t)(b * NMEM + j) * 1024 + h * 128 + 2 * lane;
            const unsigned kw = *(const unsigned*)kr, vw = *(const unsigned*)(kr + 512);
            const float sc = wave_sum(q0 * bflo(kw) + q1 * bfhi(kw));
            const float mn = fmaxf(mx, sc), corr = __expf(mx - mn), p = __expf(sc - mn);
            ss = ss * corr + p; o0 = o0 * corr + p * bflo(vw); o1 = o1 * corr + p * bfhi(vw); mx = mn;
        }
        const float inv = 1.f / ss;
        *(unsigned*)(O + (size_t)T * 512 + h * 128 + 2 * lane) = pk2(o0 * inv, o1 * inv);
    }
}
__device__ __forceinline__ void ssm_unit(LAS unsigned char* lds, bf16* P, const float* ABp, const bf16* BBTp, const bf16* CMp, const float* dskip, int unit, int tid, int lane, int wave) {
    const int bl = unit >> 5, g = unit & 31, fr = lane & 15, fq = lane >> 4;
    LAS float* bu = (LAS float*)(lds + wave * 16896);
    LAS bf16* hb = (LAS bf16*)(lds + wave * 16896);
    LAS float* ends = (LAS float*)(lds + 135168);
    const bf16x8 z8 = {0, 0, 0, 0, 0, 0, 0, 0};
    bf16x8 bbf[8], cmf[4];
#pragma unroll
    for (int nt = 0; nt < 8; ++nt) bbf[nt] = fq < 2 ? *(const bf16x8*)(BBTp + (size_t)(g * 128 + 16 * nt + fr) * 16 + 8 * fq) : z8;
#pragma unroll
    for (int ks = 0; ks < 4; ++ks) cmf[ks] = *(const bf16x8*)(CMp + (size_t)(g * 16 + fr) * 128 + 32 * ks + 8 * fq);
    const float ar = ABp[(g * 64 + lane) * 2], ai = ABp[(g * 64 + lane) * 2 + 1];
    float pr = ar, pi = ai;
#pragma unroll
    for (int i = 0; i < 5; ++i) { const float nr = pr * pr - pi * pi, ni = 2.f * pr * pi; pr = nr; pi = ni; }
    const f32x4 dsk = *(const f32x4*)(dskip + g * 16 + 4 * fq);
    float cr = 0.f, ci = 0.f;
    bf16x8 uf[2]; v2u uep[2], uepn[2];
#pragma unroll
    for (int mt = 0; mt < 2; ++mt) { const bf16* up = P + (size_t)(bl * S + wave * 32 + 16 * mt + fr) * INW + OFF_SSM + g * 16;
        uf[mt] = fq < 2 ? *(const bf16x8*)(up + 8 * fq) : z8; uep[mt] = *(const v2u*)(up + 4 * fq); }
    for (int ms = 0; ms < 16; ++ms) {
        const int rbase = bl * S + ms * 256 + wave * 32;
#pragma unroll
        for (int mt = 0; mt < 2; ++mt)
#pragma unroll
            for (int nt = 0; nt < 8; ++nt) { f32x4 acc = {0.f, 0.f, 0.f, 0.f}; acc = MFMA16(bbf[nt], uf[mt], acc);
                *(LAS f32x4*)(bu + (16 * mt + fr) * 132 + 16 * nt + 4 * fq) = acc; }
        { const int rn = bl * S + min(ms + 1, 15) * 256 + wave * 32;
#pragma unroll
          for (int mt = 0; mt < 2; ++mt) { const bf16* up = P + (size_t)(rn + 16 * mt + fr) * INW + OFF_SSM + g * 16;
              uf[mt] = fq < 2 ? *(const bf16x8*)(up + 8 * fq) : z8; uepn[mt] = *(const v2u*)(up + 4 * fq); } }
        LDS_WAIT();
        float hr = 0.f, hi = 0.f;
#pragma unroll 8
        for (int t = 0; t < 32; ++t) { const float br = bu[t * 132 + lane], bi = bu[t * 132 + 64 + lane];
            const float nhr = ar * hr - ai * hi + br, nhi = ar * hi + ai * hr + bi; hr = nhr; hi = nhi; }
        ends[wave * 128 + lane] = hr; ends[wave * 128 + 64 + lane] = hi;
        __syncthreads();
        float sr = cr, si = ci, myr = cr, myi = ci;
#pragma unroll
        for (int w = 0; w < 8; ++w) { if (w == wave) { myr = sr; myi = si; }
            const float er = ends[w * 128 + lane], ei = ends[w * 128 + 64 + lane];
            const float nsr = pr * sr - pi * si + er, nsi = pr * si + pi * sr + ei; sr = nsr; si = nsi; }
        cr = sr; ci = si;
        hr = myr; hi = myi;
#pragma unroll 8
        for (int t = 0; t < 32; ++t) { const float br = bu[t * 132 + lane], bi = bu[t * 132 + 64 + lane];
            const float nhr = ar * hr - ai * hi + br, nhi = ar * hi + ai * hr + bi; hr = nhr; hi = nhi;
            asm volatile("" ::: "memory");
            hb[t * 136 + lane] = (bf16)f2bf(hr); hb[t * 136 + 64 + lane] = (bf16)f2bf(hi);
            asm volatile("" ::: "memory"); }
        LDS_WAIT();
#pragma unroll
        for (int mt = 0; mt < 2; ++mt) { f32x4 acc = {0.f, 0.f, 0.f, 0.f};
#pragma unroll
            for (int ks = 0; ks < 4; ++ks) { const bf16x8 hf_ = *(const LAS bf16x8*)(hb + (16 * mt + fr) * 136 + 32 * ks + 8 * fq); acc = MFMA16(cmf[ks], hf_, acc); }
            const float y0 = gelu_t(acc[0] + bflo(uep[mt].x) * dsk[0]), y1 = gelu_t(acc[1] + bfhi(uep[mt].x) * dsk[1]);
            const float y2 = gelu_t(acc[2] + bflo(uep[mt].y) * dsk[2]), y3 = gelu_t(acc[3] + bfhi(uep[mt].y) * dsk[3]);
            v2u o; o.x = pk2(y0, y1); o.y = pk2(y2, y3);
            *(v2u*)(P + (size_t)(rbase + 16 * mt + fr) * INW + OFF_SSM + g * 16 + 4 * fq) = o; }
        uep[0] = uepn[0]; uep[1] = uepn[1];
        __syncthreads();
    }
}
template <int HD> struct AttnRegs { v4u kx[256 * (HD / 8) / 512], vx[256 * (HD / 8) / 512]; bf16x8 qf[HD / 32]; };
template <int HD>
__device__ __forceinline__ void attn_issue(AttnRegs<HD>& R, const bf16* Qp, size_t qstride, const bf16* Kp, const bf16* Vp, size_t kstride, int kfirst, int tid, int lane, int wave) {
    constexpr int CPR = HD / 8, NIT = 256 * CPR / 512, KST = HD / 32;
#pragma unroll
    for (int it = 0; it < NIT; ++it) { const int idx = tid + 512 * it, kk = idx / CPR, cc = idx % CPR;
        R.kx[it] = (v4u){0u, 0u, 0u, 0u}; R.vx[it] = (v4u){0u, 0u, 0u, 0u};
        if (kk >= kfirst) { R.kx[it] = *(const v4u*)(Kp + (ptrdiff_t)kk * (ptrdiff_t)kstride + cc * 8); R.vx[it] = *(const v4u*)(Vp + (ptrdiff_t)kk * (ptrdiff_t)kstride + cc * 8); } }
    const int qi = 16 * wave + (lane & 15), fq = lane >> 4;
#pragma unroll
    for (int ks = 0; ks < KST; ++ks) R.qf[ks] = *(const bf16x8*)(Qp + (size_t)qi * qstride + 32 * ks + 8 * fq);
}
template <int HD, bool DIL>
__device__ __forceinline__ void attn_stage(LAS unsigned char* lds, const AttnRegs<HD>& R, const float* relb, int dil, int gh, int tid) {
    constexpr int PITCH = HD + 8, CPR = HD / 8, NIT = 256 * CPR / 512;
    LAS bf16* Ks = (LAS bf16*)lds; LAS bf16* Vs = (LAS bf16*)(lds + 256 * PITCH * 2); LAS float* tb = (LAS float*)(lds + 2 * 256 * PITCH * 2);
#pragma unroll
    for (int it = 0; it < NIT; ++it) { const int idx = tid + 512 * it, kk = idx / CPR, cc = idx % CPR;
        *(LAS v4u*)(Ks + kk * PITCH + cc * 8) = R.kx[it]; *(LAS v4u*)(Vs + kk * PITCH + cc * 8) = R.vx[it]; }
    if (DIL) { if (tid < 256) { const int dist = tid - 64; tb[tid] = (dist >= 0 && dist <= 128) ? relb[t5_bucket(dist * dil) * 24 + gh] : 0.f; } }
}
template <int HD, bool DIL>
__device__ __forceinline__ void attn_compute(LAS unsigned char* lds, const bf16x8 (&qf)[HD / 32], int kfirst, bf16* Op, size_t ostride, float* lsep, int dil, int tid, int lane, int wave) {
    constexpr int PITCH = HD + 8, KST = HD / 32, NDT = HD / 16, NT = DIL ? 10 : 16, NK2 = NT / 2;
    const int ntb = DIL ? (wave & ~1) : 0;
    LAS bf16* Ks = (LAS bf16*)lds; LAS bf16* Vs = (LAS bf16*)(lds + 256 * PITCH * 2); LAS float* tb = (LAS float*)(lds + 2 * 256 * PITCH * 2);
    const int fr = lane & 15, fq = lane >> 4;
    const int qi = 16 * wave + fr;
    f32x4 sacc[NT];
#pragma unroll
    for (int nt = 0; nt < NT; ++nt) { f32x4 acc = {0.f, 0.f, 0.f, 0.f};
#pragma unroll
        for (int ks = 0; ks < KST; ++ks) { const bf16x8 kf = *(const LAS bf16x8*)(Ks + (16 * (ntb + nt) + fr) * PITCH + 32 * ks + 8 * fq); acc = MFMA16(kf, qf[ks], acc); }
        sacc[nt] = acc; }
    const LAS float* tbl = tb + (33 + qi - 16 * ntb - 4 * fq);
    float mx = -1e30f;
#pragma unroll
    for (int nt = 0; nt < NT; ++nt)
#pragma unroll
        for (int j = 0; j < 4; ++j) { float s = sacc[nt][j];
            if (DIL) { const int kk = 16 * (ntb + nt) + 4 * fq + j, dist = 128 + qi - kk; const bool ok = (dist >= 0) && (dist <= 128) && (kk >= kfirst);
                const float bv = tbl[159 - (16 * nt + j)];
                s = ok ? fmaf(s, 0.125f, bv) : -1e30f; }
            sacc[nt][j] = s; mx = fmaxf(mx, s); }
    mx = fmaxf(mx, __shfl_xor(mx, 16)); mx = fmaxf(mx, __shfl_xor(mx, 32));
    float sum = 0.f;
    bf16x8 pf[NK2];
#pragma unroll
    for (int k2 = 0; k2 < NK2; ++k2) { float p[8];
#pragma unroll
        for (int j = 0; j < 4; ++j) { p[j] = __expf(sacc[2 * k2][j] - mx); p[4 + j] = __expf(sacc[2 * k2 + 1][j] - mx); }
#pragma unroll
        for (int j = 0; j < 8; ++j) sum += p[j];
        v4u w; w.x = pk2(p[0], p[1]); w.y = pk2(p[2], p[3]); w.z = pk2(p[4], p[5]); w.w = pk2(p[6], p[7]);
        pf[k2] = __builtin_bit_cast(bf16x8, w); }
    sum += __shfl_xor(sum, 16); sum += __shfl_xor(sum, 32);
    const float inv = 1.f / sum;
    const int tq = fr >> 2, tp = fr & 3;
#pragma unroll
    for (int dt = 0; dt < NDT; ++dt) { f32x4 oacc = {0.f, 0.f, 0.f, 0.f};
#pragma unroll
        for (int k2 = 0; k2 < NK2; ++k2) {
            const v4i16_t lo = __builtin_amdgcn_ds_read_tr16_b64_v4i16((LAS v4i16_t*)(Vs + (16 * ntb + 32 * k2 + 4 * fq + tq) * PITCH + 16 * dt + 4 * tp));
            const v4i16_t hi = __builtin_amdgcn_ds_read_tr16_b64_v4i16((LAS v4i16_t*)(Vs + (16 * ntb + 32 * k2 + 16 + 4 * fq + tq) * PITCH + 16 * dt + 4 * tp));
            const bf16x8 vf = {lo[0], lo[1], lo[2], lo[3], hi[0], hi[1], hi[2], hi[3]};
            oacc = MFMA16(vf, pf[k2], oacc); }
        v2u o; o.x = pk2(oacc[0] * inv, oacc[1] * inv); o.y = pk2(oacc[2] * inv, oacc[3] * inv);
        *(v2u*)(Op + (size_t)qi * ostride + 16 * dt + 4 * fq) = o; }
    if (DIL) { if (fq == 0) lsep[(size_t)qi * 8 * dil] = mx + __logf(sum); }
    __syncthreads();
}
struct DilU { bf16* Qp; const bf16* Kp; size_t stride; float* lsep; int kfirst, dil, gh; };
__device__ __forceinline__ DilU dil_decode(int v, bf16* PROJp, float* LSEp) {
    const int h = v & 7, j32 = (v >> 3) & 31, bg = v >> 8, g = bg % 3, bl = bg / 3, dil = g == 0 ? 1 : (g == 1 ? 4 : 16), res = j32 % dil, n = j32 / dil;
    const int rq0 = bl * S + 128 * n * dil + res;
    DilU d; d.Qp = PROJp + (size_t)rq0 * INW + OFF_ATT + g * 512 + h * 64; d.Kp = d.Qp + 1536 - (ptrdiff_t)128 * dil * INW; d.stride = (size_t)dil * INW;
    d.lsep = LSEp + ((size_t)g * MH + rq0) * 8 + h; d.kfirst = n == 0 ? 128 : 0; d.dil = dil; d.gh = g * 8 + h; return d;
}
__device__ __forceinline__ const float* kin(int k) { int kk = k; asm volatile("" : "+s"(kk)); return ((const float* const __attribute__((address_space(4)))*)__builtin_amdgcn_kernarg_segment_ptr())[kk]; }
typedef __attribute__((address_space(1))) unsigned gu32;
#define XB_TMO      128
#define XB_XCNT(j)  (256  + 64 * (j))
#define XB_XSUB(j)  (1280 + 64 * (j))
#define XB_XGEN(j)  (2304 + 64 * (j))
#define XB_TOP      3328
#define XB_TOPGEN   3392
#define XCD_BAR_WORDS 3456
#define XB_SPIN_CAP (1u << 18)

__device__ __forceinline__ unsigned xb_ld(unsigned* p)              { return __hip_atomic_load(p, __ATOMIC_RELAXED, __HIP_MEMORY_SCOPE_AGENT); }
__device__ __forceinline__ unsigned xb_add(unsigned* p, unsigned v) { return __hip_atomic_fetch_add(p, v, __ATOMIC_RELAXED, __HIP_MEMORY_SCOPE_AGENT); }
__device__ __forceinline__ unsigned xb_xcc_id() { return (unsigned)__builtin_amdgcn_s_getreg((3 << 11) | 20) & 0xFu; }
#define XB_SPIN(cond, bar) do { unsigned _sp = 0; while (cond) { __builtin_amdgcn_s_sleep(1); \
    if ((++_sp & 255u) == 0u) { if (xb_ld(&(bar)[XB_TMO])) break; if (_sp > XB_SPIN_CAP) { atomicAdd(&(bar)[XB_TMO], 1u); break; } } } } while (0)

struct XcdBarrier {
    unsigned* bar; unsigned x;
    volatile LAS unsigned* st;
};

__device__ __forceinline__ XcdBarrier xcd_barrier_post(unsigned* bar, volatile LAS unsigned* st) {
    XcdBarrier b; b.bar = bar; b.x = xb_xcc_id(); b.st = st;
    if (threadIdx.x == 0) (void)xb_add(&bar[XB_XCNT(b.x)], 1u);
    return b;
}
__device__ __forceinline__ void xcd_barrier_complete(unsigned* bar, unsigned x, unsigned& nloc, unsigned& nx) {
    const unsigned G = gridDim.x * gridDim.y * gridDim.z;
    unsigned sum, cnt, mine, sp = 0u;
    for (;;) {
        sum = 0u; cnt = 0u; mine = 0u;
#pragma unroll
        for (unsigned j = 0; j < 16; ++j) { const unsigned c = xb_ld(&bar[XB_XCNT(j)]); sum += c; cnt += (c > 0u) ? 1u : 0u; mine = (j == x) ? c : mine; }
        if (sum == G) break;
        __builtin_amdgcn_s_sleep(1);
        if ((++sp & 255u) == 0u) { if (xb_ld(&bar[XB_TMO])) break; if (sp > XB_SPIN_CAP) { atomicAdd(&bar[XB_TMO], 1u); break; } }
    }
    nloc = mine > 0u ? mine : 1u; nx = cnt > 0u ? cnt : 1u;
}

__device__ __forceinline__ void xcd_barrier(const XcdBarrier& b) {
    asm volatile("s_waitcnt vmcnt(0)" ::: "memory");
    __syncthreads();
    if (threadIdx.x == 0) {
        unsigned* bar = b.bar;
        __builtin_amdgcn_s_waitcnt(0);
        unsigned nloc = b.st[0], nx = b.st[1];
        if (nloc == 0u) { xcd_barrier_complete(bar, b.x, nloc, nx); b.st[0] = nloc; b.st[1] = nx; }
        const unsigned old = xb_add(&bar[XB_XSUB(b.x)], 1u);
        const unsigned gen = old / nloc;
        if (old + 1u == (gen + 1u) * nloc) {
            __builtin_amdgcn_fence(__ATOMIC_RELEASE, "agent");
            asm volatile("s_waitcnt vmcnt(0)" ::: "memory");
            const unsigned og = xb_add(&bar[XB_TOP], 1u);
            const unsigned tg = og / nx;
            if (og + 1u == (tg + 1u) * nx) xb_add(&bar[XB_TOPGEN], 1u);
            else XB_SPIN(xb_ld(&bar[XB_TOPGEN]) == tg, bar);
            __builtin_amdgcn_fence(__ATOMIC_ACQUIRE, "agent");
            xb_add(&bar[XB_XGEN(b.x)], 1u);
            asm volatile("s_waitcnt vmcnt(0)" ::: "memory");
        } else {
            XB_SPIN(xb_ld(&bar[XB_XGEN(b.x)]) == gen, bar);
            __builtin_amdgcn_fence(__ATOMIC_ACQUIRE, "agent");
            asm volatile("s_waitcnt vmcnt(0)" ::: "memory");
        }
    }
    __syncthreads();
}

__global__ void __launch_bounds__(512, 2) mk_fwd(Args a) {
    extern __shared__ __attribute__((aligned(16))) unsigned char lds_raw[];
    cg::grid_group grid = cg::this_grid();
    LAS unsigned char* lds = (LAS unsigned char*)lds_raw;
    const int G = gridDim.x, bid = blockIdx.x, NGW = G * 8, NGT = G * 512;
#define PH_BEGIN unsigned char* ws = a.ws; asm volatile("" : "+s"(ws)); int tid = threadIdx.x; asm volatile("" : "+v"(tid)); int l = ll; asm volatile("" : "+s"(l)); \
    const int lane = tid & 63, wave = __builtin_amdgcn_readfirstlane(tid >> 6), gw = bid * 8 + wave, gt = bid * 512 + tid; (void)lane; (void)wave; (void)gw; (void)gt; (void)l; (void)ws;
#define WP(T, off) ((T*)(ws + (off)))
#define WIN_T WP(bf16, WS_WIN)
#define WUP_T WP(bf16, WS_WUP)
#define WOUT_T WP(bf16, WS_WOUT)
#define WCQ_T WP(bf16, WS_WCQ)
#define WCKV_T WP(bf16, WS_WCKV)
#define WCO_T WP(bf16, WS_WCO)
#define WFF1_T WP(bf16, WS_WFF1)
#define WFF2_T WP(bf16, WS_WFF2)
#define WGLU_T WP(bf16, WS_WGLU)
#define POOLT WP(bf16, WS_POOLT)
#define WST WP(bf16, WS_WST)
#define AB WP(float, WS_AB)
#define BBT WP(bf16, WS_BBT)
#define CM WP(bf16, WS_CM)
#define MEMN WP(bf16, WS_MEMN)
#define KV WP(bf16, WS_KV)
#define LSE WP(float, WS_LSE)
#define Hn WP(bf16, WS_H)
#define MERGED WP(bf16, WS_MERGED)
#define TOT WP(float, WS_TOT)
#define BR WP(bf16, WS_BR)
#define PROJ WP(bf16, WS_PROJ)
#define Y WP(bf16, WS_Y)
#define Qb WP(bf16, WS_Q)
#define Ob WP(bf16, WS_O)
#define HID WP(bf16, WS_HID)
#define YFF WP(bf16, WS_YFF)
#define X (a.out)
#define IN(k) kin(k)
    volatile LAS unsigned* MISC = (volatile LAS unsigned*)(lds + LDS_BYTES - 64);
    if (threadIdx.x < 16) MISC[threadIdx.x] = 0u;
    __syncthreads();
    XcdBarrier xb = xcd_barrier_post((unsigned*)(a.ws + WS_CTL) + 4096, MISC + 8);
    grid.sync();
    for (int ll = 0; ll < DEPTH; ++ll) {
        { PH_BEGIN
            LAS float* scr = (LAS float*)(lds + wave * 16384);
            const float* w_in = IN(I_WIN) + (size_t)l * D * INW; const float* w_up = IN(I_WUP) + (size_t)l * 4 * 512 * 1024; const float* w_out = IN(I_WOUT) + (size_t)l * D * D;
            const float* w_cq = IN(I_WCQ) + (size_t)l * D * 512; const float* w_ckv = IN(I_WCKV) + (size_t)l * D * 1024; const float* w_co = IN(I_WCO) + (size_t)l * 512 * D;
            const float* w_ff1 = IN(I_WFF1) + (size_t)l * D * DFF; const float* w_ff2 = IN(I_WFF2) + (size_t)l * DFF * D; const float* w_glu = IN(I_WGLU) + (size_t)l * 512 * 512;
            const float* pool_w = IN(I_POOLW) + (size_t)l * 4 * 128 * 128;
            constexpr int N_WIN = (D / 64) * (INW / 32), N_UP = (512 / 64) * (1024 / 32), N_OUT = (D / 64) * (D / 32), N_CQ = (D / 64) * (512 / 32), N_CKV = (D / 64) * (1024 / 32),
                          N_CO = (512 / 64) * (D / 32), N_FF1 = (D / 64) * (DFF / 32), N_FF2 = (DFF / 64) * (D / 32), N_GLU = (512 / 64) * (512 / 32), N_POOL = (128 / 64) * (128 / 32);
            constexpr int NITEMS = N_WIN + 4 * N_UP + N_OUT + N_CQ + N_CKV + N_CO + N_FF1 + N_FF2 + N_GLU + 4 * N_POOL;
            for (int it = gw; it < NITEMS; it += NGW) {
                int r = it;
                if (r < N_WIN) { tr_item(w_in, D, INW, WIN_T, scr, r, lane); continue; } r -= N_WIN;
                if (r < 4 * N_UP) { const int i = r / N_UP; tr_item(w_up + (size_t)i * 512 * 1024, 512, 1024, WUP_T + (size_t)i * 1024 * 512, scr, r % N_UP, lane); continue; } r -= 4 * N_UP;
                if (r < N_OUT) { tr_item(w_out, D, D, WOUT_T, scr, r, lane); continue; } r -= N_OUT;
                if (r < N_CQ) { tr_item(w_cq, D, 512, WCQ_T, scr, r, lane); continue; } r -= N_CQ;
                if (r < N_CKV) { tr_item(w_ckv, D, 1024, WCKV_T, scr, r, lane); continue; } r -= N_CKV;
                if (r < N_CO) { tr_item(w_co, 512, D, WCO_T, scr, r, lane); continue; } r -= N_CO;
                if (r < N_FF1) { tr_item(w_ff1, D, DFF, WFF1_T, scr, r, lane); continue; } r -= N_FF1;
                if (r < N_FF2) { tr_item(w_ff2, DFF, D, WFF2_T, scr, r, lane); continue; } r -= N_FF2;
                if (r < N_GLU) { tr_item(w_glu, 512, 512, WGLU_T, scr, r, lane); continue; } r -= N_GLU;
                { const int i = r / N_POOL; tr_item(pool_w + (size_t)i * 128 * 128, 128, 128, POOLT + (size_t)i * 128 * 128, scr, r % N_POOL, lane); }
            }
            const float* w_s = IN(I_WS) + (size_t)l * 4 * 128 * 128;
            for (int e = gt; e < 4 * 128 * 128; e += NGT) { const int t = (e >> 7) & 127, s = e & 127; WST[e] = (s <= t) ? (bf16)f2bf(w_s[e]) : (bf16)0; }
            for (int e = gt; e < 32 * 64; e += NGT) {
                const int g = e >> 6, p = e & 63;
                const float are = fminf(IN(I_ARE)[(size_t)l * 2048 + e], -1e-4f), aim = IN(I_AIM)[(size_t)l * 2048 + e];
                const double lr = (double)are, li = (double)aim, dt = dexp((double)IN(I_LOGDT)[l * 32 + g]);
                const double mag = dexp_small(lr * dt); double sn, cs; dsincos(li * dt, sn, cs);
                const double abr = mag * cs, abi = mag * sn, den = lr * lr + li * li;
                const double fr_ = ((abr - 1.0) * lr + abi * li) / den, fi_ = (abi * lr - (abr - 1.0) * li) / den;
                AB[e * 2] = (float)abr; AB[e * 2 + 1] = (float)abi;
                const float* br_ = IN(I_BRE) + ((size_t)l * 2048 + e) * 16; const float* bi_ = IN(I_BIM) + ((size_t)l * 2048 + e) * 16;
                for (int c = 0; c < 16; ++c) { const double brc = br_[c], bic = bi_[c];
                    BBT[(g * 128 + p) * 16 + c] = (bf16)f2bf((float)(fr_ * brc - fi_ * bic)); BBT[(g * 128 + 64 + p) * 16 + c] = (bf16)f2bf((float)(fr_ * bic + fi_ * brc));
                    CM[(g * 16 + c) * 128 + p] = (bf16)f2bf(IN(I_CRE)[((size_t)l * 512 + g * 16 + c) * 64 + p]); CM[(g * 16 + c) * 128 + 64 + p] = (bf16)f2bf(-IN(I_CIM)[((size_t)l * 512 + g * 16 + c) * 64 + p]); }
            }
            for (int row = gw; row < NB * NMEM; row += NGW) rms_row_bf16(IN(I_MEM) + (size_t)row * D, IN(I_GMEM) + (size_t)l * D, MEMN + (size_t)row * D, lane);
            if (l == 0) for (int row = gw; row < M; row += NGW) rms_row_bf16(IN(I_X) + (size_t)row * D, IN(I_GMIXPRE), Hn + (size_t)row * D, lane);
        }
        xcd_barrier(xb);
        { PH_BEGIN
          pg8::Gemm g{MEMN, WCKV_T, NB * NMEM, 1024, D, D}; pg8::StaticOrder So; So.init(NB * NMEM, 1024, G, (bid + G / 2) % G);
          pg8::EpiPlain<0> E{KV, 1024, 1.f};
          pg8::gemm_phase<pg8::EpiPlain<0>, pg8::StaticOrder, true, true>(lds, g, So, E); }
        for (int hh = 0; hh < 2; ++hh) {
            { PH_BEGIN int hf = hh; asm volatile("" : "+s"(hf));
              pg8::Gemm g{Hn + (size_t)hf * MH * D, WIN_T, MH, INW, D, D}; pg8::StaticOrder So; So.init(MH, INW, G, bid);
              pg8::EpiProj E{PROJ, IN(I_GATEB) + (size_t)l * 4 * D};
              pg8::gemm_phase<pg8::EpiProj, pg8::StaticOrder, true, true>(lds, g, So, E); }
            xcd_barrier(xb);
            { PH_BEGIN int hf = hh; asm volatile("" : "+s"(hf));
                unsigned* ctr = (unsigned*)(ws + WS_CTL) + 8192 + (l * 2 + hf) * 64;
                volatile LAS int* nxt = (volatile LAS int*)(lds + LDS_BYTES - 64 + 16);
                if (tid == 0) { nxt[0] = (int)atomicAdd(ctr, 1u); nxt[1] = (int)atomicAdd(ctr, 1u); }
                __syncthreads();
                int u = nxt[0], un = nxt[1];
                __syncthreads();
                while (u < 1152) {
                    unsigned unn = 0u; if (tid == 0) unn = atomicAdd(ctr, 1u);
                    if (u < 128) ssm_unit(lds, PROJ, AB, BBT, CM, IN(I_DSKIP) + (size_t)l * 512, u, tid, lane, wave);
                    else if (u < 640) sgu_unit(lds, PROJ, WST, IN(I_LNG) + (size_t)l * 512, IN(I_LNB) + (size_t)l * 512, IN(I_BS) + (size_t)l * 512, BR + (size_t)3 * MH * 512, u - 128, tid, lane, wave);
                    else pool_unit(lds, PROJ, POOLT, IN(I_POOLS) + (size_t)l * 512, BR, u - 640, tid, lane, wave);
                    if (tid == 0) nxt[0] = (int)unn;
                    __syncthreads();
                    u = un; un = nxt[0];
                    __syncthreads();
                }
                if (u < 4224) {
                    AttnRegs<64> R;
                    { const DilU d = dil_decode(u - 1152, PROJ, LSE); attn_issue<64>(R, d.Qp, d.stride, d.Kp, d.Kp + 1536, d.stride, d.kfirst, tid, lane, wave); }
                    while (u < 4224) {
                        unsigned unn = 0u; if (tid == 0) unn = atomicAdd(ctr, 1u);
                        const DilU d = dil_decode(u - 1152, PROJ, LSE);
                        attn_stage<64, true>(lds, R, IN(I_RELB), d.dil, d.gh, tid);
                        bf16x8 qf[2] = {R.qf[0], R.qf[1]};
                        __syncthreads();
                        if (un < 4224) { const DilU dn = dil_decode(un - 1152, PROJ, LSE); attn_issue<64>(R, dn.Qp, dn.stride, dn.Kp, dn.Kp + 1536, dn.stride, dn.kfirst, tid, lane, wave); }
                        attn_compute<64, true>(lds, qf, d.kfirst, d.Qp, d.stride, d.lsep, d.dil, tid, lane, wave);
                        if (tid == 0) nxt[0] = (int)unn;
                        __syncthreads();
                        u = un; un = nxt[0];
                        __syncthreads();
                    }
                }
            }
            xcd_barrier(xb);
            { PH_BEGIN
                attn_merge(PROJ, LSE, BR + (size_t)1 * MH * 512, gt, NGT);
                pg8::Gemm g{PROJ + OFF_SSM, WGLU_T, MH, 512, 512, INW}; pg8::StaticOrder So; So.init(MH, 512, G, bid);
                pg8::EpiGlu E{PROJ, BR + (size_t)2 * MH * 512, IN(I_BGLU) + (size_t)l * 512};
                pg8::gemm_phase<pg8::EpiGlu, pg8::StaticOrder, true, true>(lds, g, So, E);
            }
            xcd_barrier(xb);
            { PH_BEGIN int hf = hh; asm volatile("" : "+s"(hf));
              pg8::Gemm g{BR, WUP_T, 4 * MH, 4 * 1024, 512, 512}; pg8::BranchOrder So{G, bid};
              pg8::EpiGateChain E{PROJ, MERGED + (size_t)hf * MH * D};
              pg8::gemm_phase<pg8::EpiGateChain, pg8::BranchOrder, true, true>(lds, g, So, E); }
            xcd_barrier(xb);
        }
        { PH_BEGIN
          pg8::Gemm g{MERGED, WOUT_T, M, D, D, D}; pg8::StaticOrder So; So.init(M, D, G, bid);
          pg8::EpiPlain<0> E{Y, D, 1.f};
          pg8::gemm_phase<pg8::EpiPlain<0>, pg8::StaticOrder, true, true>(lds, g, So, E); }
        xcd_barrier(xb);
        { PH_BEGIN rowpass(l == 0 ? IN(I_X) : X, Y, IN(I_GMIXPOST) + (size_t)l * D, IN(I_GXPRE) + (size_t)l * D, X, Hn, gw, NGW, lane); }
        xcd_barrier(xb);
        { PH_BEGIN
          pg8::Gemm g{Hn, WCQ_T, M, 512, D, D}; pg8::StaticOrder So; So.init(M, 512, G, bid);
          pg8::EpiPlain<0> E{Qb, 512, 0.08838834764831845f};
          pg8::gemm_phase<pg8::EpiPlain<0>, pg8::StaticOrder, true, true>(lds, g, So, E); }
        xcd_barrier(xb);
        { PH_BEGIN
          for (int bu = bid; bu < 256; bu += G) {
              const int bh = bu >> 3, b = bh >> 2, h = bh & 3, tile0 = b * 32 + (bu & 7) * 4;
              const bf16* Kp = KV + (size_t)b * NMEM * 1024 + h * 128;
              bf16x8 qf[4];
              { AttnRegs<128> R; attn_issue<128>(R, Qb + (size_t)tile0 * 128 * 512 + h * 128, 512, Kp, Kp + 512, 1024, 0, tid, lane, wave);
                attn_stage<128, false>(lds, R, nullptr, 1, 0, tid);
#pragma unroll
                for (int ks = 0; ks < 4; ++ks) qf[ks] = R.qf[ks]; }
              __syncthreads();
              for (int k = 0; k < 4; ++k) { const int tile = tile0 + k, tn = tile0 + min(k + 1, 3);
                  bf16x8 qn[4];
#pragma unroll
                  for (int ks = 0; ks < 4; ++ks) qn[ks] = *(const bf16x8*)(Qb + (size_t)(tn * 128 + 16 * wave + (lane & 15)) * 512 + h * 128 + 32 * ks + 8 * (lane >> 4));
                  attn_compute<128, false>(lds, qf, 0, Ob + (size_t)tile * 128 * 512 + h * 128, 512, nullptr, 1, tid, lane, wave);
#pragma unroll
                  for (int ks = 0; ks < 4; ++ks) qf[ks] = qn[ks]; } } }
        xcd_barrier(xb);
        { PH_BEGIN
          pg8::Gemm g{Ob, WCO_T, M, D, 512, 512}; pg8::StaticOrder So; So.init(M, D, G, bid);
          pg8::EpiPlain<0> E{Y, D, 1.f};
          pg8::gemm_phase<pg8::EpiPlain<0>, pg8::StaticOrder, true, true>(lds, g, So, E); }
        xcd_barrier(xb);
        { PH_BEGIN rowpass(X, Y, IN(I_GXPOST) + (size_t)l * D, IN(I_GFFPRE) + (size_t)l * D, X, Hn, gw, NGW, lane); }
        xcd_barrier(xb);
        { PH_BEGIN
          pg8::Gemm g{Hn, WFF1_T, M, DFF, D, D}; pg8::StaticOrder So; So.init(M, DFF, G, bid);
          pg8::EpiPlain<1> E{HID, DFF, 1.f};
          pg8::gemm_phase<pg8::EpiPlain<1>, pg8::StaticOrder, true, true>(lds, g, So, E); }
        xcd_barrier(xb);
        { PH_BEGIN
          pg8::Gemm g{HID, WFF2_T, M, D, DFF, DFF}; pg8::StaticOrder So; So.init(M, D, G, bid);
          pg8::EpiPlain<0> E{YFF, D, 1.f};
          pg8::gemm_phase<pg8::EpiPlain<0>, pg8::StaticOrder, true, true>(lds, g, So, E); }
        xcd_barrier(xb);
        { PH_BEGIN rowpass(X, YFF, IN(I_GFFPOST) + (size_t)l * D, (l + 1 < DEPTH) ? IN(I_GMIXPRE) + (size_t)(l + 1) * D : nullptr, X, Hn, gw, NGW, lane); }
        xcd_barrier(xb);
    }
}

extern "C" void kernel_launch(void* const* d_in, const int* in_sizes, int n_in, void* d_out, int out_size, void* d_ws, size_t ws_size, hipStream_t stream) {
    static int grid = 0;
    if (grid == 0) {
        if (n_in != 35 || in_sizes[0] != M * D || out_size != M * D || ws_size < WS_END) { fprintf(stderr, "kernel_launch: unexpected problem (n_in %d, ws %zu, need %zu)\n", n_in, ws_size, (size_t)WS_END); grid = -1; return; }
        int dev = 0, cus = 0, per_cu = 0;
        (void)hipGetDevice(&dev); (void)hipDeviceGetAttribute(&cus, hipDeviceAttributeMultiprocessorCount, dev);
        if (hipFuncSetAttribute((const void*)mk_fwd, hipFuncAttributeMaxDynamicSharedMemorySize, LDS_BYTES) != hipSuccess) { fprintf(stderr, "kernel_launch: hipFuncSetAttribute failed\n"); grid = -1; return; }
        if (hipOccupancyMaxActiveBlocksPerMultiprocessor(&per_cu, (const void*)mk_fwd, 512, LDS_BYTES) != hipSuccess || per_cu < 1) per_cu = 1;
        (void)hipGetLastError();
        grid = cus * 1;
        if (grid <= 0) grid = 256;
    }
    if (grid < 0) return;
    if (hipMemsetAsync((char*)d_ws + WS_CTL, 0, 65536, stream) != hipSuccess) { fprintf(stderr, "memset failed\n"); return; }
    Args a{};
    for (int i = 0; i < 35; ++i) a.in[i] = (const float*)d_in[i];
    a.out = (float*)d_out; a.ws = (unsigned char*)d_ws;
    void* args[] = {&a};
    hipError_t e = hipLaunchCooperativeKernel((const void*)mk_fwd, dim3(grid), dim3(512), args, LDS_BYTES, stream);
    if (e != hipSuccess) fprintf(stderr, "cooperative launch failed: %s (grid %d)\n", hipGetErrorString(e), grid);
}
```

```cpp
#include <hip/hip_runtime.h>
#include <hip/hip_cooperative_groups.h>
#include <cstdio>
#include <cstdint>
namespace cg = cooperative_groups;

constexpr int NB = 8, S = 4096, D = 1024, M = NB * S, MH = M / 2, DEPTH = 4, NMEM = 256;
constexpr int INW = 10752, OFF_ATT = 512, OFF_SSM = 5120, OFF_SGU = 5632, OFF_GATE = 6656;
constexpr int DFF = 4096;
constexpr float EPS = 1e-6f;

namespace pg8 {
#define PG8_LAS __attribute__((address_space(3)))
typedef unsigned short bf16_t;
typedef short bf16x8 __attribute__((ext_vector_type(8)));
typedef float f32x4 __attribute__((ext_vector_type(4)));
typedef unsigned u32x4 __attribute__((ext_vector_type(4)));
constexpr int BM = 256, BK = 64, HALF = 128, HTB = HALF * BK * 2  , STAGE_BYTES = 8 * HTB, NXCD = 8, WGM = 8;

__host__ __device__ __forceinline__ int lds_byte(int r, int c) { const int st = (r >> 4) * 2 + (c >> 5), rr = r & 15, cc = c & 31, ob = rr * 64 + cc * 2; return st * 1024 + (ob ^ (((ob >> 9) & 1) << 5)); }
__host__ __device__ __forceinline__ void stage_rc(int b, int& R, int& C) { const int st = b / 1024, sb = b % 1024, swz = sb ^ (((sb >> 9) & 1) << 5); R = (st >> 1) * 16 + swz / 64; C = (st & 1) * 32 + (swz % 64) / 2; }
__host__ __device__ __forceinline__ int perm32(int rho) { const int n = rho >> 4, i = rho & 15; return 8 * (i >> 2) + 4 * n + (i & 3); }

struct Unit { int pm, pn; };
struct Gemm { const bf16_t* A; const bf16_t* Bt; int M, N, K, lda; };

struct StaticOrder {
    int nM, nN, nwg, G, c;
    __host__ __device__ void init(int M, int N, int G_, int c_) { nM = M / BM; nN = N / BM; nwg = nM * nN; G = G_; c = c_; }
    __host__ __device__ bool next(int i, Unit& u) const {
        const long L = (long)i * G + c; if (L >= nwg) return false;
        int wgid = (int)L; { const int q = nwg / NXCD, r = nwg % NXCD, xcd = wgid % NXCD, off = wgid / NXCD; wgid = (xcd < r ? xcd * (q + 1) : r * (q + 1) + (xcd - r) * q) + off; }
        const int nig = WGM * nN, gid = wgid / nig, fm = gid * WGM, gsz = (nM - fm) < WGM ? (nM - fm) : WGM;
        u.pm = fm + ((wgid % nig) % gsz); u.pn = (wgid % nig) / gsz; return true;
    }
    __device__ __forceinline__ void a_ready(const Unit&) const {}
    __device__ __forceinline__ void done(const Unit&) const {}
};
__device__ __forceinline__ unsigned cvt_pk_bf16(float lo, float hi) { unsigned r; asm volatile("v_cvt_pk_bf16_f32 %0, %1, %2" : "=v"(r) : "v"(lo), "v"(hi)); return r; }
__device__ __forceinline__ float bflo(unsigned w) { return __builtin_bit_cast(float, w << 16); }
__device__ __forceinline__ float bfhi(unsigned w) { return __builtin_bit_cast(float, w & 0xffff0000u); }
__device__ __forceinline__ float sigm(float x) { return __builtin_amdgcn_rcpf(1.f + __expf(-x)); }
__device__ __forceinline__ float gelu_t(float x) { const float z = 1.5957691216057308f * (x + 0.044715f * x * x * x); return x * __builtin_amdgcn_rcpf(1.f + __expf(-z)); }

#define EPI_ARGS const f32x4 (&acc)[2][2][4][2], const Unit& u, int wr, int wc, int fr, int fq
#define EPI_FOR_ROWS _Pragma("unroll") for (int ai = 0; ai < 2; ++ai) _Pragma("unroll") for (int m = 0; m < 4; ++m)
#define EPI_FOR_BJ _Pragma("unroll") for (int bj = 0; bj < 2; ++bj)

struct EpiProj {
    static constexpr bool PERM = true, AFTER_DRAIN = false, CHAIN = false;
    bf16_t* O; const float* gb;
    __device__ __forceinline__ void operator()(EPI_ARGS) const {
        const int colt = u.pn * BM; const int mode = colt >= OFF_GATE ? 2 : (colt >= OFF_SGU ? 1 : 0);
        const int col0 = colt + wc * 32 + 8 * fq;
        f32x4 bv[2][2];
        EPI_FOR_BJ { _Pragma("unroll") for (int n = 0; n < 2; ++n) bv[bj][n] = (mode == 2) ? *(const f32x4*)(gb + (col0 - OFF_GATE) + bj * HALF + 4 * n) : (f32x4){0.f, 0.f, 0.f, 0.f}; }
        EPI_FOR_ROWS { const int row = u.pm * BM + ai * HALF + wr * 64 + m * 16 + fr; bf16_t* rowp = O + (size_t)row * INW + col0;
            EPI_FOR_BJ { f32x4 v0 = acc[ai][bj][m][0] + bv[bj][0], v1 = acc[ai][bj][m][1] + bv[bj][1];
                if (mode == 2) { _Pragma("unroll") for (int j = 0; j < 4; ++j) { v0[j] = sigm(v0[j]); v1[j] = sigm(v1[j]); } }
                else if (mode == 1) { _Pragma("unroll") for (int j = 0; j < 4; ++j) { v0[j] = gelu_t(v0[j]); v1[j] = gelu_t(v1[j]); } }
                u32x4 w; w.x = cvt_pk_bf16(v0[0], v0[1]); w.y = cvt_pk_bf16(v0[2], v0[3]); w.z = cvt_pk_bf16(v1[0], v1[1]); w.w = cvt_pk_bf16(v1[2], v1[3]);
                *(u32x4*)(rowp + bj * HALF) = w; } }
    }
};
template <int ACT  > struct EpiPlain {
    static constexpr bool PERM = true, AFTER_DRAIN = false, CHAIN = false;
    bf16_t* O; int ldc; float scale;
    __device__ __forceinline__ void operator()(EPI_ARGS) const {
        const int col0 = u.pn * BM + wc * 32 + 8 * fq;
        EPI_FOR_ROWS { const int row = u.pm * BM + ai * HALF + wr * 64 + m * 16 + fr; bf16_t* rowp = O + (size_t)row * ldc + col0;
            EPI_FOR_BJ { f32x4 v0 = acc[ai][bj][m][0], v1 = acc[ai][bj][m][1];
                if (ACT == 1) { _Pragma("unroll") for (int j = 0; j < 4; ++j) { const float a = fmaxf(v0[j], 0.f), b = fmaxf(v1[j], 0.f); v0[j] = a * a; v1[j] = b * b; } }
                v0 = v0 * scale; v1 = v1 * scale;
                u32x4 w; w.x = cvt_pk_bf16(v0[0], v0[1]); w.y = cvt_pk_bf16(v0[2], v0[3]); w.z = cvt_pk_bf16(v1[0], v1[1]); w.w = cvt_pk_bf16(v1[2], v1[3]);
                *(u32x4*)(rowp + bj * HALF) = w; } }
    }
};
struct EpiGlu {
    static constexpr bool PERM = true, AFTER_DRAIN = false, CHAIN = false;
    const bf16_t* G; bf16_t* O; const float* bias;
    __device__ __forceinline__ void operator()(EPI_ARGS) const {
        const int col0 = u.pn * BM + wc * 32 + 8 * fq;
        f32x4 bv[2][2];
        EPI_FOR_BJ { _Pragma("unroll") for (int n = 0; n < 2; ++n) bv[bj][n] = *(const f32x4*)(bias + col0 + bj * HALF + 4 * n); }
        EPI_FOR_ROWS { const int row = u.pm * BM + ai * HALF + wr * 64 + m * 16 + fr;
            EPI_FOR_BJ { const u32x4 gw = *(const u32x4*)(G + (size_t)row * INW + OFF_SSM + col0 + bj * HALF);
                f32x4 v0 = acc[ai][bj][m][0] + bv[bj][0], v1 = acc[ai][bj][m][1] + bv[bj][1];
                v0[0] = bflo(gw.x) * sigm(v0[0]); v0[1] = bfhi(gw.x) * sigm(v0[1]); v0[2] = bflo(gw.y) * sigm(v0[2]); v0[3] = bfhi(gw.y) * sigm(v0[3]);
                v1[0] = bflo(gw.z) * sigm(v1[0]); v1[1] = bfhi(gw.z) * sigm(v1[1]); v1[2] = bflo(gw.w) * sigm(v1[2]); v1[3] = bfhi(gw.w) * sigm(v1[3]);
                u32x4 w; w.x = cvt_pk_bf16(v0[0], v0[1]); w.y = cvt_pk_bf16(v0[2], v0[3]); w.z = cvt_pk_bf16(v1[0], v1[1]); w.w = cvt_pk_bf16(v1[2], v1[3]);
                *(u32x4*)(O + (size_t)row * 512 + col0 + bj * HALF) = w; } }
    }
};
struct EpiGateAcc {
    static constexpr bool PERM = true, AFTER_DRAIN = false, CHAIN = false;
    const bf16_t* P; float* TOT; bf16_t* O;
    __device__ __forceinline__ void operator()(EPI_ARGS) const {
        const int br = u.pn >> 2, pn = u.pn & 3, pm = u.pm & 63;
        const int col0 = pn * BM + wc * 32 + 8 * fq;
        EPI_FOR_ROWS { const int row = pm * BM + ai * HALF + wr * 64 + m * 16 + fr;
            EPI_FOR_BJ { const int col = col0 + bj * HALF;
                const u32x4 gw = *(const u32x4*)(P + (size_t)row * INW + OFF_GATE + br * 1024 + col);
                float* tp = TOT + (size_t)row * 1024 + col;
                f32x4 t0 = {0.f, 0.f, 0.f, 0.f}, t1 = {0.f, 0.f, 0.f, 0.f};
                if (br > 0) { t0 = *(const f32x4*)tp; t1 = *(const f32x4*)(tp + 4); }
                const f32x4 v0 = acc[ai][bj][m][0], v1 = acc[ai][bj][m][1];
                t0[0] += bflo(gw.x) * v0[0]; t0[1] += bfhi(gw.x) * v0[1]; t0[2] += bflo(gw.y) * v0[2]; t0[3] += bfhi(gw.y) * v0[3];
                t1[0] += bflo(gw.z) * v1[0]; t1[1] += bfhi(gw.z) * v1[1]; t1[2] += bflo(gw.w) * v1[2]; t1[3] += bfhi(gw.w) * v1[3];
                if (br < 3) { *(f32x4*)tp = t0; *(f32x4*)(tp + 4) = t1; }
                else { u32x4 w; w.x = cvt_pk_bf16(t0[0], t0[1]); w.y = cvt_pk_bf16(t0[2], t0[3]); w.z = cvt_pk_bf16(t1[0], t1[1]); w.w = cvt_pk_bf16(t1[2], t1[3]);
                    *(u32x4*)(O + (size_t)row * 1024 + col) = w; } } }
    }
};
struct EpiF32 {
    static constexpr bool PERM = false, AFTER_DRAIN = false, CHAIN = false;
    float* Y; int ldc;
    __device__ __forceinline__ void operator()(EPI_ARGS) const {
        const int col0 = u.pn * BM + wc * 32 + 4 * fq;
        EPI_FOR_ROWS { const int row = u.pm * BM + ai * HALF + wr * 64 + m * 16 + fr; float* rowp = Y + (size_t)row * ldc + col0;
            EPI_FOR_BJ { _Pragma("unroll") for (int n = 0; n < 2; ++n) *(f32x4*)(rowp + bj * HALF + n * 16) = acc[ai][bj][m][n]; } }
    }
};
struct EpiGateChain {
    static constexpr bool PERM = true, AFTER_DRAIN = false, CHAIN = true;
    const bf16_t* P; bf16_t* O;
    __device__ __forceinline__ void operator()(f32x4 (&acc)[2][2][4][2], const Unit& u, int wr, int wc, int fr, int fq) const {
        const int br = u.pn >> 2, pn = u.pn & 3, pm = u.pm & 63;
        const int col0 = pn * BM + wc * 32 + 8 * fq;
        const int noff = br < 3 ? 1024 : 0;
        EPI_FOR_ROWS { const int row = pm * BM + ai * HALF + wr * 64 + m * 16 + fr;
            const bf16_t* gp = P + (size_t)row * INW + OFF_GATE + br * 1024 + col0;
            u32x4 gc[2], gn[2];
            EPI_FOR_BJ { gc[bj] = *(const u32x4*)(gp + bj * HALF); gn[bj] = *(const u32x4*)(gp + noff + bj * HALF); }
            EPI_FOR_BJ { f32x4 v0 = acc[ai][bj][m][0], v1 = acc[ai][bj][m][1];
                v0[0] *= bflo(gc[bj].x); v0[1] *= bfhi(gc[bj].x); v0[2] *= bflo(gc[bj].y); v0[3] *= bfhi(gc[bj].y);
                v1[0] *= bflo(gc[bj].z); v1[1] *= bfhi(gc[bj].z); v1[2] *= bflo(gc[bj].w); v1[3] *= bfhi(gc[bj].w);
                if (br < 3) {
                    v0[0] *= __builtin_amdgcn_rcpf(fmaxf(bflo(gn[bj].x), 1e-30f)); v0[1] *= __builtin_amdgcn_rcpf(fmaxf(bfhi(gn[bj].x), 1e-30f)); v0[2] *= __builtin_amdgcn_rcpf(fmaxf(bflo(gn[bj].y), 1e-30f)); v0[3] *= __builtin_amdgcn_rcpf(fmaxf(bfhi(gn[bj].y), 1e-30f));
                    v1[0] *= __builtin_amdgcn_rcpf(fmaxf(bflo(gn[bj].z), 1e-30f)); v1[1] *= __builtin_amdgcn_rcpf(fmaxf(bfhi(gn[bj].z), 1e-30f)); v1[2] *= __builtin_amdgcn_rcpf(fmaxf(bflo(gn[bj].w), 1e-30f)); v1[3] *= __builtin_amdgcn_rcpf(fmaxf(bfhi(gn[bj].w), 1e-30f));
                    acc[ai][bj][m][0] = v0; acc[ai][bj][m][1] = v1; }
                else { u32x4 w; w.x = cvt_pk_bf16(v0[0], v0[1]); w.y = cvt_pk_bf16(v0[2], v0[3]); w.z = cvt_pk_bf16(v1[0], v1[1]); w.w = cvt_pk_bf16(v1[2], v1[3]);
                    *(u32x4*)(O + (size_t)row * 1024 + col0 + bj * HALF) = w;
                    acc[ai][bj][m][0] = (f32x4){0.f, 0.f, 0.f, 0.f}; acc[ai][bj][m][1] = (f32x4){0.f, 0.f, 0.f, 0.f}; } } }
    }
};
struct BranchOrder {
    int G, c;
    __device__ bool next(int i, Unit& u) const { const int r = i >> 2, br = i & 3, T = r * G + c; if (T >= 256) return false; u.pm = br * 64 + (T >> 2); u.pn = br * 4 + (T & 3); return true; }
    __device__ __forceinline__ void a_ready(const Unit&) const {}
    __device__ __forceinline__ void done(const Unit&) const {}
};
template <class Epi, class Sched, bool ALIGN_EPI = false, bool SP2 = false>
__device__ __forceinline__ void gemm_phase(PG8_LAS unsigned char* lds, const Gemm g, const Sched& S, const Epi& E) {
    int tid_ = threadIdx.x; asm volatile("" : "+v"(tid_)); const int tid = tid_, wid = __builtin_amdgcn_readfirstlane(tid >> 6), lane = tid & 63, wr = wid >> 2, wc = wid & 3, fr = lane & 15, fq = lane >> 4;
    const int K = g.K, nt = K / BK;
    unsigned voffA[2], voffB[2];
#pragma unroll
    for (int i = 0; i < 2; ++i) { int R, C; stage_rc(tid * 16 + i * 8192, R, C); const int Rb = Epi::PERM ? ((R & ~31) + perm32(R & 31)) : R;
        voffA[i] = (unsigned)(R * g.lda + C) * 2u; voffB[i] = (unsigned)(Rb * K + C) * 2u; }
    const size_t kstep = (size_t)(BK * 2);
    const size_t hstepA = (size_t)HALF * g.lda * 2, hstepB = (size_t)HALF * K * 2;
    const size_t tstepA = 2 * hstepA, tstepB = 2 * hstepB;
    const unsigned ldsw = (unsigned)wid * 1024u;
    const int aoff = lds_byte(wr * 64 + fr, fq * 8), boff = lds_byte(wc * 32 + fr, fq * 8);
#define PG8_SA(b, h) (((b) * 2 + (h)) * HTB)
#define PG8_SB(b, h) ((4 + (b) * 2 + (h)) * HTB)
#define PG8_STAGE(bufoff, gbase, voff) do { _Pragma("unroll") for (int _i = 0; _i < 2; ++_i) \
        __builtin_amdgcn_global_load_lds((const unsigned*)((const char*)(gbase) + (voff)[_i]), (PG8_LAS unsigned*)(lds + (bufoff) + ldsw + _i * 8192), 16, 0, 0); } while (0)
#define PG8_LDA(dst, b, h) do { _Pragma("unroll") for (int m = 0; m < 4; ++m) _Pragma("unroll") for (int k = 0; k < 2; ++k) dst[m][k] = *(const PG8_LAS bf16x8*)(lds + PG8_SA(b, h) + aoff + m * 2048 + k * 1024); } while (0)
#define PG8_LDB(dst, b, h) do { _Pragma("unroll") for (int n = 0; n < 2; ++n) _Pragma("unroll") for (int k = 0; k < 2; ++k) dst[n][k] = *(const PG8_LAS bf16x8*)(lds + PG8_SB(b, h) + boff + n * 2048 + k * 1024); } while (0)
#define PG8_MMA(ai, bj, At, Bt) do { __builtin_amdgcn_s_setprio(1); _Pragma("unroll") for (int m = 0; m < 4; ++m) _Pragma("unroll") for (int n = 0; n < 2; ++n) _Pragma("unroll") for (int k = 0; k < 2; ++k) \
        acc[ai][bj][m][n] = __builtin_amdgcn_mfma_f32_16x16x32_bf16(Bt[n][k], At[m][k], acc[ai][bj][m][n], 0, 0, 0); __builtin_amdgcn_s_setprio(0); } while (0)
#define PG8_WAIT_V(n) asm volatile("s_waitcnt vmcnt(" #n ")" ::: "memory")
#define PG8_WAIT_L(n) asm volatile("s_waitcnt lgkmcnt(" #n ")" ::: "memory")
#define PG8_BAR __builtin_amdgcn_s_barrier()
#define PG8_SCHED __builtin_amdgcn_sched_barrier(0)
    Unit cur, nxt; int ui = 0;
    if (!S.next(0, cur)) return;
    f32x4 acc[2][2][4][2];
#pragma unroll
    for (int a = 0; a < 2; ++a)
#pragma unroll
        for (int b = 0; b < 2; ++b)
#pragma unroll
            for (int m = 0; m < 4; ++m)
#pragma unroll
                for (int n = 0; n < 2; ++n) acc[a][b][m][n] = (f32x4){0.f, 0.f, 0.f, 0.f};
    bf16x8 At[4][2], B0[2][2], B1[2][2];
    const char* cA = (const char*)g.A + (size_t)cur.pm * tstepA; const char* cB = (const char*)g.Bt + (size_t)cur.pn * tstepB;
    S.a_ready(cur);
    if constexpr (SP2) {
        PG8_STAGE(PG8_SB(0, 0), cB, voffB); PG8_STAGE(PG8_SB(0, 1), cB + hstepB, voffB); PG8_STAGE(PG8_SA(0, 0), cA, voffA); PG8_STAGE(PG8_SA(0, 1), cA + hstepA, voffA);
        if (wr == 1) PG8_BAR;
        PG8_WAIT_V(2); PG8_BAR;
        PG8_STAGE(PG8_SB(1, 0), cB + kstep, voffB); PG8_STAGE(PG8_SA(1, 0), cA + kstep, voffA); PG8_STAGE(PG8_SB(1, 1), cB + hstepB + kstep, voffB);
        PG8_WAIT_V(6); PG8_BAR;
    } else {
        PG8_STAGE(PG8_SB(0, 0), cB, voffB); PG8_STAGE(PG8_SA(0, 0), cA, voffA); PG8_STAGE(PG8_SB(0, 1), cB + hstepB, voffB); PG8_STAGE(PG8_SA(0, 1), cA + hstepA, voffA);
        if (wr == 1) PG8_BAR;
        PG8_WAIT_V(4); PG8_BAR;
        PG8_STAGE(PG8_SB(1, 0), cB + kstep, voffB); PG8_STAGE(PG8_SA(1, 0), cA + kstep, voffA); PG8_STAGE(PG8_SB(1, 1), cB + hstepB + kstep, voffB);
        PG8_WAIT_V(6); PG8_BAR;
    }
    for (;;) {
        const bool has_next = S.next(ui + 1, nxt);
        const char* nA = has_next ? (const char*)g.A + (size_t)nxt.pm * tstepA : cA; const char* nB = has_next ? (const char*)g.Bt + (size_t)nxt.pn * tstepB : cB;
        for (int t = 0; t < nt; t += 2) {
            const bool last = (t == nt - 2);
            const char* a1 = cA + (size_t)(t + 1) * kstep;
            const char* a2 = last ? nA : cA + (size_t)(t + 2) * kstep; const char* b2 = last ? nB : cB + (size_t)(t + 2) * kstep;
            const char* a3 = a2 + kstep; const char* b3 = b2 + kstep;
            if (last && has_next) S.a_ready(nxt);
            if constexpr (SP2) {
            PG8_LDB(B0, 0, 0); PG8_LDB(B1, 0, 1); PG8_SCHED; PG8_LDA(At, 0, 0); PG8_STAGE(PG8_SA(1, 1), a1 + hstepA, voffA);
            PG8_WAIT_V(8); PG8_WAIT_L(0); PG8_BAR; PG8_MMA(0, 0, At, B0); PG8_MMA(0, 1, At, B1); PG8_BAR; PG8_SCHED;
            PG8_LDA(At, 0, 1); PG8_STAGE(PG8_SB(0, 0), b2, voffB); PG8_STAGE(PG8_SB(0, 1), b2 + hstepB, voffB); PG8_STAGE(PG8_SA(0, 0), a2, voffA);
            PG8_WAIT_V(8); PG8_WAIT_L(0); PG8_BAR; PG8_MMA(1, 0, At, B0); PG8_MMA(1, 1, At, B1); PG8_BAR; PG8_SCHED;
            PG8_LDB(B0, 1, 0); PG8_LDB(B1, 1, 1); PG8_SCHED; PG8_LDA(At, 1, 0); PG8_STAGE(PG8_SA(0, 1), a2 + hstepA, voffA);
            PG8_WAIT_V(8); PG8_WAIT_L(0); PG8_BAR; PG8_MMA(0, 0, At, B0); PG8_MMA(0, 1, At, B1); PG8_BAR; PG8_SCHED;
            PG8_LDA(At, 1, 1); PG8_STAGE(PG8_SB(1, 0), b3, voffB); PG8_STAGE(PG8_SB(1, 1), b3 + hstepB, voffB); PG8_STAGE(PG8_SA(1, 0), a3, voffA);
            PG8_WAIT_V(8); PG8_WAIT_L(0); PG8_BAR; PG8_MMA(1, 0, At, B0); PG8_MMA(1, 1, At, B1); PG8_BAR; PG8_SCHED;
            } else {
            PG8_LDB(B0, 0, 0); PG8_SCHED; PG8_LDA(At, 0, 0); PG8_STAGE(PG8_SA(1, 1), a1 + hstepA, voffA);
            PG8_WAIT_L(8); PG8_BAR; PG8_WAIT_L(0); PG8_MMA(0, 0, At, B0); PG8_BAR; PG8_SCHED;
            PG8_LDB(B1, 0, 1); PG8_STAGE(PG8_SB(0, 0), b2, voffB);
            PG8_BAR; PG8_WAIT_L(0); PG8_MMA(0, 1, At, B1); PG8_BAR;
            PG8_LDA(At, 0, 1); PG8_STAGE(PG8_SA(0, 0), a2, voffA);
            PG8_BAR; PG8_WAIT_L(0); PG8_MMA(1, 0, At, B0); PG8_BAR; PG8_SCHED;
            PG8_STAGE(PG8_SB(0, 1), b2 + hstepB, voffB);
            PG8_WAIT_V(6); PG8_BAR; PG8_MMA(1, 1, At, B1); PG8_BAR;
            PG8_LDB(B0, 1, 0); PG8_SCHED; PG8_LDA(At, 1, 0); PG8_STAGE(PG8_SA(0, 1), a2 + hstepA, voffA);
            PG8_WAIT_L(8); PG8_BAR; PG8_WAIT_L(0); PG8_MMA(0, 0, At, B0); PG8_BAR; PG8_SCHED;
            PG8_LDB(B1, 1, 1); PG8_STAGE(PG8_SB(1, 0), b3, voffB);
            PG8_BAR; PG8_WAIT_L(0); PG8_MMA(0, 1, At, B1); PG8_BAR;
            PG8_LDA(At, 1, 1); PG8_STAGE(PG8_SA(1, 0), a3, voffA);
            PG8_BAR; PG8_WAIT_L(0); PG8_MMA(1, 0, At, B0); PG8_BAR; PG8_SCHED;
            PG8_STAGE(PG8_SB(1, 1), b3 + hstepB, voffB);
            PG8_WAIT_V(6); PG8_BAR; PG8_MMA(1, 1, At, B1); PG8_BAR;
            }
        }
        if constexpr (ALIGN_EPI) { if (wr == 0) PG8_BAR; }
        if constexpr (!Epi::AFTER_DRAIN) { E(acc, cur, wr, wc, fr, fq); S.done(cur); }
        if (!has_next) break;
        if constexpr (!Epi::CHAIN) {
#pragma unroll
        for (int a = 0; a < 2; ++a)
#pragma unroll
            for (int b = 0; b < 2; ++b)
#pragma unroll
                for (int m = 0; m < 4; ++m)
#pragma unroll
                    for (int n = 0; n < 2; ++n) acc[a][b][m][n] = (f32x4){0.f, 0.f, 0.f, 0.f};
        }
        cur = nxt; cA = nA; cB = nB; ++ui;
        if constexpr (ALIGN_EPI) { if (wr == 1) PG8_BAR; }
    }
    PG8_WAIT_V(0);
    if constexpr (!ALIGN_EPI) { if (wr == 0) PG8_BAR; }
    PG8_BAR;
    if constexpr (Epi::AFTER_DRAIN) { E.fused(acc, cur, wr, wc, fr, fq, lds, wid, lane); S.done(cur); }
#undef PG8_SA
#undef PG8_SB
#undef PG8_STAGE
#undef PG8_LDA
#undef PG8_LDB
#undef PG8_MMA
#undef PG8_WAIT_V
#undef PG8_WAIT_L
#undef PG8_BAR
#undef PG8_SCHED
}
}

constexpr size_t MiB = 1u << 20, KiB = 1u << 10;
constexpr size_t WS_CTL = 0, CTL_BYTES = 1 * MiB;
constexpr size_t WS_WIN = 1 * MiB, WS_WUP = 22 * MiB, WS_WOUT = 26 * MiB, WS_WCQ = 28 * MiB, WS_WCKV = 29 * MiB, WS_WCO = 31 * MiB, WS_WFF1 = 32 * MiB, WS_WFF2 = 40 * MiB, WS_WGLU = 48 * MiB;
constexpr size_t WS_POOLT = 48 * MiB + 512 * KiB, WS_WST = WS_POOLT + 256 * KiB, WS_AB = WS_WST + 256 * KiB, WS_BBT = WS_AB + 256 * KiB, WS_CM = WS_BBT + 256 * KiB;
constexpr size_t WS_MEMN = 50 * MiB, WS_KV = 54 * MiB, WS_LSE = 58 * MiB, WS_H = 60 * MiB, WS_MERGED = 124 * MiB, WS_TOT = 188 * MiB, WS_BR = 252 * MiB, WS_PROJ = 316 * MiB, WS_END = 652 * MiB;
constexpr size_t WS_Y = WS_PROJ, WS_Q = 444 * MiB, WS_O = 476 * MiB, WS_HID = WS_PROJ, WS_YFF = WS_MERGED;
static_assert(WS_CM + 256 * KiB <= WS_MEMN && WS_PROJ + (size_t)MH * INW * 2 <= WS_END && WS_HID + (size_t)M * DFF * 2 <= WS_END && WS_YFF + (size_t)M * D * 4 <= WS_BR, "ws map");
constexpr int LDS_BYTES = 147456;

#define LAS __attribute__((address_space(3)))
typedef unsigned short bf16;
typedef unsigned v4u __attribute__((ext_vector_type(4)));
typedef unsigned v2u __attribute__((ext_vector_type(2)));
typedef float f32x4 __attribute__((ext_vector_type(4)));
typedef short bf16x8 __attribute__((ext_vector_type(8)));
using pg8::bflo; using pg8::bfhi; using pg8::sigm; using pg8::gelu_t;
__device__ __forceinline__ unsigned f2bf(float f) { unsigned u = __builtin_bit_cast(unsigned, f); return (u + 0x7fffu + ((u >> 16) & 1u)) >> 16; }
__device__ __forceinline__ unsigned pk2(float lo, float hi) { return f2bf(lo) | (f2bf(hi) << 16); }
__device__ __forceinline__ float bf2f(bf16 b) { return __builtin_bit_cast(float, (unsigned)b << 16); }
__device__ __forceinline__ float wave_sum(float v) {
#pragma unroll
    for (int o = 1; o < 64; o <<= 1) v += __shfl_xor(v, o);
    return v;
}
#define LDS_WAIT() asm volatile("s_waitcnt lgkmcnt(0)" ::: "memory")

struct Args { const float* in[35]; float* out; unsigned char* ws; };
enum { I_X = 0, I_MEM, I_RELB, I_GMIXPRE, I_GMIXPOST, I_WIN, I_GATEB, I_POOLW, I_POOLS, I_ARE, I_AIM, I_LOGDT, I_BRE, I_BIM, I_CRE, I_CIM, I_DSKIP, I_WGLU, I_BGLU,
       I_LNG, I_LNB, I_WS, I_BS, I_WUP, I_WOUT, I_GXPRE, I_GXPOST, I_GMEM, I_WCQ, I_WCKV, I_WCO, I_GFFPRE, I_GFFPOST, I_WFF1, I_WFF2 };

__device__ __forceinline__ void tr_item(const float* W, int K, int N, bf16* WT, LAS float* scr, int item, int lane) {
    const int nblk = N / 32, kb = item / nblk, nb = item % nblk, k0 = 64 * kb, n0 = 32 * nb;
#pragma unroll 8
    for (int i = 0; i < 32; ++i) { const int kk = 2 * i + (lane >> 5); scr[kk * 33 + (lane & 31)] = W[(size_t)(k0 + kk) * N + n0 + (lane & 31)]; }
    LDS_WAIT();
    const int c = lane & 7;
#pragma unroll
    for (int j = 0; j < 4; ++j) { const int n = (lane >> 3) + 8 * j; const LAS float* s = scr + (8 * c) * 33 + n;
        v4u o; o.x = pk2(s[0 * 33], s[1 * 33]); o.y = pk2(s[2 * 33], s[3 * 33]); o.z = pk2(s[4 * 33], s[5 * 33]); o.w = pk2(s[6 * 33], s[7 * 33]);
        *(v4u*)(WT + (size_t)(n0 + n) * K + k0 + 8 * c) = o; }
    LDS_WAIT();
}
__device__ __forceinline__ void rms_row_bf16(const float* xrow, const float* g, bf16* orow, int lane) {
    const f32x4* xr = (const f32x4*)xrow + lane; const f32x4* gr = (const f32x4*)g + lane;
    f32x4 v[4]; float s = 0.f;
#pragma unroll
    for (int j = 0; j < 4; ++j) { v[j] = xr[64 * j]; s += (v[j].x * v[j].x + v[j].y * v[j].y) + (v[j].z * v[j].z + v[j].w * v[j].w); }
    const float r = rsqrtf(wave_sum(s) * (1.f / D) + EPS);
    v2u* o8 = (v2u*)orow + lane;
#pragma unroll
    for (int j = 0; j < 4; ++j) { const f32x4 gv = gr[64 * j]; v2u w; w.x = pk2(v[j].x * r * gv.x, v[j].y * r * gv.y); w.y = pk2(v[j].z * r * gv.z, v[j].w * r * gv.w); o8[64 * j] = w; }
}
__device__ __forceinline__ void rowpass(const float* Xi, const bf16* Y, const float* gpost, const float* gpre, float* Xo, bf16* Hh, int gw, int NGW, int lane) {
    constexpr int R = 4;
    f32x4 gp[4];
#pragma unroll
    for (int j = 0; j < 4; ++j) gp[j] = ((const f32x4*)gpost)[lane + 64 * j];
    for (int row0 = gw * R; row0 < M; row0 += NGW * R) {
        f32x4 y[R][4], x[R][4]; float s[R], s2[R];
#pragma unroll
        for (int q = 0; q < R; ++q) { const v2u* yr = (const v2u*)(Y + (size_t)(row0 + q) * D) + lane; const f32x4* xr = (const f32x4*)(Xi + (size_t)(row0 + q) * D) + lane;
#pragma unroll
            for (int j = 0; j < 4; ++j) { const v2u yw = yr[64 * j]; y[q][j] = (f32x4){bflo(yw.x), bfhi(yw.x), bflo(yw.y), bfhi(yw.y)}; x[q][j] = xr[64 * j]; } }
#pragma unroll
        for (int q = 0; q < R; ++q) { s[q] = 0.f;
#pragma unroll
            for (int j = 0; j < 4; ++j) s[q] += (y[q][j].x * y[q][j].x + y[q][j].y * y[q][j].y) + (y[q][j].z * y[q][j].z + y[q][j].w * y[q][j].w); }
#pragma unroll
        for (int o = 1; o < 64; o <<= 1) {
#pragma unroll
            for (int q = 0; q < R; ++q) s[q] += __shfl_xor(s[q], o); }
#pragma unroll
        for (int q = 0; q < R; ++q) { const float r = rsqrtf(s[q] * (1.f / D) + EPS); s2[q] = 0.f; f32x4* xo = (f32x4*)(Xo + (size_t)(row0 + q) * D) + lane;
#pragma unroll
            for (int j = 0; j < 4; ++j) { x[q][j] = x[q][j] + y[q][j] * r * gp[j]; xo[64 * j] = x[q][j];
                s2[q] += (x[q][j].x * x[q][j].x + x[q][j].y * x[q][j].y) + (x[q][j].z * x[q][j].z + x[q][j].w * x[q][j].w); } }
        if (gpre) {
#pragma unroll
            for (int o = 1; o < 64; o <<= 1) {
#pragma unroll
                for (int q = 0; q < R; ++q) s2[q] += __shfl_xor(s2[q], o); }
#pragma unroll
            for (int q = 0; q < R; ++q) { const float r2 = rsqrtf(s2[q] * (1.f / D) + EPS); v2u* o8 = (v2u*)(Hh + (size_t)(row0 + q) * D) + lane;
#pragma unroll
                for (int j = 0; j < 4; ++j) { const f32x4 gv = ((const f32x4*)gpre)[lane + 64 * j]; v2u w; w.x = pk2(x[q][j].x * r2 * gv.x, x[q][j].y * r2 * gv.y); w.y = pk2(x[q][j].z * r2 * gv.z, x[q][j].w * r2 * gv.w); o8[64 * j] = w; } } }
    }
}
__device__ __forceinline__ int t5_bucket(int n) {
    if (n < 16) return n;
    return 16 + (n >= 22) + (n >= 30) + (n >= 40) + (n >= 54) + (n >= 73) + (n >= 99) + (n >= 134) + (n >= 182) + (n >= 246) + (n >= 332) + (n >= 450) + (n >= 609) + (n >= 825) + (n >= 1117) + (n >= 1513);
}
__device__ __forceinline__ double dexp_small(double x) {
    double t = 1.0, s = 1.0;
#pragma unroll
    for (int k = 1; k <= 16; ++k) { t *= x / (double)k; s += t; }
    return s;
}
__device__ __forceinline__ double dexp(double x) { double e = dexp_small(x * (1.0 / 32.0)); e *= e; e *= e; e *= e; e *= e; e *= e; return e; }
__device__ __forceinline__ void dsincos(double x, double& sn, double& cs) {
    const double TWO_PI = 6.283185307179586476925286766559;
    x -= TWO_PI * __builtin_rint(x * (1.0 / TWO_PI));
    const double r = x * 0.125, r2 = r * r;
    double st = r, ct = 1.0, s = r, c = 1.0;
#pragma unroll
    for (int k = 1; k <= 8; ++k) { ct *= -r2 / (double)((2 * k - 1) * (2 * k)); st *= -r2 / (double)((2 * k) * (2 * k + 1)); c += ct; s += st; }
#pragma unroll
    for (int k = 0; k < 3; ++k) { const double s2 = 2.0 * s * c, c2 = c * c - s * s; s = s2; c = c2; }
    sn = s; cs = c;
}
typedef short v4i16_t __attribute__((ext_vector_type(4)));
#define MFMA16(bfrag, afrag, c) __builtin_amdgcn_mfma_f32_16x16x32_bf16((bfrag), (afrag), (c), 0, 0, 0)
__device__ __forceinline__ void attn_naive(bf16* P, float* LSE, const float* relb, int gw, int NGW, int lane) {
    for (int uidx = gw; uidx < MH * 24; uidx += NGW) {
        const int r = uidx / 24, gh = uidx % 24, g = gh >> 3, h = gh & 7;
        const int t = r & (S - 1), dil = g == 0 ? 1 : (g == 1 ? 4 : 16);
        const int nd = min(t / dil, 128);
        bf16* prow = P + (size_t)r * INW + OFF_ATT + g * 512 + h * 64 + lane;
        const float q = bf2f(*prow);
        float mx = -1e30f, ss = 0.f, o = 0.f;
        for (int dist = 0; dist <= nd; ++dist) {
            const bf16* kp = prow - (size_t)dist * dil * INW;
            const float kv = bf2f(kp[1536]), vv = bf2f(kp[3072]);
            const float sc = wave_sum(q * kv) * 0.125f + relb[t5_bucket(dist * dil) * 24 + gh];
            const float mn = fmaxf(mx, sc), corr = __expf(mx - mn), p = __expf(sc - mn);
            ss = ss * corr + p; o = o * corr + p * vv; mx = mn;
        }
        *prow = (bf16)f2bf(o / ss);
        if (lane == 0) LSE[((size_t)g * MH + r) * 8 + h] = mx + __logf(ss);
    }
}
__device__ __forceinline__ void attn_merge(const bf16* __restrict__ P, const float* __restrict__ LSE, bf16* __restrict__ BR1, int gt, int NGT) {
#pragma unroll 4
    for (int e = gt; e < MH * 64; e += NGT) {
        const int r = e >> 6, ch = e & 63, h = ch >> 3;
        const float l0 = LSE[((size_t)0 * MH + r) * 8 + h], l1 = LSE[((size_t)1 * MH + r) * 8 + h], l2 = LSE[((size_t)2 * MH + r) * 8 + h];
        const float mx = fmaxf(l0, fmaxf(l1, l2));
        float w0 = __expf(l0 - mx), w1 = __expf(l1 - mx), w2 = __expf(l2 - mx); const float inv = 1.f / (w0 + w1 + w2); w0 *= inv; w1 *= inv; w2 *= inv;
        const bf16* base = P + (size_t)r * INW + OFF_ATT + ch * 8;
        const v4u a0 = *(const v4u*)base, a1 = *(const v4u*)(base + 512), a2 = *(const v4u*)(base + 1024);
        v4u o;
        o.x = pk2(w0 * bflo(a0.x) + w1 * bflo(a1.x) + w2 * bflo(a2.x), w0 * bfhi(a0.x) + w1 * bfhi(a1.x) + w2 * bfhi(a2.x));
        o.y = pk2(w0 * bflo(a0.y) + w1 * bflo(a1.y) + w2 * bflo(a2.y), w0 * bfhi(a0.y) + w1 * bfhi(a1.y) + w2 * bfhi(a2.y));
        o.z = pk2(w0 * bflo(a0.z) + w1 * bflo(a1.z) + w2 * bflo(a2.z), w0 * bfhi(a0.z) + w1 * bfhi(a1.z) + w2 * bfhi(a2.z));
        o.w = pk2(w0 * bflo(a0.w) + w1 * bflo(a1.w) + w2 * bflo(a2.w), w0 * bfhi(a0.w) + w1 * bfhi(a1.w) + w2 * bfhi(a2.w));
        *(v4u*)(BR1 + (size_t)r * 512 + ch * 8) = o;
    }
}
__device__ __forceinline__ void ssm_naive(bf16* P, const float* AB, const bf16* BBT, const bf16* CM, const float* dskip, int gw, int NGW, int lane) {
    for (int uidx = gw; uidx < 4 * 32; uidx += NGW) {
        const int bl = uidx >> 5, g = uidx & 31;
        float bbr[16], bbi[16], cr[16], ci[16];
#pragma unroll
        for (int c = 0; c < 16; ++c) { bbr[c] = bf2f(BBT[(g * 128 + lane) * 16 + c]); bbi[c] = bf2f(BBT[(g * 128 + 64 + lane) * 16 + c]);
            cr[c] = bf2f(CM[(g * 16 + c) * 128 + lane]); ci[c] = bf2f(CM[(g * 16 + c) * 128 + 64 + lane]); }
        const float ar = AB[(g * 64 + lane) * 2], ai = AB[(g * 64 + lane) * 2 + 1];
        const float dsk = dskip[g * 16 + (lane & 15)];
        float hr = 0.f, hi = 0.f;
        for (int t = 0; t < S; ++t) {
            bf16* up = P + (size_t)(bl * S + t) * INW + OFF_SSM + g * 16;
            const v4u u0 = *(const v4u*)up, u1 = *(const v4u*)(up + 8);
            const float ul = bf2f(up[lane & 15]);
            float u[16] = {bflo(u0.x), bfhi(u0.x), bflo(u0.y), bfhi(u0.y), bflo(u0.z), bfhi(u0.z), bflo(u0.w), bfhi(u0.w),
                           bflo(u1.x), bfhi(u1.x), bflo(u1.y), bfhi(u1.y), bflo(u1.z), bfhi(u1.z), bflo(u1.w), bfhi(u1.w)};
            float bur = 0.f, bui = 0.f;
#pragma unroll
            for (int c = 0; c < 16; ++c) { bur += bbr[c] * u[c]; bui += bbi[c] * u[c]; }
            const float nhr = ar * hr - ai * hi + bur, nhi = ar * hi + ai * hr + bui; hr = nhr; hi = nhi;
            float ym = 0.f;
#pragma unroll
            for (int c = 0; c < 16; ++c) { const float yc = wave_sum(cr[c] * hr + ci[c] * hi); if (lane == c) ym = yc; }
            if (lane < 16) up[lane] = (bf16)f2bf(gelu_t(ym + ul * dsk));
        }
    }
}
__device__ __forceinline__ void sgu_unit(LAS unsigned char* lds, const bf16* P, const bf16* WST, const float* lng, const float* lnb, const float* bs, bf16* BR3, int unit, int tid, int lane, int wave) {
    const int g = unit & 3, n = (unit >> 2) & 31, bl = unit >> 7;
    const int r0 = bl * S + n * 128;
    LAS float* stats = (LAS float*)lds; LAS bf16* VnT = (LAS bf16*)(lds + 1024);
    const int fr = lane & 15, fq = lane >> 4, tq = fr >> 2, tp = fr & 3, t = 16 * wave + fr, nks = (wave >> 1) + 1;
    v4u xs[16], vn[4]; bf16x8 wf[4]; v2u uw[8];
#pragma unroll
    for (int rr = 0; rr < 16; ++rr) xs[rr] = *(const v4u*)(P + (size_t)(r0 + 16 * wave + rr) * INW + OFF_SGU + 512 + lane * 8);
#pragma unroll
    for (int it = 0; it < 4; ++it) { const int idx = tid + 512 * it, s = idx >> 4, ch = (idx & 15) * 8; vn[it] = *(const v4u*)(P + (size_t)(r0 + s) * INW + OFF_SGU + 512 + g * 128 + ch); }
#pragma unroll
    for (int ks = 0; ks < 4; ++ks) wf[ks] = *(const bf16x8*)(WST + ((size_t)g * 128 + t) * 128 + 32 * ks + 8 * fq);
#pragma unroll
    for (int nt = 0; nt < 8; ++nt) uw[nt] = *(const v2u*)(P + (size_t)(r0 + t) * INW + OFF_SGU + g * 128 + 16 * nt + 4 * fq);
    const float bst = bs[g * 128 + t];
#pragma unroll
    for (int rr = 0; rr < 16; ++rr) { const int row = 16 * wave + rr; const v4u x = xs[rr];
        float v[8] = {bflo(x.x), bfhi(x.x), bflo(x.y), bfhi(x.y), bflo(x.z), bfhi(x.z), bflo(x.w), bfhi(x.w)};
        float s = 0.f;
#pragma unroll
        for (int j = 0; j < 8; ++j) s += v[j];
        const float mean = wave_sum(s) * (1.f / 512.f); float q = 0.f;
#pragma unroll
        for (int j = 0; j < 8; ++j) { const float d = v[j] - mean; q += d * d; }
        const float rstd = rsqrtf(wave_sum(q) * (1.f / 512.f) + EPS);
        if (lane == 0) { stats[row * 2] = mean; stats[row * 2 + 1] = rstd; } }
    __syncthreads();
#pragma unroll
    for (int it = 0; it < 4; ++it) { const int idx = tid + 512 * it, s = idx >> 4, ch = (idx & 15) * 8;
        const v4u x = vn[it];
        const float mean = stats[s * 2], rstd = stats[s * 2 + 1];
        float v[8] = {bflo(x.x), bfhi(x.x), bflo(x.y), bfhi(x.y), bflo(x.z), bfhi(x.z), bflo(x.w), bfhi(x.w)};
        const f32x4 g0 = *(const f32x4*)(lng + g * 128 + ch), g1 = *(const f32x4*)(lng + g * 128 + ch + 4), b0 = *(const f32x4*)(lnb + g * 128 + ch), b1 = *(const f32x4*)(lnb + g * 128 + ch + 4);
#pragma unroll
        for (int j = 0; j < 4; ++j) { v[j] = (v[j] - mean) * rstd * g0[j] + b0[j]; v[4 + j] = (v[4 + j] - mean) * rstd * g1[j] + b1[j]; }
        v4u w; w.x = pk2(v[0], v[1]); w.y = pk2(v[2], v[3]); w.z = pk2(v[4], v[5]); w.w = pk2(v[6], v[7]);
        *(LAS v4u*)(VnT + s * 136 + ch) = w;
    }
    __syncthreads();
    { f32x4 acc[8];
#pragma unroll
      for (int nt = 0; nt < 8; ++nt) acc[nt] = (f32x4){0.f, 0.f, 0.f, 0.f};
#pragma unroll
      for (int ks = 0; ks < 4; ++ks) if (ks < nks) {
#pragma unroll
          for (int nt = 0; nt < 8; ++nt) {
              const v4i16_t lo = __builtin_amdgcn_ds_read_tr16_b64_v4i16((LAS v4i16_t*)(VnT + (32 * ks + 8 * fq + tq) * 136 + 16 * nt + 4 * tp));
              const v4i16_t hi = __builtin_amdgcn_ds_read_tr16_b64_v4i16((LAS v4i16_t*)(VnT + (32 * ks + 8 * fq + 4 + tq) * 136 + 16 * nt + 4 * tp));
              const bf16x8 vf = {lo[0], lo[1], lo[2], lo[3], hi[0], hi[1], hi[2], hi[3]};
              acc[nt] = MFMA16(vf, wf[ks], acc[nt]); } }
#pragma unroll
      for (int nt = 0; nt < 8; ++nt) { const int c = 16 * nt + 4 * fq;
          v2u o; o.x = pk2(bflo(uw[nt].x) * (acc[nt][0] + bst), bfhi(uw[nt].x) * (acc[nt][1] + bst)); o.y = pk2(bflo(uw[nt].y) * (acc[nt][2] + bst), bfhi(uw[nt].y) * (acc[nt][3] + bst));
          *(v2u*)(BR3 + (size_t)(r0 + t) * 512 + g * 128 + c) = o; } }
    __syncthreads();
}
__device__ __forceinline__ void pool_unit(LAS unsigned char* lds, const bf16* P, const bf16* poolt, const float* pscale, bf16* BR0, int unit, int tid, int lane, int wave) {
    const int gi = unit & 3, tt = (unit >> 2) & 31, bl = unit >> 7;
    const int t0 = tt * 128, r0 = bl * S + t0, w = 2 << gi;
    LAS bf16* raw = (LAS bf16*)lds; LAS bf16* Pt = (LAS bf16*)(lds + 36864);
    const int fr = lane & 15, fq = lane >> 4;
    v4u rx[5];
#pragma unroll
    for (int it = 0; it < 5; ++it) { const int idx = tid + 512 * it, j = idx >> 4, ch = (idx & 15) * 8;
        rx[it] = (v4u){0u, 0u, 0u, 0u};
        if (idx < 144 * 16 && t0 - 16 + j >= 0) rx[it] = *(const v4u*)(P + (size_t)(r0 - 16 + j) * INW + gi * 128 + ch); }
    bf16x8 wfa[2][8];
#pragma unroll
    for (int ks = 0; ks < 2; ++ks)
#pragma unroll
        for (int nt = 0; nt < 8; ++nt) wfa[ks][nt] = *(const bf16x8*)(poolt + ((size_t)gi * 128 + 16 * nt + fr) * 128 + 32 * ks + 8 * fq);
#pragma unroll
    for (int it = 0; it < 5; ++it) { const int idx = tid + 512 * it, j = idx >> 4, ch = (idx & 15) * 8; if (idx < 144 * 16) *(LAS v4u*)(raw + j * 128 + ch) = rx[it]; }
    __syncthreads();
    { const int c = tid & 127, tq = tid >> 7, tb0 = tq * 32; const float rc = 1.f / (float)w;
      float s = 0.f;
      for (int j = 0; j < w; ++j) s += bf2f(raw[(16 + tb0 - j) * 128 + c]);
      for (int i = 0; i < 32; ++i) { const int t = tb0 + i; const int cnt = min(t0 + t + 1, w);
          const float cur = bf2f(raw[(16 + t) * 128 + c]);
          const float mean = (cnt == w) ? s * rc : s / (float)cnt;
          Pt[t * 136 + c] = (bf16)f2bf(mean - cur);
          s += bf2f(raw[(17 + t) * 128 + c]) - bf2f(raw[(17 + t - w) * 128 + c]); } }
    __syncthreads();
    { const int t = 16 * wave + fr;
      f32x4 acc[8];
#pragma unroll
      for (int nt = 0; nt < 8; ++nt) acc[nt] = (f32x4){0.f, 0.f, 0.f, 0.f};
#pragma unroll
      for (int ks = 0; ks < 4; ++ks) { const bf16x8 pf = *(const LAS bf16x8*)(Pt + t * 136 + 32 * ks + 8 * fq);
#pragma unroll
          for (int nt = 0; nt < 8; ++nt) { const bf16x8 wf = ks < 2 ? wfa[ks & 1][nt] : *(const bf16x8*)(poolt + ((size_t)gi * 128 + 16 * nt + fr) * 128 + 32 * ks + 8 * fq); acc[nt] = MFMA16(wf, pf, acc[nt]); } }
#pragma unroll
      for (int nt = 0; nt < 8; ++nt) { const int d = 16 * nt + 4 * fq; const f32x4 sc = *(const f32x4*)(pscale + gi * 128 + d);
          v2u o; o.x = pk2(acc[nt][0] * sc[0], acc[nt][1] * sc[1]); o.y = pk2(acc[nt][2] * sc[2], acc[nt][3] * sc[3]);
          *(v2u*)(BR0 + (size_t)(r0 + t) * 512 + gi * 128 + d) = o; } }
    __syncthreads();
}
__device__ __forceinline__ void xattn_naive(const bf16* Q, const bf16* KV, bf16* O, int gw, int NGW, int lane) {
    for (int uidx = gw; uidx < M * 4; uidx += NGW) {
        const int T = uidx >> 2, h = uidx & 3, b = T / S;
        const unsigned qw = *(const unsigned*)(Q + (size_t)T * 512 + h * 128 + 2 * lane);
        const float q0 = bflo(qw), q1 = bfhi(qw);
        float mx = -1e30f, ss = 0.f, o0 = 0.f, o1 = 0.f;
        for (int j = 0; j < NMEM; ++j) {
            const bf16* kr = KV + (size_t)(b * NMEM + j) * 1024 + h * 128 + 2 * lane;
            const unsigned kw = *(const unsigned*)kr, vw = *(const unsigned*)(kr + 512);
            const float sc = wave_sum(q0 * bflo(kw) + q1 * bfhi(kw));
            const float mn = fmaxf(mx, sc), corr = __expf(mx - mn), p = __expf(sc - mn);
            ss = ss * corr + p; o0 = o0 * corr + p * bflo(vw); o1 = o1 * corr + p * bfhi(vw); mx = mn;
        }
        const float inv = 1.f / ss;
        *(unsigned*)(O + (size_t)T * 512 + h * 128 + 2 * lane) = pk2(o0 * inv, o1 * inv);
    }
}
__device__ __forceinline__ void ssm_unit(LAS unsigned char* lds, bf16* P, const float* ABp, const bf16* BBTp, const bf16* CMp, const float* dskip, int unit, int tid, int lane, int wave) {
    const int bl = unit >> 5, g = unit & 31, fr = lane & 15, fq = lane >> 4;
    LAS float* bu = (LAS float*)(lds + wave * 16896);
    LAS bf16* hb = (LAS bf16*)(lds + wave * 16896);
    LAS float* ends = (LAS float*)(lds + 135168);
    const bf16x8 z8 = {0, 0, 0, 0, 0, 0, 0, 0};
    bf16x8 bbf[8], cmf[4];
#pragma unroll
    for (int nt = 0; nt < 8; ++nt) bbf[nt] = fq < 2 ? *(const bf16x8*)(BBTp + (size_t)(g * 128 + 16 * nt + fr) * 16 + 8 * fq) : z8;
#pragma unroll
    for (int ks = 0; ks < 4; ++ks) cmf[ks] = *(const bf16x8*)(CMp + (size_t)(g * 16 + fr) * 128 + 32 * ks + 8 * fq);
    const float ar = ABp[(g * 64 + lane) * 2], ai = ABp[(g * 64 + lane) * 2 + 1];
    float pr = ar, pi = ai;
#pragma unroll
    for (int i = 0; i < 5; ++i) { const float nr = pr * pr - pi * pi, ni = 2.f * pr * pi; pr = nr; pi = ni; }
    const f32x4 dsk = *(const f32x4*)(dskip + g * 16 + 4 * fq);
    float cr = 0.f, ci = 0.f;
    bf16x8 uf[2]; v2u uep[2], uepn[2];
#pragma unroll
    for (int mt = 0; mt < 2; ++mt) { const bf16* up = P + (size_t)(bl * S + wave * 32 + 16 * mt + fr) * INW + OFF_SSM + g * 16;
        uf[mt] = fq < 2 ? *(const bf16x8*)(up + 8 * fq) : z8; uep[mt] = *(const v2u*)(up + 4 * fq); }
    for (int ms = 0; ms < 16; ++ms) {
        const int rbase = bl * S + ms * 256 + wave * 32;
#pragma unroll
        for (int mt = 0; mt < 2; ++mt)
#pragma unroll
            for (int nt = 0; nt < 8; ++nt) { f32x4 acc = {0.f, 0.f, 0.f, 0.f}; acc = MFMA16(bbf[nt], uf[mt], acc);
                *(LAS f32x4*)(bu + (16 * mt + fr) * 132 + 16 * nt + 4 * fq) = acc; }
        { const int rn = bl * S + min(ms + 1, 15) * 256 + wave * 32;
#pragma unroll
          for (int mt = 0; mt < 2; ++mt) { const bf16* up = P + (size_t)(rn + 16 * mt + fr) * INW + OFF_SSM + g * 16;
              uf[mt] = fq < 2 ? *(const bf16x8*)(up + 8 * fq) : z8; uepn[mt] = *(const v2u*)(up + 4 * fq); } }
        LDS_WAIT();
        float hr = 0.f, hi = 0.f;
#pragma unroll 8
        for (int t = 0; t < 32; ++t) { const float br = bu[t * 132 + lane], bi = bu[t * 132 + 64 + lane];
            const float nhr = ar * hr - ai * hi + br, nhi = ar * hi + ai * hr + bi; hr = nhr; hi = nhi; }
        ends[wave * 128 + lane] = hr; ends[wave * 128 + 64 + lane] = hi;
        __syncthreads();
        float sr = cr, si = ci, myr = cr, myi = ci;
#pragma unroll
        for (int w = 0; w < 8; ++w) { if (w == wave) { myr = sr; myi = si; }
            const float er = ends[w * 128 + lane], ei = ends[w * 128 + 64 + lane];
            const float nsr = pr * sr - pi * si + er, nsi = pr * si + pi * sr + ei; sr = nsr; si = nsi; }
        cr = sr; ci = si;
        hr = myr; hi = myi;
#pragma unroll 8
        for (int t = 0; t < 32; ++t) { const float br = bu[t * 132 + lane], bi = bu[t * 132 + 64 + lane];
            const float nhr = ar * hr - ai * hi + br, nhi = ar * hi + ai * hr + bi; hr = nhr; hi = nhi;
            hb[t * 136 + lane] = (bf16)f2bf(hr); hb[t * 136 + 64 + lane] = (bf16)f2bf(hi); }
        LDS_WAIT();
#pragma unroll
        for (int mt = 0; mt < 2; ++mt) { f32x4 acc = {0.f, 0.f, 0.f, 0.f};
#pragma unroll
            for (int ks = 0; ks < 4; ++ks) { const bf16x8 hf_ = *(const LAS bf16x8*)(hb + (16 * mt + fr) * 136 + 32 * ks + 8 * fq); acc = MFMA16(cmf[ks], hf_, acc); }
            const float y0 = gelu_t(acc[0] + bflo(uep[mt].x) * dsk[0]), y1 = gelu_t(acc[1] + bfhi(uep[mt].x) * dsk[1]);
            const float y2 = gelu_t(acc[2] + bflo(uep[mt].y) * dsk[2]), y3 = gelu_t(acc[3] + bfhi(uep[mt].y) * dsk[3]);
            v2u o; o.x = pk2(y0, y1); o.y = pk2(y2, y3);
            *(v2u*)(P + (size_t)(rbase + 16 * mt + fr) * INW + OFF_SSM + g * 16 + 4 * fq) = o; }
        uep[0] = uepn[0]; uep[1] = uepn[1];
        __syncthreads();
    }
}
template <int HD> struct AttnRegs { v4u kx[256 * (HD / 8) / 512], vx[256 * (HD / 8) / 512]; bf16x8 qf[HD / 32]; };
template <int HD>
__device__ __forceinline__ void attn_issue(AttnRegs<HD>& R, const bf16* Qp, size_t qstride, const bf16* Kp, const bf16* Vp, size_t kstride, int kfirst, int tid, int lane, int wave) {
    constexpr int CPR = HD / 8, NIT = 256 * CPR / 512, KST = HD / 32;
#pragma unroll
    for (int it = 0; it < NIT; ++it) { const int idx = tid + 512 * it, kk = idx / CPR, cc = idx % CPR;
        R.kx[it] = (v4u){0u, 0u, 0u, 0u}; R.vx[it] = (v4u){0u, 0u, 0u, 0u};
        if (kk >= kfirst) { R.kx[it] = *(const v4u*)(Kp + (ptrdiff_t)kk * (ptrdiff_t)kstride + cc * 8); R.vx[it] = *(const v4u*)(Vp + (ptrdiff_t)kk * (ptrdiff_t)kstride + cc * 8); } }
    const int qi = 16 * wave + (lane & 15), fq = lane >> 4;
#pragma unroll
    for (int ks = 0; ks < KST; ++ks) R.qf[ks] = *(const bf16x8*)(Qp + (size_t)qi * qstride + 32 * ks + 8 * fq);
}
template <int HD, bool DIL>
__device__ __forceinline__ void attn_stage(LAS unsigned char* lds, const AttnRegs<HD>& R, const float* relb, int dil, int gh, int tid) {
    constexpr int PITCH = HD + 8, CPR = HD / 8, NIT = 256 * CPR / 512;
    LAS bf16* Ks = (LAS bf16*)lds; LAS bf16* Vs = (LAS bf16*)(lds + 256 * PITCH * 2); LAS float* tb = (LAS float*)(lds + 2 * 256 * PITCH * 2);
#pragma unroll
    for (int it = 0; it < NIT; ++it) { const int idx = tid + 512 * it, kk = idx / CPR, cc = idx % CPR;
        *(LAS v4u*)(Ks + kk * PITCH + cc * 8) = R.kx[it]; *(LAS v4u*)(Vs + kk * PITCH + cc * 8) = R.vx[it]; }
    if (DIL) { if (tid < 256) { const int dist = tid - 64; tb[tid] = (dist >= 0 && dist <= 128) ? relb[t5_bucket(dist * dil) * 24 + gh] * 1.4426950408889634f : 0.f; } }
}
template <int HD, bool DIL>
__device__ __forceinline__ void attn_compute(LAS unsigned char* lds, const bf16x8 (&qf)[HD / 32], int kfirst, bf16* Op, size_t ostride, float* lsep, int dil, int tid, int lane, int wave) {
    constexpr int PITCH = HD + 8, KST = HD / 32, NDT = HD / 16, NT = DIL ? 10 : 16, NK2 = NT / 2;
    const int ntb = DIL ? (wave & ~1) : 0;
    LAS bf16* Ks = (LAS bf16*)lds; LAS bf16* Vs = (LAS bf16*)(lds + 256 * PITCH * 2); LAS float* tb = (LAS float*)(lds + 2 * 256 * PITCH * 2);
    const int fr = lane & 15, fq = lane >> 4;
    const int qi = 16 * wave + fr;
    f32x4 sacc[NT];
#pragma unroll
    for (int nt = 0; nt < NT; ++nt) { f32x4 acc = {0.f, 0.f, 0.f, 0.f};
#pragma unroll
        for (int ks = 0; ks < KST; ++ks) { const bf16x8 kf = *(const LAS bf16x8*)(Ks + (16 * (ntb + nt) + fr) * PITCH + 32 * ks + 8 * fq); acc = MFMA16(kf, qf[ks], acc); }
        sacc[nt] = acc; }
    const LAS float* tbl = tb + (33 + qi - 16 * ntb - 4 * fq);
    constexpr float SC = DIL ? 0.125f * 1.4426950408889634f : 1.4426950408889634f;
    const int dbase = 128 + qi - 16 * ntb - 4 * fq;
    const unsigned dmax = DIL ? (unsigned)(kfirst ? qi : 128) : 0u;
    float mx = -1e30f;
#pragma unroll
    for (int nt = 0; nt < NT; ++nt)
#pragma unroll
        for (int j = 0; j < 4; ++j) { float s = sacc[nt][j];
            if (DIL) { const unsigned dist = (unsigned)(dbase - (16 * nt + j));
                const float bv = tbl[159 - (16 * nt + j)];
                s = dist <= dmax ? fmaf(s, SC, bv) : -1e30f; }
            else s *= SC;
            sacc[nt][j] = s; mx = fmaxf(mx, s); }
    mx = fmaxf(mx, __shfl_xor(mx, 16)); mx = fmaxf(mx, __shfl_xor(mx, 32));
    float sum = 0.f;
    bf16x8 pf[NK2];
#pragma unroll
    for (int k2 = 0; k2 < NK2; ++k2) { float p[8];
#pragma unroll
        for (int j = 0; j < 4; ++j) { p[j] = __builtin_amdgcn_exp2f(sacc[2 * k2][j] - mx); p[4 + j] = __builtin_amdgcn_exp2f(sacc[2 * k2 + 1][j] - mx); }
#pragma unroll
        for (int j = 0; j < 8; ++j) sum += p[j];
        v4u w; w.x = pk2(p[0], p[1]); w.y = pk2(p[2], p[3]); w.z = pk2(p[4], p[5]); w.w = pk2(p[6], p[7]);
        pf[k2] = __builtin_bit_cast(bf16x8, w); }
    sum += __shfl_xor(sum, 16); sum += __shfl_xor(sum, 32);
    const float inv = 1.f / sum;
    const int tq = fr >> 2, tp = fr & 3;
#pragma unroll
    for (int dt = 0; dt < NDT; ++dt) { f32x4 oacc = {0.f, 0.f, 0.f, 0.f};
#pragma unroll
        for (int k2 = 0; k2 < NK2; ++k2) {
            const v4i16_t lo = __builtin_amdgcn_ds_read_tr16_b64_v4i16((LAS v4i16_t*)(Vs + (16 * ntb + 32 * k2 + 4 * fq + tq) * PITCH + 16 * dt + 4 * tp));
            const v4i16_t hi = __builtin_amdgcn_ds_read_tr16_b64_v4i16((LAS v4i16_t*)(Vs + (16 * ntb + 32 * k2 + 16 + 4 * fq + tq) * PITCH + 16 * dt + 4 * tp));
            const bf16x8 vf = {lo[0], lo[1], lo[2], lo[3], hi[0], hi[1], hi[2], hi[3]};
            oacc = MFMA16(vf, pf[k2], oacc); }
        v2u o; o.x = pk2(oacc[0] * inv, oacc[1] * inv); o.y = pk2(oacc[2] * inv, oacc[3] * inv);
        *(v2u*)(Op + (size_t)qi * ostride + 16 * dt + 4 * fq) = o; }
    if (DIL) { if (fq == 0) lsep[(size_t)qi * 8 * dil] = (mx + __log2f(sum)) * 0.6931471805599453f; }
    __syncthreads();
}
struct DilU { bf16* Qp; const bf16* Kp; size_t stride; float* lsep; int kfirst, dil, gh; };
__device__ __forceinline__ DilU dil_decode(int v, bf16* PROJp, float* LSEp) {
    const int h = v & 7, j32 = (v >> 3) & 31, bg = v >> 8, g = bg % 3, bl = bg / 3, dil = g == 0 ? 1 : (g == 1 ? 4 : 16), res = j32 % dil, n = j32 / dil;
    const int rq0 = bl * S + 128 * n * dil + res;
    DilU d; d.Qp = PROJp + (size_t)rq0 * INW + OFF_ATT + g * 512 + h * 64; d.Kp = d.Qp + 1536 - (ptrdiff_t)128 * dil * INW; d.stride = (size_t)dil * INW;
    d.lsep = LSEp + ((size_t)g * MH + rq0) * 8 + h; d.kfirst = n == 0 ? 128 : 0; d.dil = dil; d.gh = g * 8 + h; return d;
}
__device__ __forceinline__ const float* kin(int k) { int kk = k; asm volatile("" : "+s"(kk)); return ((const float* const __attribute__((address_space(4)))*)__builtin_amdgcn_kernarg_segment_ptr())[kk]; }
typedef __attribute__((address_space(1))) unsigned gu32;
#define XB_TMO      128
#define XB_XCNT(j)  (256  + 64 * (j))
#define XB_XSUB(j)  (1280 + 64 * (j))
#define XB_XGEN(j)  (2304 + 64 * (j))
#define XB_TOP      3328
#define XB_TOPGEN   3392
#define XCD_BAR_WORDS 3456
#define XB_SPIN_CAP (1u << 18)

__device__ __forceinline__ unsigned xb_ld(unsigned* p)              { return __hip_atomic_load(p, __ATOMIC_RELAXED, __HIP_MEMORY_SCOPE_AGENT); }
__device__ __forceinline__ unsigned xb_add(unsigned* p, unsigned v) { return __hip_atomic_fetch_add(p, v, __ATOMIC_RELAXED, __HIP_MEMORY_SCOPE_AGENT); }
__device__ __forceinline__ unsigned xb_xcc_id() { return (unsigned)__builtin_amdgcn_s_getreg((3 << 11) | 20) & 0xFu; }
#define XB_SPIN(cond, bar) do { unsigned _sp = 0; while (cond) { __builtin_amdgcn_s_sleep(1); \
    if ((++_sp & 255u) == 0u) { if (xb_ld(&(bar)[XB_TMO])) break; if (_sp > XB_SPIN_CAP) { atomicAdd(&(bar)[XB_TMO], 1u); break; } } } } while (0)

struct XcdBarrier {
    unsigned* bar; unsigned x;
    volatile LAS unsigned* st;
};

__device__ __forceinline__ XcdBarrier xcd_barrier_post(unsigned* bar, volatile LAS unsigned* st) {
    XcdBarrier b; b.bar = bar; b.x = xb_xcc_id(); b.st = st;
    if (threadIdx.x == 0) (void)xb_add(&bar[XB_XCNT(b.x)], 1u);
    return b;
}
__device__ __forceinline__ void xcd_barrier_complete(unsigned* bar, unsigned x, unsigned& nloc, unsigned& nx) {
    const unsigned G = gridDim.x * gridDim.y * gridDim.z;
    unsigned sum, cnt, mine, sp = 0u;
    for (;;) {
        sum = 0u; cnt = 0u; mine = 0u;
#pragma unroll
        for (unsigned j = 0; j < 16; ++j) { const unsigned c = xb_ld(&bar[XB_XCNT(j)]); sum += c; cnt += (c > 0u) ? 1u : 0u; mine = (j == x) ? c : mine; }
        if (sum == G) break;
        __builtin_amdgcn_s_sleep(1);
        if ((++sp & 255u) == 0u) { if (xb_ld(&bar[XB_TMO])) break; if (sp > XB_SPIN_CAP) { atomicAdd(&bar[XB_TMO], 1u); break; } }
    }
    nloc = mine > 0u ? mine : 1u; nx = cnt > 0u ? cnt : 1u;
}

__device__ __forceinline__ void xcd_barrier(const XcdBarrier& b) {
    asm volatile("s_waitcnt vmcnt(0)" ::: "memory");
    __syncthreads();
    if (threadIdx.x == 0) {
        unsigned* bar = b.bar;
        __builtin_amdgcn_s_waitcnt(0);
        unsigned nloc = b.st[0], nx = b.st[1];
        if (nloc == 0u) { xcd_barrier_complete(bar, b.x, nloc, nx); b.st[0] = nloc; b.st[1] = nx; }
        const unsigned old = xb_add(&bar[XB_XSUB(b.x)], 1u);
        const unsigned gen = old / nloc;
        if (old + 1u == (gen + 1u) * nloc) {
            __builtin_amdgcn_fence(__ATOMIC_RELEASE, "agent");
            asm volatile("s_waitcnt vmcnt(0)" ::: "memory");
            const unsigned og = xb_add(&bar[XB_TOP], 1u);
            const unsigned tg = og / nx;
            if (og + 1u == (tg + 1u) * nx) xb_add(&bar[XB_TOPGEN], 1u);
            else XB_SPIN(xb_ld(&bar[XB_TOPGEN]) == tg, bar);
            __builtin_amdgcn_fence(__ATOMIC_ACQUIRE, "agent");
            xb_add(&bar[XB_XGEN(b.x)], 1u);
            asm volatile("s_waitcnt vmcnt(0)" ::: "memory");
        } else {
            XB_SPIN(xb_ld(&bar[XB_XGEN(b.x)]) == gen, bar);
            __builtin_amdgcn_fence(__ATOMIC_ACQUIRE, "agent");
            asm volatile("s_waitcnt vmcnt(0)" ::: "memory");
        }
    }
    __syncthreads();
}

__global__ void __launch_bounds__(512, 2) mk_fwd(Args a) {
    extern __shared__ __attribute__((aligned(16))) unsigned char lds_raw[];
    cg::grid_group grid = cg::this_grid();
    LAS unsigned char* lds = (LAS unsigned char*)lds_raw;
    const int G = gridDim.x, bid = blockIdx.x, NGW = G * 8, NGT = G * 512;
#define PH_BEGIN unsigned char* ws = a.ws; asm volatile("" : "+s"(ws)); int tid = threadIdx.x; asm volatile("" : "+v"(tid)); int l = ll; asm volatile("" : "+s"(l)); \
    const int lane = tid & 63, wave = __builtin_amdgcn_readfirstlane(tid >> 6), gw = bid * 8 + wave, gt = bid * 512 + tid; (void)lane; (void)wave; (void)gw; (void)gt; (void)l; (void)ws;
#define WP(T, off) ((T*)(ws + (off)))
#define WIN_T WP(bf16, WS_WIN)
#define WUP_T WP(bf16, WS_WUP)
#define WOUT_T WP(bf16, WS_WOUT)
#define WCQ_T WP(bf16, WS_WCQ)
#define WCKV_T WP(bf16, WS_WCKV)
#define WCO_T WP(bf16, WS_WCO)
#define WFF1_T WP(bf16, WS_WFF1)
#define WFF2_T WP(bf16, WS_WFF2)
#define WGLU_T WP(bf16, WS_WGLU)
#define POOLT WP(bf16, WS_POOLT)
#define WST WP(bf16, WS_WST)
#define AB WP(float, WS_AB)
#define BBT WP(bf16, WS_BBT)
#define CM WP(bf16, WS_CM)
#define MEMN WP(bf16, WS_MEMN)
#define KV WP(bf16, WS_KV)
#define LSE WP(float, WS_LSE)
#define Hn WP(bf16, WS_H)
#define MERGED WP(bf16, WS_MERGED)
#define TOT WP(float, WS_TOT)
#define BR WP(bf16, WS_BR)
#define PROJ WP(bf16, WS_PROJ)
#define Y WP(bf16, WS_Y)
#define Qb WP(bf16, WS_Q)
#define Ob WP(bf16, WS_O)
#define HID WP(bf16, WS_HID)
#define YFF WP(bf16, WS_YFF)
#define X (a.out)
#define IN(k) kin(k)
    volatile LAS unsigned* MISC = (volatile LAS unsigned*)(lds + LDS_BYTES - 64);
    if (threadIdx.x < 16) MISC[threadIdx.x] = 0u;
    __syncthreads();
    XcdBarrier xb = xcd_barrier_post((unsigned*)(a.ws + WS_CTL) + 4096, MISC + 8);
    grid.sync();
    for (int ll = 0; ll < DEPTH; ++ll) {
        { PH_BEGIN
            LAS float* scr = (LAS float*)(lds + wave * 16384);
            const float* w_in = IN(I_WIN) + (size_t)l * D * INW; const float* w_up = IN(I_WUP) + (size_t)l * 4 * 512 * 1024; const float* w_out = IN(I_WOUT) + (size_t)l * D * D;
            const float* w_cq = IN(I_WCQ) + (size_t)l * D * 512; const float* w_ckv = IN(I_WCKV) + (size_t)l * D * 1024; const float* w_co = IN(I_WCO) + (size_t)l * 512 * D;
            const float* w_ff1 = IN(I_WFF1) + (size_t)l * D * DFF; const float* w_ff2 = IN(I_WFF2) + (size_t)l * DFF * D; const float* w_glu = IN(I_WGLU) + (size_t)l * 512 * 512;
            const float* pool_w = IN(I_POOLW) + (size_t)l * 4 * 128 * 128;
            constexpr int N_WIN = (D / 64) * (INW / 32), N_UP = (512 / 64) * (1024 / 32), N_OUT = (D / 64) * (D / 32), N_CQ = (D / 64) * (512 / 32), N_CKV = (D / 64) * (1024 / 32),
                          N_CO = (512 / 64) * (D / 32), N_FF1 = (D / 64) * (DFF / 32), N_FF2 = (DFF / 64) * (D / 32), N_GLU = (512 / 64) * (512 / 32), N_POOL = (128 / 64) * (128 / 32);
            constexpr int NITEMS = N_WIN + 4 * N_UP + N_OUT + N_CQ + N_CKV + N_CO + N_FF1 + N_FF2 + N_GLU + 4 * N_POOL;
            for (int it = gw; it < NITEMS; it += NGW) {
                int r = it;
                if (r < N_WIN) { tr_item(w_in, D, INW, WIN_T, scr, r, lane); continue; } r -= N_WIN;
                if (r < 4 * N_UP) { const int i = r / N_UP; tr_item(w_up + (size_t)i * 512 * 1024, 512, 1024, WUP_T + (size_t)i * 1024 * 512, scr, r % N_UP, lane); continue; } r -= 4 * N_UP;
                if (r < N_OUT) { tr_item(w_out, D, D, WOUT_T, scr, r, lane); continue; } r -= N_OUT;
                if (r < N_CQ) { tr_item(w_cq, D, 512, WCQ_T, scr, r, lane); continue; } r -= N_CQ;
                if (r < N_CKV) { tr_item(w_ckv, D, 1024, WCKV_T, scr, r, lane); continue; } r -= N_CKV;
                if (r < N_CO) { tr_item(w_co, 512, D, WCO_T, scr, r, lane); continue; } r -= N_CO;
                if (r < N_FF1) { tr_item(w_ff1, D, DFF, WFF1_T, scr, r, lane); continue; } r -= N_FF1;
                if (r < N_FF2) { tr_item(w_ff2, DFF, D, WFF2_T, scr, r, lane); continue; } r -= N_FF2;
                if (r < N_GLU) { tr_item(w_glu, 512, 512, WGLU_T, scr, r, lane); continue; } r -= N_GLU;
                { const int i = r / N_POOL; tr_item(pool_w + (size_t)i * 128 * 128, 128, 128, POOLT + (size_t)i * 128 * 128, scr, r % N_POOL, lane); }
            }
            const float* w_s = IN(I_WS) + (size_t)l * 4 * 128 * 128;
            for (int e = gt; e < 4 * 128 * 128; e += NGT) { const int t = (e >> 7) & 127, s = e & 127; WST[e] = (s <= t) ? (bf16)f2bf(w_s[e]) : (bf16)0; }
            for (int e = gt; e < 32 * 64; e += NGT) {
                const int g = e >> 6, p = e & 63;
                const float are = fminf(IN(I_ARE)[(size_t)l * 2048 + e], -1e-4f), aim = IN(I_AIM)[(size_t)l * 2048 + e];
                const double lr = (double)are, li = (double)aim, dt = dexp((double)IN(I_LOGDT)[l * 32 + g]);
                const double mag = dexp_small(lr * dt); double sn, cs; dsincos(li * dt, sn, cs);
                const double abr = mag * cs, abi = mag * sn, den = lr * lr + li * li;
                const double fr_ = ((abr - 1.0) * lr + abi * li) / den, fi_ = (abi * lr - (abr - 1.0) * li) / den;
                AB[e * 2] = (float)abr; AB[e * 2 + 1] = (float)abi;
                const float* br_ = IN(I_BRE) + ((size_t)l * 2048 + e) * 16; const float* bi_ = IN(I_BIM) + ((size_t)l * 2048 + e) * 16;
                for (int c = 0; c < 16; ++c) { const double brc = br_[c], bic = bi_[c];
                    BBT[(g * 128 + p) * 16 + c] = (bf16)f2bf((float)(fr_ * brc - fi_ * bic)); BBT[(g * 128 + 64 + p) * 16 + c] = (bf16)f2bf((float)(fr_ * bic + fi_ * brc));
                    CM[(g * 16 + c) * 128 + p] = (bf16)f2bf(IN(I_CRE)[((size_t)l * 512 + g * 16 + c) * 64 + p]); CM[(g * 16 + c) * 128 + 64 + p] = (bf16)f2bf(-IN(I_CIM)[((size_t)l * 512 + g * 16 + c) * 64 + p]); }
            }
            for (int row = gw; row < NB * NMEM; row += NGW) rms_row_bf16(IN(I_MEM) + (size_t)row * D, IN(I_GMEM) + (size_t)l * D, MEMN + (size_t)row * D, lane);
            if (l == 0) for (int row = gw; row < M; row += NGW) rms_row_bf16(IN(I_X) + (size_t)row * D, IN(I_GMIXPRE), Hn + (size_t)row * D, lane);
        }
        xcd_barrier(xb);
        { PH_BEGIN
          pg8::Gemm g{MEMN, WCKV_T, NB * NMEM, 1024, D, D}; pg8::StaticOrder So; So.init(NB * NMEM, 1024, G, (bid + G / 2) % G);
          pg8::EpiPlain<0> E{KV, 1024, 1.f};
          pg8::gemm_phase<pg8::EpiPlain<0>, pg8::StaticOrder, true, true>(lds, g, So, E); }
        for (int hh = 0; hh < 2; ++hh) {
            { PH_BEGIN int hf = hh; asm volatile("" : "+s"(hf));
              pg8::Gemm g{Hn + (size_t)hf * MH * D, WIN_T, MH, INW, D, D}; pg8::StaticOrder So; So.init(MH, INW, G, bid);
              pg8::EpiProj E{PROJ, IN(I_GATEB) + (size_t)l * 4 * D};
              pg8::gemm_phase<pg8::EpiProj, pg8::StaticOrder, true, true>(lds, g, So, E); }
            xcd_barrier(xb);
            { PH_BEGIN int hf = hh; asm volatile("" : "+s"(hf));
                unsigned* ctr = (unsigned*)(ws + WS_CTL) + 8192 + (l * 2 + hf) * 64;
                volatile LAS int* nxt = (volatile LAS int*)(lds + LDS_BYTES - 64 + 16);
                if (tid == 0) { nxt[0] = (int)atomicAdd(ctr, 1u); nxt[1] = (int)atomicAdd(ctr, 1u); }
                __syncthreads();
                int u = nxt[0], un = nxt[1];
                __syncthreads();
                while (u < 1152) {
                    unsigned unn = 0u; if (tid == 0) unn = atomicAdd(ctr, 1u);
                    if (u < 128) ssm_unit(lds, PROJ, AB, BBT, CM, IN(I_DSKIP) + (size_t)l * 512, u, tid, lane, wave);
                    else if (u < 640) sgu_unit(lds, PROJ, WST, IN(I_LNG) + (size_t)l * 512, IN(I_LNB) + (size_t)l * 512, IN(I_BS) + (size_t)l * 512, BR + (size_t)3 * MH * 512, u - 128, tid, lane, wave);
                    else pool_unit(lds, PROJ, POOLT, IN(I_POOLS) + (size_t)l * 512, BR, u - 640, tid, lane, wave);
                    if (tid == 0) nxt[0] = (int)unn;
                    __syncthreads();
                    u = un; un = nxt[0];
                    __syncthreads();
                }
                if (u < 4224) {
                    AttnRegs<64> R;
                    { const DilU d = dil_decode(u - 1152, PROJ, LSE); attn_issue<64>(R, d.Qp, d.stride, d.Kp, d.Kp + 1536, d.stride, d.kfirst, tid, lane, wave); }
                    while (u < 4224) {
                        unsigned unn = 0u; if (tid == 0) unn = atomicAdd(ctr, 1u);
                        const DilU d = dil_decode(u - 1152, PROJ, LSE);
                        attn_stage<64, true>(lds, R, IN(I_RELB), d.dil, d.gh, tid);
                        bf16x8 qf[2] = {R.qf[0], R.qf[1]};
                        __syncthreads();
                        if (un < 4224) { const DilU dn = dil_decode(un - 1152, PROJ, LSE); attn_issue<64>(R, dn.Qp, dn.stride, dn.Kp, dn.Kp + 1536, dn.stride, dn.kfirst, tid, lane, wave); }
                        attn_compute<64, true>(lds, qf, d.kfirst, d.Qp, d.stride, d.lsep, d.dil, tid, lane, wave);
                        if (tid == 0) nxt[0] = (int)unn;
                        __syncthreads();
                        u = un; un = nxt[0];
                        __syncthreads();
                    }
                }
            }
            xcd_barrier(xb);
            { PH_BEGIN
                attn_merge(PROJ, LSE, BR + (size_t)1 * MH * 512, gt, NGT);
                pg8::Gemm g{PROJ + OFF_SSM, WGLU_T, MH, 512, 512, INW}; pg8::StaticOrder So; So.init(MH, 512, G, bid);
                pg8::EpiGlu E{PROJ, BR + (size_t)2 * MH * 512, IN(I_BGLU) + (size_t)l * 512};
                pg8::gemm_phase<pg8::EpiGlu, pg8::StaticOrder, true, true>(lds, g, So, E);
            }
            xcd_barrier(xb);
            { PH_BEGIN int hf = hh; asm volatile("" : "+s"(hf));
              pg8::Gemm g{BR, WUP_T, 4 * MH, 4 * 1024, 512, 512}; pg8::BranchOrder So{G, bid};
              pg8::EpiGateChain E{PROJ, MERGED + (size_t)hf * MH * D};
              pg8::gemm_phase<pg8::EpiGateChain, pg8::BranchOrder, true, true>(lds, g, So, E); }
            xcd_barrier(xb);
        }
        { PH_BEGIN
          pg8::Gemm g{MERGED, WOUT_T, M, D, D, D}; pg8::StaticOrder So; So.init(M, D, G, bid);
          pg8::EpiPlain<0> E{Y, D, 1.f};
          pg8::gemm_phase<pg8::EpiPlain<0>, pg8::StaticOrder, true, true>(lds, g, So, E); }
        xcd_barrier(xb);
        { PH_BEGIN rowpass(l == 0 ? IN(I_X) : X, Y, IN(I_GMIXPOST) + (size_t)l * D, IN(I_GXPRE) + (size_t)l * D, X, Hn, gw, NGW, lane); }
        xcd_barrier(xb);
        { PH_BEGIN
          pg8::Gemm g{Hn, WCQ_T, M, 512, D, D}; pg8::StaticOrder So; So.init(M, 512, G, bid);
          pg8::EpiPlain<0> E{Qb, 512, 0.08838834764831845f};
          pg8::gemm_phase<pg8::EpiPlain<0>, pg8::StaticOrder, true, true>(lds, g, So, E); }
        xcd_barrier(xb);
        { PH_BEGIN
          for (int bu = bid; bu < 256; bu += G) {
              const int bh = bu >> 3, b = bh >> 2, h = bh & 3, tile0 = b * 32 + (bu & 7) * 4;
              const bf16* Kp = KV + (size_t)b * NMEM * 1024 + h * 128;
              bf16x8 qf[4];
              { AttnRegs<128> R; attn_issue<128>(R, Qb + (size_t)tile0 * 128 * 512 + h * 128, 512, Kp, Kp + 512, 1024, 0, tid, lane, wave);
                attn_stage<128, false>(lds, R, nullptr, 1, 0, tid);
#pragma unroll
                for (int ks = 0; ks < 4; ++ks) qf[ks] = R.qf[ks]; }
              __syncthreads();
              for (int k = 0; k < 4; ++k) { const int tile = tile0 + k, tn = tile0 + min(k + 1, 3);
                  bf16x8 qn[4];
#pragma unroll
                  for (int ks = 0; ks < 4; ++ks) qn[ks] = *(const bf16x8*)(Qb + (size_t)(tn * 128 + 16 * wave + (lane & 15)) * 512 + h * 128 + 32 * ks + 8 * (lane >> 4));
                  attn_compute<128, false>(lds, qf, 0, Ob + (size_t)tile * 128 * 512 + h * 128, 512, nullptr, 1, tid, lane, wave);
#pragma unroll
                  for (int ks = 0; ks < 4; ++ks) qf[ks] = qn[ks]; } } }
        xcd_barrier(xb);
        { PH_BEGIN
          pg8::Gemm g{Ob, WCO_T, M, D, 512, 512}; pg8::StaticOrder So; So.init(M, D, G, bid);
          pg8::EpiPlain<0> E{Y, D, 1.f};
          pg8::gemm_phase<pg8::EpiPlain<0>, pg8::StaticOrder, true, true>(lds, g, So, E); }
        xcd_barrier(xb);
        { PH_BEGIN rowpass(X, Y, IN(I_GXPOST) + (size_t)l * D, IN(I_GFFPRE) + (size_t)l * D, X, Hn, gw, NGW, lane); }
        xcd_barrier(xb);
        { PH_BEGIN
          pg8::Gemm g{Hn, WFF1_T, M, DFF, D, D}; pg8::StaticOrder So; So.init(M, DFF, G, bid);
          pg8::EpiPlain<1> E{HID, DFF, 1.f};
          pg8::gemm_phase<pg8::EpiPlain<1>, pg8::StaticOrder, true, true>(lds, g, So, E); }
        xcd_barrier(xb);
        { PH_BEGIN
          pg8::Gemm g{HID, WFF2_T, M, D, DFF, DFF}; pg8::StaticOrder So; So.init(M, D, G, bid);
          pg8::EpiPlain<0> E{YFF, D, 1.f};
          pg8::gemm_phase<pg8::EpiPlain<0>, pg8::StaticOrder, true, true>(lds, g, So, E); }
        xcd_barrier(xb);
        { PH_BEGIN rowpass(X, YFF, IN(I_GFFPOST) + (size_t)l * D, (l + 1 < DEPTH) ? IN(I_GMIXPRE) + (size_t)(l + 1) * D : nullptr, X, Hn, gw, NGW, lane); }
        xcd_barrier(xb);
    }
}

extern "C" void kernel_launch(void* const* d_in, const int* in_sizes, int n_in, void* d_out, int out_size, void* d_ws, size_t ws_size, hipStream_t stream) {
    static int grid = 0;
    if (grid == 0) {
        if (n_in != 35 || in_sizes[0] != M * D || out_size != M * D || ws_size < WS_END) { fprintf(stderr, "kernel_launch: unexpected problem (n_in %d, ws %zu, need %zu)\n", n_in, ws_size, (size_t)WS_END); grid = -1; return; }
        int dev = 0, cus = 0, per_cu = 0;
        (void)hipGetDevice(&dev); (void)hipDeviceGetAttribute(&cus, hipDeviceAttributeMultiprocessorCount, dev);
        if (hipFuncSetAttribute((const void*)mk_fwd, hipFuncAttributeMaxDynamicSharedMemorySize, LDS_BYTES) != hipSuccess) { fprintf(stderr, "kernel_launch: hipFuncSetAttribute failed\n"); grid = -1; return; }
        if (hipOccupancyMaxActiveBlocksPerMultiprocessor(&per_cu, (const void*)mk_fwd, 512, LDS_BYTES) != hipSuccess || per_cu < 1) per_cu = 1;
        (void)hipGetLastError();
        grid = cus * 1;
        if (grid <= 0) grid = 256;
    }
    if (grid < 0) return;
    if (hipMemsetAsync((char*)d_ws + WS_CTL, 0, 65536, stream) != hipSuccess) { fprintf(stderr, "memset failed\n"); return; }
    Args a{};
    for (int i = 0; i < 35; ++i) a.in[i] = (const float*)d_in[i];
    a.out = (float*)d_out; a.ws = (unsigned char*)d_ws;
    void* args[] = {&a};
    hipError_t e = hipLaunchCooperativeKernel((const void*)mk_fwd, dim3(grid), dim3(512), args, LDS_BYTES, stream);
    if (e != hipSuccess) fprintf(stderr, "cooperative launch failed: %s (grid %d)\n", hipGetErrorString(e), grid);
}
```

```cpp
#include <hip/hip_runtime.h>
#include <hip/hip_cooperative_groups.h>
#include <cstdio>
#include <cstdint>
namespace cg = cooperative_groups;

constexpr int NB = 8, S = 4096, D = 1024, M = NB * S, MH = M / 2, DEPTH = 4, NMEM = 256;
constexpr int INW = 10752, OFF_ATT = 512, OFF_SSM = 5120, OFF_SGU = 5632, OFF_GATE = 6656;
constexpr int DFF = 4096;
constexpr float EPS = 1e-6f;

namespace pg8 {
#define PG8_LAS __attribute__((address_space(3)))
typedef unsigned short bf16_t;
typedef short bf16x8 __attribute__((ext_vector_type(8)));
typedef float f32x4 __attribute__((ext_vector_type(4)));
typedef unsigned u32x4 __attribute__((ext_vector_type(4)));
constexpr int BM = 256, BK = 64, HALF = 128, HTB = HALF * BK * 2  , STAGE_BYTES = 8 * HTB, NXCD = 8, WGM = 8;

__host__ __device__ __forceinline__ int lds_byte(int r, int c) { const int st = (r >> 4) * 2 + (c >> 5), rr = r & 15, cc = c & 31, ob = rr * 64 + cc * 2; return st * 1024 + (ob ^ (((ob >> 9) & 1) << 5)); }
__host__ __device__ __forceinline__ void stage_rc(int b, int& R, int& C) { const int st = b / 1024, sb = b % 1024, swz = sb ^ (((sb >> 9) & 1) << 5); R = (st >> 1) * 16 + swz / 64; C = (st & 1) * 32 + (swz % 64) / 2; }
__host__ __device__ __forceinline__ int perm32(int rho) { const int n = rho >> 4, i = rho & 15; return 8 * (i >> 2) + 4 * n + (i & 3); }

struct Unit { int pm, pn; };
struct Gemm { const bf16_t* A; const bf16_t* Bt; int M, N, K, lda; };

struct StaticOrder {
    int nM, nN, nwg, G, c;
    __host__ __device__ void init(int M, int N, int G_, int c_) { nM = M / BM; nN = N / BM; nwg = nM * nN; G = G_; c = c_; }
    __host__ __device__ bool next(int i, Unit& u) const {
        const long L = (long)i * G + c; if (L >= nwg) return false;
        int wgid = (int)L; { const int q = nwg / NXCD, r = nwg % NXCD, xcd = wgid % NXCD, off = wgid / NXCD; wgid = (xcd < r ? xcd * (q + 1) : r * (q + 1) + (xcd - r) * q) + off; }
        const int nig = WGM * nN, gid = wgid / nig, fm = gid * WGM, gsz = (nM - fm) < WGM ? (nM - fm) : WGM;
        u.pm = fm + ((wgid % nig) % gsz); u.pn = (wgid % nig) / gsz; return true;
    }
    __device__ __forceinline__ void a_ready(const Unit&) const {}
    __device__ __forceinline__ void done(const Unit&) const {}
};
__device__ __forceinline__ unsigned cvt_pk_bf16(float lo, float hi) { unsigned r; asm volatile("v_cvt_pk_bf16_f32 %0, %1, %2" : "=v"(r) : "v"(lo), "v"(hi)); return r; }
__device__ __forceinline__ float bflo(unsigned w) { return __builtin_bit_cast(float, w << 16); }
__device__ __forceinline__ float bfhi(unsigned w) { return __builtin_bit_cast(float, w & 0xffff0000u); }
__device__ __forceinline__ float sigm(float x) { return __builtin_amdgcn_rcpf(1.f + __expf(-x)); }
__device__ __forceinline__ float gelu_t(float x) { const float z = 1.5957691216057308f * (x + 0.044715f * x * x * x); return x * __builtin_amdgcn_rcpf(1.f + __expf(-z)); }

#define EPI_ARGS const f32x4 (&acc)[2][2][4][2], const Unit& u, int wr, int wc, int fr, int fq
#define EPI_FOR_ROWS _Pragma("unroll") for (int ai = 0; ai < 2; ++ai) _Pragma("unroll") for (int m = 0; m < 4; ++m)
#define EPI_FOR_BJ _Pragma("unroll") for (int bj = 0; bj < 2; ++bj)

struct EpiProj {
    static constexpr bool PERM = true, AFTER_DRAIN = false, CHAIN = false;
    bf16_t* O; const float* gb;
    __device__ __forceinline__ void operator()(EPI_ARGS) const {
        const int colt = u.pn * BM; const int mode = colt >= OFF_GATE ? 2 : (colt >= OFF_SGU ? 1 : 0);
        const int col0 = colt + wc * 32 + 8 * fq;
        f32x4 bv[2][2];
        EPI_FOR_BJ { _Pragma("unroll") for (int n = 0; n < 2; ++n) bv[bj][n] = (mode == 2) ? *(const f32x4*)(gb + (col0 - OFF_GATE) + bj * HALF + 4 * n) : (f32x4){0.f, 0.f, 0.f, 0.f}; }
        EPI_FOR_ROWS { const int row = u.pm * BM + ai * HALF + wr * 64 + m * 16 + fr; bf16_t* rowp = O + (size_t)row * INW + col0;
            EPI_FOR_BJ { f32x4 v0 = acc[ai][bj][m][0] + bv[bj][0], v1 = acc[ai][bj][m][1] + bv[bj][1];
                if (mode == 2) { _Pragma("unroll") for (int j = 0; j < 4; ++j) { v0[j] = sigm(v0[j]); v1[j] = sigm(v1[j]); } }
                else if (mode == 1) { _Pragma("unroll") for (int j = 0; j < 4; ++j) { v0[j] = gelu_t(v0[j]); v1[j] = gelu_t(v1[j]); } }
                u32x4 w; w.x = cvt_pk_bf16(v0[0], v0[1]); w.y = cvt_pk_bf16(v0[2], v0[3]); w.z = cvt_pk_bf16(v1[0], v1[1]); w.w = cvt_pk_bf16(v1[2], v1[3]);
                *(u32x4*)(rowp + bj * HALF) = w; } }
    }
};
template <int ACT  > struct EpiPlain {
    static constexpr bool PERM = true, AFTER_DRAIN = false, CHAIN = false;
    bf16_t* O; int ldc; float scale;
    __device__ __forceinline__ void operator()(EPI_ARGS) const {
        const int col0 = u.pn * BM + wc * 32 + 8 * fq;
        EPI_FOR_ROWS { const int row = u.pm * BM + ai * HALF + wr * 64 + m * 16 + fr; bf16_t* rowp = O + (size_t)row * ldc + col0;
            EPI_FOR_BJ { f32x4 v0 = acc[ai][bj][m][0], v1 = acc[ai][bj][m][1];
                if (ACT == 1) { _Pragma("unroll") for (int j = 0; j < 4; ++j) { const float a = fmaxf(v0[j], 0.f), b = fmaxf(v1[j], 0.f); v0[j] = a * a; v1[j] = b * b; } }
                v0 = v0 * scale; v1 = v1 * scale;
                u32x4 w; w.x = cvt_pk_bf16(v0[0], v0[1]); w.y = cvt_pk_bf16(v0[2], v0[3]); w.z = cvt_pk_bf16(v1[0], v1[1]); w.w = cvt_pk_bf16(v1[2], v1[3]);
                *(u32x4*)(rowp + bj * HALF) = w; } }
    }
};
struct EpiGlu {
    static constexpr bool PERM = true, AFTER_DRAIN = false, CHAIN = false;
    const bf16_t* G; bf16_t* O; const float* bias;
    __device__ __forceinline__ void operator()(EPI_ARGS) const {
        const int col0 = u.pn * BM + wc * 32 + 8 * fq;
        f32x4 bv[2][2];
        EPI_FOR_BJ { _Pragma("unroll") for (int n = 0; n < 2; ++n) bv[bj][n] = *(const f32x4*)(bias + col0 + bj * HALF + 4 * n); }
        EPI_FOR_ROWS { const int row = u.pm * BM + ai * HALF + wr * 64 + m * 16 + fr;
            EPI_FOR_BJ { const u32x4 gw = *(const u32x4*)(G + (size_t)row * INW + OFF_SSM + col0 + bj * HALF);
                f32x4 v0 = acc[ai][bj][m][0] + bv[bj][0], v1 = acc[ai][bj][m][1] + bv[bj][1];
                v0[0] = bflo(gw.x) * sigm(v0[0]); v0[1] = bfhi(gw.x) * sigm(v0[1]); v0[2] = bflo(gw.y) * sigm(v0[2]); v0[3] = bfhi(gw.y) * sigm(v0[3]);
                v1[0] = bflo(gw.z) * sigm(v1[0]); v1[1] = bfhi(gw.z) * sigm(v1[1]); v1[2] = bflo(gw.w) * sigm(v1[2]); v1[3] = bfhi(gw.w) * sigm(v1[3]);
                u32x4 w; w.x = cvt_pk_bf16(v0[0], v0[1]); w.y = cvt_pk_bf16(v0[2], v0[3]); w.z = cvt_pk_bf16(v1[0], v1[1]); w.w = cvt_pk_bf16(v1[2], v1[3]);
                *(u32x4*)(O + (size_t)row * 512 + col0 + bj * HALF) = w; } }
    }
};
struct EpiGateAcc {
    static constexpr bool PERM = true, AFTER_DRAIN = false, CHAIN = false;
    const bf16_t* P; float* TOT; bf16_t* O;
    __device__ __forceinline__ void operator()(EPI_ARGS) const {
        const int br = u.pn >> 2, pn = u.pn & 3, pm = u.pm & 63;
        const int col0 = pn * BM + wc * 32 + 8 * fq;
        EPI_FOR_ROWS { const int row = pm * BM + ai * HALF + wr * 64 + m * 16 + fr;
            EPI_FOR_BJ { const int col = col0 + bj * HALF;
                const u32x4 gw = *(const u32x4*)(P + (size_t)row * INW + OFF_GATE + br * 1024 + col);
                float* tp = TOT + (size_t)row * 1024 + col;
                f32x4 t0 = {0.f, 0.f, 0.f, 0.f}, t1 = {0.f, 0.f, 0.f, 0.f};
                if (br > 0) { t0 = *(const f32x4*)tp; t1 = *(const f32x4*)(tp + 4); }
                const f32x4 v0 = acc[ai][bj][m][0], v1 = acc[ai][bj][m][1];
                t0[0] += bflo(gw.x) * v0[0]; t0[1] += bfhi(gw.x) * v0[1]; t0[2] += bflo(gw.y) * v0[2]; t0[3] += bfhi(gw.y) * v0[3];
                t1[0] += bflo(gw.z) * v1[0]; t1[1] += bfhi(gw.z) * v1[1]; t1[2] += bflo(gw.w) * v1[2]; t1[3] += bfhi(gw.w) * v1[3];
                if (br < 3) { *(f32x4*)tp = t0; *(f32x4*)(tp + 4) = t1; }
                else { u32x4 w; w.x = cvt_pk_bf16(t0[0], t0[1]); w.y = cvt_pk_bf16(t0[2], t0[3]); w.z = cvt_pk_bf16(t1[0], t1[1]); w.w = cvt_pk_bf16(t1[2], t1[3]);
                    *(u32x4*)(O + (size_t)row * 1024 + col) = w; } } }
    }
};
struct EpiF32 {
    static constexpr bool PERM = false, AFTER_DRAIN = false, CHAIN = false;
    float* Y; int ldc;
    __device__ __forceinline__ void operator()(EPI_ARGS) const {
        const int col0 = u.pn * BM + wc * 32 + 4 * fq;
        EPI_FOR_ROWS { const int row = u.pm * BM + ai * HALF + wr * 64 + m * 16 + fr; float* rowp = Y + (size_t)row * ldc + col0;
            EPI_FOR_BJ { _Pragma("unroll") for (int n = 0; n < 2; ++n) *(f32x4*)(rowp + bj * HALF + n * 16) = acc[ai][bj][m][n]; } }
    }
};
struct EpiGateChain {
    static constexpr bool PERM = true, AFTER_DRAIN = false, CHAIN = true;
    const bf16_t* P; bf16_t* O;
    __device__ __forceinline__ void operator()(f32x4 (&acc)[2][2][4][2], const Unit& u, int wr, int wc, int fr, int fq) const {
        const int br = u.pn >> 2, pn = u.pn & 3, pm = u.pm & 63;
        const int col0 = pn * BM + wc * 32 + 8 * fq;
        const int noff = br < 3 ? 1024 : 0;
        EPI_FOR_ROWS { const int row = pm * BM + ai * HALF + wr * 64 + m * 16 + fr;
            const bf16_t* gp = P + (size_t)row * INW + OFF_GATE + br * 1024 + col0;
            u32x4 gc[2], gn[2];
            EPI_FOR_BJ { gc[bj] = *(const u32x4*)(gp + bj * HALF); gn[bj] = *(const u32x4*)(gp + noff + bj * HALF); }
            EPI_FOR_BJ { f32x4 v0 = acc[ai][bj][m][0], v1 = acc[ai][bj][m][1];
                v0[0] *= bflo(gc[bj].x); v0[1] *= bfhi(gc[bj].x); v0[2] *= bflo(gc[bj].y); v0[3] *= bfhi(gc[bj].y);
                v1[0] *= bflo(gc[bj].z); v1[1] *= bfhi(gc[bj].z); v1[2] *= bflo(gc[bj].w); v1[3] *= bfhi(gc[bj].w);
                if (br < 3) {
                    v0[0] *= __builtin_amdgcn_rcpf(fmaxf(bflo(gn[bj].x), 1e-30f)); v0[1] *= __builtin_amdgcn_rcpf(fmaxf(bfhi(gn[bj].x), 1e-30f)); v0[2] *= __builtin_amdgcn_rcpf(fmaxf(bflo(gn[bj].y), 1e-30f)); v0[3] *= __builtin_amdgcn_rcpf(fmaxf(bfhi(gn[bj].y), 1e-30f));
                    v1[0] *= __builtin_amdgcn_rcpf(fmaxf(bflo(gn[bj].z), 1e-30f)); v1[1] *= __builtin_amdgcn_rcpf(fmaxf(bfhi(gn[bj].z), 1e-30f)); v1[2] *= __builtin_amdgcn_rcpf(fmaxf(bflo(gn[bj].w), 1e-30f)); v1[3] *= __builtin_amdgcn_rcpf(fmaxf(bfhi(gn[bj].w), 1e-30f));
                    acc[ai][bj][m][0] = v0; acc[ai][bj][m][1] = v1; }
                else { u32x4 w; w.x = cvt_pk_bf16(v0[0], v0[1]); w.y = cvt_pk_bf16(v0[2], v0[3]); w.z = cvt_pk_bf16(v1[0], v1[1]); w.w = cvt_pk_bf16(v1[2], v1[3]);
                    *(u32x4*)(O + (size_t)row * 1024 + col0 + bj * HALF) = w;
                    acc[ai][bj][m][0] = (f32x4){0.f, 0.f, 0.f, 0.f}; acc[ai][bj][m][1] = (f32x4){0.f, 0.f, 0.f, 0.f}; } } }
    }
};
struct BranchOrder {
    int G, c;
    __device__ bool next(int i, Unit& u) const { const int r = i >> 2, br = i & 3, T = r * G + c; if (T >= 256) return false; u.pm = br * 64 + (T >> 2); u.pn = br * 4 + (T & 3); return true; }
    __device__ __forceinline__ void a_ready(const Unit&) const {}
    __device__ __forceinline__ void done(const Unit&) const {}
};
template <class Epi, class Sched, bool ALIGN_EPI = false, bool SP2 = false>
__device__ __forceinline__ void gemm_phase(PG8_LAS unsigned char* lds, const Gemm g, const Sched& S, const Epi& E) {
    int tid_ = threadIdx.x; asm volatile("" : "+v"(tid_)); const int tid = tid_, wid = __builtin_amdgcn_readfirstlane(tid >> 6), lane = tid & 63, wr = wid >> 2, wc = wid & 3, fr = lane & 15, fq = lane >> 4;
    const int K = g.K, nt = K / BK;
    unsigned voffA[2], voffB[2];
#pragma unroll
    for (int i = 0; i < 2; ++i) { int R, C; stage_rc(tid * 16 + i * 8192, R, C); const int Rb = Epi::PERM ? ((R & ~31) + perm32(R & 31)) : R;
        voffA[i] = (unsigned)(R * g.lda + C) * 2u; voffB[i] = (unsigned)(Rb * K + C) * 2u; }
    const size_t kstep = (size_t)(BK * 2);
    const size_t hstepA = (size_t)HALF * g.lda * 2, hstepB = (size_t)HALF * K * 2;
    const size_t tstepA = 2 * hstepA, tstepB = 2 * hstepB;
    const unsigned ldsw = (unsigned)wid * 1024u;
    const int aoff = lds_byte(wr * 64 + fr, fq * 8), boff = lds_byte(wc * 32 + fr, fq * 8);
#define PG8_SA(b, h) (((b) * 2 + (h)) * HTB)
#define PG8_SB(b, h) ((4 + (b) * 2 + (h)) * HTB)
#define PG8_STAGE(bufoff, gbase, voff) do { _Pragma("unroll") for (int _i = 0; _i < 2; ++_i) \
        __builtin_amdgcn_global_load_lds((const unsigned*)((const char*)(gbase) + (voff)[_i]), (PG8_LAS unsigned*)(lds + (bufoff) + ldsw + _i * 8192), 16, 0, 0); } while (0)
#define PG8_LDA(dst, b, h) do { _Pragma("unroll") for (int m = 0; m < 4; ++m) _Pragma("unroll") for (int k = 0; k < 2; ++k) dst[m][k] = *(const PG8_LAS bf16x8*)(lds + PG8_SA(b, h) + aoff + m * 2048 + k * 1024); } while (0)
#define PG8_LDB(dst, b, h) do { _Pragma("unroll") for (int n = 0; n < 2; ++n) _Pragma("unroll") for (int k = 0; k < 2; ++k) dst[n][k] = *(const PG8_LAS bf16x8*)(lds + PG8_SB(b, h) + boff + n * 2048 + k * 1024); } while (0)
#define PG8_MMA(ai, bj, At, Bt) do { __builtin_amdgcn_s_setprio(1); _Pragma("unroll") for (int m = 0; m < 4; ++m) _Pragma("unroll") for (int n = 0; n < 2; ++n) _Pragma("unroll") for (int k = 0; k < 2; ++k) \
        acc[ai][bj][m][n] = __builtin_amdgcn_mfma_f32_16x16x32_bf16(Bt[n][k], At[m][k], acc[ai][bj][m][n], 0, 0, 0); __builtin_amdgcn_s_setprio(0); } while (0)
#define PG8_WAIT_V(n) asm volatile("s_waitcnt vmcnt(" #n ")" ::: "memory")
#define PG8_WAIT_L(n) asm volatile("s_waitcnt lgkmcnt(" #n ")" ::: "memory")
#define PG8_BAR __builtin_amdgcn_s_barrier()
#define PG8_SCHED __builtin_amdgcn_sched_barrier(0)
    Unit cur, nxt; int ui = 0;
    if (!S.next(0, cur)) return;
    f32x4 acc[2][2][4][2];
#pragma unroll
    for (int a = 0; a < 2; ++a)
#pragma unroll
        for (int b = 0; b < 2; ++b)
#pragma unroll
            for (int m = 0; m < 4; ++m)
#pragma unroll
                for (int n = 0; n < 2; ++n) acc[a][b][m][n] = (f32x4){0.f, 0.f, 0.f, 0.f};
    bf16x8 At[4][2], B0[2][2], B1[2][2];
    const char* cA = (const char*)g.A + (size_t)cur.pm * tstepA; const char* cB = (const char*)g.Bt + (size_t)cur.pn * tstepB;
    S.a_ready(cur);
    if constexpr (SP2) {
        PG8_STAGE(PG8_SB(0, 0), cB, voffB); PG8_STAGE(PG8_SB(0, 1), cB + hstepB, voffB); PG8_STAGE(PG8_SA(0, 0), cA, voffA); PG8_STAGE(PG8_SA(0, 1), cA + hstepA, voffA);
        if (wr == 1) PG8_BAR;
        PG8_WAIT_V(2); PG8_BAR;
        PG8_STAGE(PG8_SB(1, 0), cB + kstep, voffB); PG8_STAGE(PG8_SA(1, 0), cA + kstep, voffA); PG8_STAGE(PG8_SB(1, 1), cB + hstepB + kstep, voffB);
        PG8_WAIT_V(6); PG8_BAR;
    } else {
        PG8_STAGE(PG8_SB(0, 0), cB, voffB); PG8_STAGE(PG8_SA(0, 0), cA, voffA); PG8_STAGE(PG8_SB(0, 1), cB + hstepB, voffB); PG8_STAGE(PG8_SA(0, 1), cA + hstepA, voffA);
        if (wr == 1) PG8_BAR;
        PG8_WAIT_V(4); PG8_BAR;
        PG8_STAGE(PG8_SB(1, 0), cB + kstep, voffB); PG8_STAGE(PG8_SA(1, 0), cA + kstep, voffA); PG8_STAGE(PG8_SB(1, 1), cB + hstepB + kstep, voffB);
        PG8_WAIT_V(6); PG8_BAR;
    }
    for (;;) {
        const bool has_next = S.next(ui + 1, nxt);
        const char* nA = has_next ? (const char*)g.A + (size_t)nxt.pm * tstepA : cA; const char* nB = has_next ? (const char*)g.Bt + (size_t)nxt.pn * tstepB : cB;
        for (int t = 0; t < nt; t += 2) {
            const bool last = (t == nt - 2);
            const char* a1 = cA + (size_t)(t + 1) * kstep;
            const char* a2 = last ? nA : cA + (size_t)(t + 2) * kstep; const char* b2 = last ? nB : cB + (size_t)(t + 2) * kstep;
            const char* a3 = a2 + kstep; const char* b3 = b2 + kstep;
            if (last && has_next) S.a_ready(nxt);
            if constexpr (SP2) {
            PG8_LDB(B0, 0, 0); PG8_LDB(B1, 0, 1); PG8_SCHED; PG8_LDA(At, 0, 0); PG8_STAGE(PG8_SA(1, 1), a1 + hstepA, voffA);
            PG8_WAIT_V(8); PG8_WAIT_L(0); PG8_BAR; PG8_MMA(0, 0, At, B0); PG8_MMA(0, 1, At, B1); PG8_BAR; PG8_SCHED;
            PG8_LDA(At, 0, 1); PG8_STAGE(PG8_SB(0, 0), b2, voffB); PG8_STAGE(PG8_SB(0, 1), b2 + hstepB, voffB); PG8_STAGE(PG8_SA(0, 0), a2, voffA);
            PG8_WAIT_V(8); PG8_WAIT_L(0); PG8_BAR; PG8_MMA(1, 0, At, B0); PG8_MMA(1, 1, At, B1); PG8_BAR; PG8_SCHED;
            PG8_LDB(B0, 1, 0); PG8_LDB(B1, 1, 1); PG8_SCHED; PG8_LDA(At, 1, 0); PG8_STAGE(PG8_SA(0, 1), a2 + hstepA, voffA);
            PG8_WAIT_V(8); PG8_WAIT_L(0); PG8_BAR; PG8_MMA(0, 0, At, B0); PG8_MMA(0, 1, At, B1); PG8_BAR; PG8_SCHED;
            PG8_LDA(At, 1, 1); PG8_STAGE(PG8_SB(1, 0), b3, voffB); PG8_STAGE(PG8_SB(1, 1), b3 + hstepB, voffB); PG8_STAGE(PG8_SA(1, 0), a3, voffA);
            PG8_WAIT_V(8); PG8_WAIT_L(0); PG8_BAR; PG8_MMA(1, 0, At, B0); PG8_MMA(1, 1, At, B1); PG8_BAR; PG8_SCHED;
            } else {
            PG8_LDB(B0, 0, 0); PG8_SCHED; PG8_LDA(At, 0, 0); PG8_STAGE(PG8_SA(1, 1), a1 + hstepA, voffA);
            PG8_WAIT_L(8); PG8_BAR; PG8_WAIT_L(0); PG8_MMA(0, 0, At, B0); PG8_BAR; PG8_SCHED;
            PG8_LDB(B1, 0, 1); PG8_STAGE(PG8_SB(0, 0), b2, voffB);
            PG8_BAR; PG8_WAIT_L(0); PG8_MMA(0, 1, At, B1); PG8_BAR;
            PG8_LDA(At, 0, 1); PG8_STAGE(PG8_SA(0, 0), a2, voffA);
            PG8_BAR; PG8_WAIT_L(0); PG8_MMA(1, 0, At, B0); PG8_BAR; PG8_SCHED;
            PG8_STAGE(PG8_SB(0, 1), b2 + hstepB, voffB);
            PG8_WAIT_V(6); PG8_BAR; PG8_MMA(1, 1, At, B1); PG8_BAR;
            PG8_LDB(B0, 1, 0); PG8_SCHED; PG8_LDA(At, 1, 0); PG8_STAGE(PG8_SA(0, 1), a2 + hstepA, voffA);
            PG8_WAIT_L(8); PG8_BAR; PG8_WAIT_L(0); PG8_MMA(0, 0, At, B0); PG8_BAR; PG8_SCHED;
            PG8_LDB(B1, 1, 1); PG8_STAGE(PG8_SB(1, 0), b3, voffB);
            PG8_BAR; PG8_WAIT_L(0); PG8_MMA(0, 1, At, B1); PG8_BAR;
            PG8_LDA(At, 1, 1); PG8_STAGE(PG8_SA(1, 0), a3, voffA);
            PG8_BAR; PG8_WAIT_L(0); PG8_MMA(1, 0, At, B0); PG8_BAR; PG8_SCHED;
            PG8_STAGE(PG8_SB(1, 1), b3 + hstepB, voffB);
            PG8_WAIT_V(6); PG8_BAR; PG8_MMA(1, 1, At, B1); PG8_BAR;
            }
        }
        if constexpr (ALIGN_EPI) { if (wr == 0) PG8_BAR; }
        if constexpr (!Epi::AFTER_DRAIN) { E(acc, cur, wr, wc, fr, fq); S.done(cur); }
        if (!has_next) break;
        if constexpr (!Epi::CHAIN) {
#pragma unroll
        for (int a = 0; a < 2; ++a)
#pragma unroll
            for (int b = 0; b < 2; ++b)
#pragma unroll
                for (int m = 0; m < 4; ++m)
#pragma unroll
                    for (int n = 0; n < 2; ++n) acc[a][b][m][n] = (f32x4){0.f, 0.f, 0.f, 0.f};
        }
        cur = nxt; cA = nA; cB = nB; ++ui;
        if constexpr (ALIGN_EPI) { if (wr == 1) PG8_BAR; }
    }
    PG8_WAIT_V(0);
    if constexpr (!ALIGN_EPI) { if (wr == 0) PG8_BAR; }
    PG8_BAR;
    if constexpr (Epi::AFTER_DRAIN) { E.fused(acc, cur, wr, wc, fr, fq, lds, wid, lane); S.done(cur); }
#undef PG8_SA
#undef PG8_SB
#undef PG8_STAGE
#undef PG8_LDA
#undef PG8_LDB
#undef PG8_MMA
#undef PG8_WAIT_V
#undef PG8_WAIT_L
#undef PG8_BAR
#undef PG8_SCHED
}
}

constexpr size_t MiB = 1u << 20, KiB = 1u << 10;
constexpr size_t WS_CTL = 0, CTL_BYTES = 1 * MiB;
constexpr size_t WS_WIN = 1 * MiB, WS_WUP = 22 * MiB, WS_WOUT = 26 * MiB, WS_WCQ = 28 * MiB, WS_WCKV = 29 * MiB, WS_WCO = 31 * MiB, WS_WFF1 = 32 * MiB, WS_WFF2 = 40 * MiB, WS_WGLU = 48 * MiB;
constexpr size_t WS_POOLT = 48 * MiB + 512 * KiB, WS_WST = WS_POOLT + 256 * KiB, WS_AB = WS_WST + 256 * KiB, WS_BBT = WS_AB + 256 * KiB, WS_CM = WS_BBT + 256 * KiB;
constexpr size_t WS_MEMN = 50 * MiB, WS_KV = 54 * MiB, WS_LSE = 58 * MiB, WS_H = 60 * MiB, WS_MERGED = 124 * MiB, WS_TOT = 188 * MiB, WS_BR = 252 * MiB, WS_PROJ = 316 * MiB, WS_END = 652 * MiB;
constexpr size_t WS_Y = WS_PROJ, WS_Q = 444 * MiB, WS_O = 476 * MiB, WS_HID = WS_PROJ, WS_YFF = WS_MERGED;
static_assert(WS_CM + 256 * KiB <= WS_MEMN && WS_PROJ + (size_t)MH * INW * 2 <= WS_END && WS_HID + (size_t)M * DFF * 2 <= WS_END && WS_YFF + (size_t)M * D * 4 <= WS_BR, "ws map");
constexpr int LDS_BYTES = 147456;

#define LAS __attribute__((address_space(3)))
typedef unsigned short bf16;
typedef unsigned v4u __attribute__((ext_vector_type(4)));
typedef unsigned v2u __attribute__((ext_vector_type(2)));
typedef float f32x4 __attribute__((ext_vector_type(4)));
typedef short bf16x8 __attribute__((ext_vector_type(8)));
using pg8::bflo; using pg8::bfhi; using pg8::sigm; using pg8::gelu_t;
__device__ __forceinline__ unsigned f2bf(float f) { unsigned u = __builtin_bit_cast(unsigned, f); return (u + 0x7fffu + ((u >> 16) & 1u)) >> 16; }
__device__ __forceinline__ unsigned pk2(float lo, float hi) { return f2bf(lo) | (f2bf(hi) << 16); }
__device__ __forceinline__ float bf2f(bf16 b) { return __builtin_bit_cast(float, (unsigned)b << 16); }
__device__ __forceinline__ float wave_sum(float v) {
#pragma unroll
    for (int o = 1; o < 64; o <<= 1) v += __shfl_xor(v, o);
    return v;
}
#define LDS_WAIT() asm volatile("s_waitcnt lgkmcnt(0)" ::: "memory")

struct Args { const float* in[35]; float* out; unsigned char* ws; };
enum { I_X = 0, I_MEM, I_RELB, I_GMIXPRE, I_GMIXPOST, I_WIN, I_GATEB, I_POOLW, I_POOLS, I_ARE, I_AIM, I_LOGDT, I_BRE, I_BIM, I_CRE, I_CIM, I_DSKIP, I_WGLU, I_BGLU,
       I_LNG, I_LNB, I_WS, I_BS, I_WUP, I_WOUT, I_GXPRE, I_GXPOST, I_GMEM, I_WCQ, I_WCKV, I_WCO, I_GFFPRE, I_GFFPOST, I_WFF1, I_WFF2 };

__device__ __forceinline__ void tr_item(const float* W, int K, int N, bf16* WT, LAS float* scr, int item, int lane) {
    const int nblk = N / 32, kb = item / nblk, nb = item % nblk, k0 = 64 * kb, n0 = 32 * nb;
#pragma unroll 8
    for (int i = 0; i < 32; ++i) { const int kk = 2 * i + (lane >> 5); scr[kk * 33 + (lane & 31)] = W[(size_t)(k0 + kk) * N + n0 + (lane & 31)]; }
    LDS_WAIT();
    const int c = lane & 7;
#pragma unroll
    for (int j = 0; j < 4; ++j) { const int n = (lane >> 3) + 8 * j; const LAS float* s = scr + (8 * c) * 33 + n;
        v4u o; o.x = pk2(s[0 * 33], s[1 * 33]); o.y = pk2(s[2 * 33], s[3 * 33]); o.z = pk2(s[4 * 33], s[5 * 33]); o.w = pk2(s[6 * 33], s[7 * 33]);
        *(v4u*)(WT + (size_t)(n0 + n) * K + k0 + 8 * c) = o; }
    LDS_WAIT();
}
__device__ __forceinline__ void rms_row_bf16(const float* xrow, const float* g, bf16* orow, int lane) {
    const f32x4* xr = (const f32x4*)xrow + lane; const f32x4* gr = (const f32x4*)g + lane;
    f32x4 v[4]; float s = 0.f;
#pragma unroll
    for (int j = 0; j < 4; ++j) { v[j] = xr[64 * j]; s += (v[j].x * v[j].x + v[j].y * v[j].y) + (v[j].z * v[j].z + v[j].w * v[j].w); }
    const float r = rsqrtf(wave_sum(s) * (1.f / D) + EPS);
    v2u* o8 = (v2u*)orow + lane;
#pragma unroll
    for (int j = 0; j < 4; ++j) { const f32x4 gv = gr[64 * j]; v2u w; w.x = pk2(v[j].x * r * gv.x, v[j].y * r * gv.y); w.y = pk2(v[j].z * r * gv.z, v[j].w * r * gv.w); o8[64 * j] = w; }
}
template <bool XIF, bool XOF>
__device__ __forceinline__ void rowpass(const void* Xi, const bf16* Y, const float* gpost, const float* gpre, void* Xo, bf16* Hh, int gw, int NGW, int lane) {
    constexpr int R = 4;
    f32x4 gp[4];
#pragma unroll
    for (int j = 0; j < 4; ++j) gp[j] = ((const f32x4*)gpost)[lane + 64 * j];
    for (int row0 = gw * R; row0 < M; row0 += NGW * R) {
        f32x4 y[R][4], x[R][4]; float s[R], s2[R];
#pragma unroll
        for (int q = 0; q < R; ++q) { const v2u* yr = (const v2u*)(Y + (size_t)(row0 + q) * D) + lane;
#pragma unroll
            for (int j = 0; j < 4; ++j) { const v2u yw = yr[64 * j]; y[q][j] = (f32x4){bflo(yw.x), bfhi(yw.x), bflo(yw.y), bfhi(yw.y)}; }
            if (XIF) { const f32x4* xr = (const f32x4*)((const float*)Xi + (size_t)(row0 + q) * D) + lane;
#pragma unroll
                for (int j = 0; j < 4; ++j) x[q][j] = xr[64 * j]; }
            else { const v2u* xr = (const v2u*)((const bf16*)Xi + (size_t)(row0 + q) * D) + lane;
#pragma unroll
                for (int j = 0; j < 4; ++j) { const v2u xw = xr[64 * j]; x[q][j] = (f32x4){bflo(xw.x), bfhi(xw.x), bflo(xw.y), bfhi(xw.y)}; } } }
#pragma unroll
        for (int q = 0; q < R; ++q) { s[q] = 0.f;
#pragma unroll
            for (int j = 0; j < 4; ++j) s[q] += (y[q][j].x * y[q][j].x + y[q][j].y * y[q][j].y) + (y[q][j].z * y[q][j].z + y[q][j].w * y[q][j].w); }
#pragma unroll
        for (int o = 1; o < 64; o <<= 1) {
#pragma unroll
            for (int q = 0; q < R; ++q) s[q] += __shfl_xor(s[q], o); }
#pragma unroll
        for (int q = 0; q < R; ++q) { const float r = rsqrtf(s[q] * (1.f / D) + EPS); s2[q] = 0.f;
#pragma unroll
            for (int j = 0; j < 4; ++j) { x[q][j] = x[q][j] + y[q][j] * r * gp[j];
                s2[q] += (x[q][j].x * x[q][j].x + x[q][j].y * x[q][j].y) + (x[q][j].z * x[q][j].z + x[q][j].w * x[q][j].w); }
            if (XOF) { f32x4* xo = (f32x4*)((float*)Xo + (size_t)(row0 + q) * D) + lane;
#pragma unroll
                for (int j = 0; j < 4; ++j) xo[64 * j] = x[q][j]; }
            else { v2u* xo = (v2u*)((bf16*)Xo + (size_t)(row0 + q) * D) + lane;
#pragma unroll
                for (int j = 0; j < 4; ++j) { v2u w; w.x = pk2(x[q][j].x, x[q][j].y); w.y = pk2(x[q][j].z, x[q][j].w); xo[64 * j] = w; } } }
        if (gpre) {
#pragma unroll
            for (int o = 1; o < 64; o <<= 1) {
#pragma unroll
                for (int q = 0; q < R; ++q) s2[q] += __shfl_xor(s2[q], o); }
#pragma unroll
            for (int q = 0; q < R; ++q) { const float r2 = rsqrtf(s2[q] * (1.f / D) + EPS); v2u* o8 = (v2u*)(Hh + (size_t)(row0 + q) * D) + lane;
#pragma unroll
                for (int j = 0; j < 4; ++j) { const f32x4 gv = ((const f32x4*)gpre)[lane + 64 * j]; v2u w; w.x = pk2(x[q][j].x * r2 * gv.x, x[q][j].y * r2 * gv.y); w.y = pk2(x[q][j].z * r2 * gv.z, x[q][j].w * r2 * gv.w); o8[64 * j] = w; } } }
    }
}
__device__ __forceinline__ int t5_bucket(int n) {
    if (n < 16) return n;
    return 16 + (n >= 22) + (n >= 30) + (n >= 40) + (n >= 54) + (n >= 73) + (n >= 99) + (n >= 134) + (n >= 182) + (n >= 246) + (n >= 332) + (n >= 450) + (n >= 609) + (n >= 825) + (n >= 1117) + (n >= 1513);
}
__device__ __forceinline__ double dexp_small(double x) {
    double t = 1.0, s = 1.0;
#pragma unroll
    for (int k = 1; k <= 16; ++k) { t *= x / (double)k; s += t; }
    return s;
}
__device__ __forceinline__ double dexp(double x) { double e = dexp_small(x * (1.0 / 32.0)); e *= e; e *= e; e *= e; e *= e; e *= e; return e; }
__device__ __forceinline__ void dsincos(double x, double& sn, double& cs) {
    const double TWO_PI = 6.283185307179586476925286766559;
    x -= TWO_PI * __builtin_rint(x * (1.0 / TWO_PI));
    const double r = x * 0.125, r2 = r * r;
    double st = r, ct = 1.0, s = r, c = 1.0;
#pragma unroll
    for (int k = 1; k <= 8; ++k) { ct *= -r2 / (double)((2 * k - 1) * (2 * k)); st *= -r2 / (double)((2 * k) * (2 * k + 1)); c += ct; s += st; }
#pragma unroll
    for (int k = 0; k < 3; ++k) { const double s2 = 2.0 * s * c, c2 = c * c - s * s; s = s2; c = c2; }
    sn = s; cs = c;
}
typedef short v4i16_t __attribute__((ext_vector_type(4)));
#define MFMA16(bfrag, afrag, c) __builtin_amdgcn_mfma_f32_16x16x32_bf16((bfrag), (afrag), (c), 0, 0, 0)
__device__ __forceinline__ void attn_naive(bf16* P, float* LSE, const float* relb, int gw, int NGW, int lane) {
    for (int uidx = gw; uidx < MH * 24; uidx += NGW) {
        const int r = uidx / 24, gh = uidx % 24, g = gh >> 3, h = gh & 7;
        const int t = r & (S - 1), dil = g == 0 ? 1 : (g == 1 ? 4 : 16);
        const int nd = min(t / dil, 128);
        bf16* prow = P + (size_t)r * INW + OFF_ATT + g * 512 + h * 64 + lane;
        const float q = bf2f(*prow);
        float mx = -1e30f, ss = 0.f, o = 0.f;
        for (int dist = 0; dist <= nd; ++dist) {
            const bf16* kp = prow - (size_t)dist * dil * INW;
            const float kv = bf2f(kp[1536]), vv = bf2f(kp[3072]);
            const float sc = wave_sum(q * kv) * 0.125f + relb[t5_bucket(dist * dil) * 24 + gh];
            const float mn = fmaxf(mx, sc), corr = __expf(mx - mn), p = __expf(sc - mn);
            ss = ss * corr + p; o = o * corr + p * vv; mx = mn;
        }
        *prow = (bf16)f2bf(o / ss);
        if (lane == 0) LSE[((size_t)g * MH + r) * 8 + h] = mx + __logf(ss);
    }
}
__device__ __forceinline__ void attn_merge(const bf16* __restrict__ P, const float* __restrict__ LSE, bf16* __restrict__ BR1, int gt, int NGT) {
#pragma unroll 4
    for (int e = gt; e < MH * 64; e += NGT) {
        const int r = e >> 6, ch = e & 63, h = ch >> 3;
        const float l0 = LSE[((size_t)0 * MH + r) * 8 + h], l1 = LSE[((size_t)1 * MH + r) * 8 + h], l2 = LSE[((size_t)2 * MH + r) * 8 + h];
        const float mx = fmaxf(l0, fmaxf(l1, l2));
        float w0 = __expf(l0 - mx), w1 = __expf(l1 - mx), w2 = __expf(l2 - mx); const float inv = 1.f / (w0 + w1 + w2); w0 *= inv; w1 *= inv; w2 *= inv;
        const bf16* base = P + (size_t)r * INW + OFF_ATT + ch * 8;
        const v4u a0 = *(const v4u*)base, a1 = *(const v4u*)(base + 512), a2 = *(const v4u*)(base + 1024);
        v4u o;
        o.x = pk2(w0 * bflo(a0.x) + w1 * bflo(a1.x) + w2 * bflo(a2.x), w0 * bfhi(a0.x) + w1 * bfhi(a1.x) + w2 * bfhi(a2.x));
        o.y = pk2(w0 * bflo(a0.y) + w1 * bflo(a1.y) + w2 * bflo(a2.y), w0 * bfhi(a0.y) + w1 * bfhi(a1.y) + w2 * bfhi(a2.y));
        o.z = pk2(w0 * bflo(a0.z) + w1 * bflo(a1.z) + w2 * bflo(a2.z), w0 * bfhi(a0.z) + w1 * bfhi(a1.z) + w2 * bfhi(a2.z));
        o.w = pk2(w0 * bflo(a0.w) + w1 * bflo(a1.w) + w2 * bflo(a2.w), w0 * bfhi(a0.w) + w1 * bfhi(a1.w) + w2 * bfhi(a2.w));
        *(v4u*)(BR1 + (size_t)r * 512 + ch * 8) = o;
    }
}
__device__ __forceinline__ void ssm_naive(bf16* P, const float* AB, const bf16* BBT, const bf16* CM, const float* dskip, int gw, int NGW, int lane) {
    for (int uidx = gw; uidx < 4 * 32; uidx += NGW) {
        const int bl = uidx >> 5, g = uidx & 31;
        float bbr[16], bbi[16], cr[16], ci[16];
#pragma unroll
        for (int c = 0; c < 16; ++c) { bbr[c] = bf2f(BBT[(g * 128 + lane) * 16 + c]); bbi[c] = bf2f(BBT[(g * 128 + 64 + lane) * 16 + c]);
            cr[c] = bf2f(CM[(g * 16 + c) * 128 + lane]); ci[c] = bf2f(CM[(g * 16 + c) * 128 + 64 + lane]); }
        const float ar = AB[(g * 64 + lane) * 2], ai = AB[(g * 64 + lane) * 2 + 1];
        const float dsk = dskip[g * 16 + (lane & 15)];
        float hr = 0.f, hi = 0.f;
        for (int t = 0; t < S; ++t) {
            bf16* up = P + (size_t)(bl * S + t) * INW + OFF_SSM + g * 16;
            const v4u u0 = *(const v4u*)up, u1 = *(const v4u*)(up + 8);
            const float ul = bf2f(up[lane & 15]);
            float u[16] = {bflo(u0.x), bfhi(u0.x), bflo(u0.y), bfhi(u0.y), bflo(u0.z), bfhi(u0.z), bflo(u0.w), bfhi(u0.w),
                           bflo(u1.x), bfhi(u1.x), bflo(u1.y), bfhi(u1.y), bflo(u1.z), bfhi(u1.z), bflo(u1.w), bfhi(u1.w)};
            float bur = 0.f, bui = 0.f;
#pragma unroll
            for (int c = 0; c < 16; ++c) { bur += bbr[c] * u[c]; bui += bbi[c] * u[c]; }
            const float nhr = ar * hr - ai * hi + bur, nhi = ar * hi + ai * hr + bui; hr = nhr; hi = nhi;
            float ym = 0.f;
#pragma unroll
            for (int c = 0; c < 16; ++c) { const float yc = wave_sum(cr[c] * hr + ci[c] * hi); if (lane == c) ym = yc; }
            if (lane < 16) up[lane] = (bf16)f2bf(gelu_t(ym + ul * dsk));
        }
    }
}
__device__ __forceinline__ void sgu_unit(LAS unsigned char* lds, const bf16* P, const bf16* WST, const float* lng, const float* lnb, const float* bs, bf16* BR3, int unit, int tid, int lane, int wave) {
    const int g = unit & 3, n = (unit >> 2) & 31, bl = unit >> 7;
    const int r0 = bl * S + n * 128;
    LAS float* stats = (LAS float*)lds; LAS bf16* VnT = (LAS bf16*)(lds + 1024);
    const int fr = lane & 15, fq = lane >> 4, tq = fr >> 2, tp = fr & 3, t = 16 * wave + fr, nks = (wave >> 1) + 1;
    v4u xs[16], vn[4]; bf16x8 wf[4]; v2u uw[8];
#pragma unroll
    for (int rr = 0; rr < 16; ++rr) xs[rr] = *(const v4u*)(P + (size_t)(r0 + 16 * wave + rr) * INW + OFF_SGU + 512 + lane * 8);
#pragma unroll
    for (int it = 0; it < 4; ++it) { const int idx = tid + 512 * it, s = idx >> 4, ch = (idx & 15) * 8; vn[it] = *(const v4u*)(P + (size_t)(r0 + s) * INW + OFF_SGU + 512 + g * 128 + ch); }
#pragma unroll
    for (int ks = 0; ks < 4; ++ks) wf[ks] = *(const bf16x8*)(WST + ((size_t)g * 128 + t) * 128 + 32 * ks + 8 * fq);
#pragma unroll
    for (int nt = 0; nt < 8; ++nt) uw[nt] = *(const v2u*)(P + (size_t)(r0 + t) * INW + OFF_SGU + g * 128 + 16 * nt + 4 * fq);
    const float bst = bs[g * 128 + t];
#pragma unroll
    for (int rr = 0; rr < 16; ++rr) { const int row = 16 * wave + rr; const v4u x = xs[rr];
        float v[8] = {bflo(x.x), bfhi(x.x), bflo(x.y), bfhi(x.y), bflo(x.z), bfhi(x.z), bflo(x.w), bfhi(x.w)};
        float s = 0.f;
#pragma unroll
        for (int j = 0; j < 8; ++j) s += v[j];
        const float mean = wave_sum(s) * (1.f / 512.f); float q = 0.f;
#pragma unroll
        for (int j = 0; j < 8; ++j) { const float d = v[j] - mean; q += d * d; }
        const float rstd = rsqrtf(wave_sum(q) * (1.f / 512.f) + EPS);
        if (lane == 0) { stats[row * 2] = mean; stats[row * 2 + 1] = rstd; } }
    __syncthreads();
#pragma unroll
    for (int it = 0; it < 4; ++it) { const int idx = tid + 512 * it, s = idx >> 4, ch = (idx & 15) * 8;
        const v4u x = vn[it];
        const float mean = stats[s * 2], rstd = stats[s * 2 + 1];
        float v[8] = {bflo(x.x), bfhi(x.x), bflo(x.y), bfhi(x.y), bflo(x.z), bfhi(x.z), bflo(x.w), bfhi(x.w)};
        const f32x4 g0 = *(const f32x4*)(lng + g * 128 + ch), g1 = *(const f32x4*)(lng + g * 128 + ch + 4), b0 = *(const f32x4*)(lnb + g * 128 + ch), b1 = *(const f32x4*)(lnb + g * 128 + ch + 4);
#pragma unroll
        for (int j = 0; j < 4; ++j) { v[j] = (v[j] - mean) * rstd * g0[j] + b0[j]; v[4 + j] = (v[4 + j] - mean) * rstd * g1[j] + b1[j]; }
        v4u w; w.x = pk2(v[0], v[1]); w.y = pk2(v[2], v[3]); w.z = pk2(v[4], v[5]); w.w = pk2(v[6], v[7]);
        *(LAS v4u*)(VnT + s * 136 + ch) = w;
    }
    __syncthreads();
    { f32x4 acc[8];
#pragma unroll
      for (int nt = 0; nt < 8; ++nt) acc[nt] = (f32x4){0.f, 0.f, 0.f, 0.f};
#pragma unroll
      for (int ks = 0; ks < 4; ++ks) if (ks < nks) {
#pragma unroll
          for (int nt = 0; nt < 8; ++nt) {
              const v4i16_t lo = __builtin_amdgcn_ds_read_tr16_b64_v4i16((LAS v4i16_t*)(VnT + (32 * ks + 8 * fq + tq) * 136 + 16 * nt + 4 * tp));
              const v4i16_t hi = __builtin_amdgcn_ds_read_tr16_b64_v4i16((LAS v4i16_t*)(VnT + (32 * ks + 8 * fq + 4 + tq) * 136 + 16 * nt + 4 * tp));
              const bf16x8 vf = {lo[0], lo[1], lo[2], lo[3], hi[0], hi[1], hi[2], hi[3]};
              acc[nt] = MFMA16(vf, wf[ks], acc[nt]); } }
#pragma unroll
      for (int nt = 0; nt < 8; ++nt) { const int c = 16 * nt + 4 * fq;
          v2u o; o.x = pk2(bflo(uw[nt].x) * (acc[nt][0] + bst), bfhi(uw[nt].x) * (acc[nt][1] + bst)); o.y = pk2(bflo(uw[nt].y) * (acc[nt][2] + bst), bfhi(uw[nt].y) * (acc[nt][3] + bst));
          *(v2u*)(BR3 + (size_t)(r0 + t) * 512 + g * 128 + c) = o; } }
    __syncthreads();
}
__device__ __forceinline__ void pool_unit(LAS unsigned char* lds, const bf16* P, const bf16* poolt, const float* pscale, bf16* BR0, int unit, int tid, int lane, int wave) {
    const int gi = unit & 3, tt = (unit >> 2) & 31, bl = unit >> 7;
    const int t0 = tt * 128, r0 = bl * S + t0, w = 2 << gi;
    LAS bf16* raw = (LAS bf16*)lds; LAS bf16* Pt = (LAS bf16*)(lds + 36864);
    const int fr = lane & 15, fq = lane >> 4;
    v4u rx[5];
#pragma unroll
    for (int it = 0; it < 5; ++it) { const int idx = tid + 512 * it, j = idx >> 4, ch = (idx & 15) * 8;
        rx[it] = (v4u){0u, 0u, 0u, 0u};
        if (idx < 144 * 16 && t0 - 16 + j >= 0) rx[it] = *(const v4u*)(P + (size_t)(r0 - 16 + j) * INW + gi * 128 + ch); }
    bf16x8 wfa[2][8];
#pragma unroll
    for (int ks = 0; ks < 2; ++ks)
#pragma unroll
        for (int nt = 0; nt < 8; ++nt) wfa[ks][nt] = *(const bf16x8*)(poolt + ((size_t)gi * 128 + 16 * nt + fr) * 128 + 32 * ks + 8 * fq);
#pragma unroll
    for (int it = 0; it < 5; ++it) { const int idx = tid + 512 * it, j = idx >> 4, ch = (idx & 15) * 8; if (idx < 144 * 16) *(LAS v4u*)(raw + j * 128 + ch) = rx[it]; }
    __syncthreads();
    { const int c = tid & 127, tq = tid >> 7, tb0 = tq * 32; const float rc = 1.f / (float)w;
      float s = 0.f;
      for (int j = 0; j < w; ++j) s += bf2f(raw[(16 + tb0 - j) * 128 + c]);
      for (int i = 0; i < 32; ++i) { const int t = tb0 + i; const int cnt = min(t0 + t + 1, w);
          const float cur = bf2f(raw[(16 + t) * 128 + c]);
          const float mean = (cnt == w) ? s * rc : s / (float)cnt;
          Pt[t * 136 + c] = (bf16)f2bf(mean - cur);
          s += bf2f(raw[(17 + t) * 128 + c]) - bf2f(raw[(17 + t - w) * 128 + c]); } }
    __syncthreads();
    { const int t = 16 * wave + fr;
      f32x4 acc[8];
#pragma unroll
      for (int nt = 0; nt < 8; ++nt) acc[nt] = (f32x4){0.f, 0.f, 0.f, 0.f};
#pragma unroll
      for (int ks = 0; ks < 4; ++ks) { const bf16x8 pf = *(const LAS bf16x8*)(Pt + t * 136 + 32 * ks + 8 * fq);
#pragma unroll
          for (int nt = 0; nt < 8; ++nt) { const bf16x8 wf = ks < 2 ? wfa[ks & 1][nt] : *(const bf16x8*)(poolt + ((size_t)gi * 128 + 16 * nt + fr) * 128 + 32 * ks + 8 * fq); acc[nt] = MFMA16(wf, pf, acc[nt]); } }
#pragma unroll
      for (int nt = 0; nt < 8; ++nt) { const int d = 16 * nt + 4 * fq; const f32x4 sc = *(const f32x4*)(pscale + gi * 128 + d);
          v2u o; o.x = pk2(acc[nt][0] * sc[0], acc[nt][1] * sc[1]); o.y = pk2(acc[nt][2] * sc[2], acc[nt][3] * sc[3]);
          *(v2u*)(BR0 + (size_t)(r0 + t) * 512 + gi * 128 + d) = o; } }
    __syncthreads();
}
__device__ __forceinline__ void xattn_naive(const bf16* Q, const bf16* KV, bf16* O, int gw, int NGW, int lane) {
    for (int uidx = gw; uidx < M * 4; uidx += NGW) {
        const int T = uidx >> 2, h = uidx & 3, b = T / S;
        const unsigned qw = *(const unsigned*)(Q + (size_t)T * 512 + h * 128 + 2 * lane);
        const float q0 = bflo(qw), q1 = bfhi(qw);
        float mx = -1e30f, ss = 0.f, o0 = 0.f, o1 = 0.f;
        for (int j = 0; j < NMEM; ++j) {
            const bf16* kr = KV + (size_t)(b * NMEM + j) * 1024 + h * 128 + 2 * lane;
            const unsigned kw = *(const unsigned*)kr, vw = *(const unsigned*)(kr + 512);
            const float sc = wave_sum(q0 * bflo(kw) + q1 * bfhi(kw));
            const float mn = fmaxf(mx, sc), corr = __expf(mx - mn), p = __expf(sc - mn);
            ss = ss * corr + p; o0 = o0 * corr + p * bflo(vw); o1 = o1 * corr + p * bfhi(vw); mx = mn;
        }
        const float inv = 1.f / ss;
        *(unsigned*)(O + (size_t)T * 512 + h * 128 + 2 * lane) = pk2(o0 * inv, o1 * inv);
    }
}
__device__ __forceinline__ void ssm_unit(LAS unsigned char* lds, bf16* P, const float* ABp, const bf16* BBTp, const bf16* CMp, const float* dskip, int unit, int tid, int lane, int wave) {
    const int bl = unit >> 5, g = unit & 31, fr = lane & 15, fq = lane >> 4;
    LAS float* bu = (LAS float*)(lds + wave * 16896);
    LAS bf16* hb = (LAS bf16*)(lds + wave * 16896);
    LAS float* ends = (LAS float*)(lds + 135168);
    const bf16x8 z8 = {0, 0, 0, 0, 0, 0, 0, 0};
    bf16x8 bbf[8], cmf[4];
#pragma unroll
    for (int nt = 0; nt < 8; ++nt) bbf[nt] = fq < 2 ? *(const bf16x8*)(BBTp + (size_t)(g * 128 + 16 * nt + fr) * 16 + 8 * fq) : z8;
#pragma unroll
    for (int ks = 0; ks < 4; ++ks) cmf[ks] = *(const bf16x8*)(CMp + (size_t)(g * 16 + fr) * 128 + 32 * ks + 8 * fq);
    const float ar = ABp[(g * 64 + lane) * 2], ai = ABp[(g * 64 + lane) * 2 + 1];
    float pr = ar, pi = ai;
#pragma unroll
    for (int i = 0; i < 5; ++i) { const float nr = pr * pr - pi * pi, ni = 2.f * pr * pi; pr = nr; pi = ni; }
    const f32x4 dsk = *(const f32x4*)(dskip + g * 16 + 4 * fq);
    float cr = 0.f, ci = 0.f;
    bf16x8 uf[2]; v2u uep[2], uepn[2];
#pragma unroll
    for (int mt = 0; mt < 2; ++mt) { const bf16* up = P + (size_t)(bl * S + wave * 32 + 16 * mt + fr) * INW + OFF_SSM + g * 16;
        uf[mt] = fq < 2 ? *(const bf16x8*)(up + 8 * fq) : z8; uep[mt] = *(const v2u*)(up + 4 * fq); }
    for (int ms = 0; ms < 16; ++ms) {
        const int rbase = bl * S + ms * 256 + wave * 32;
#pragma unroll
        for (int mt = 0; mt < 2; ++mt)
#pragma unroll
            for (int nt = 0; nt < 8; ++nt) { f32x4 acc = {0.f, 0.f, 0.f, 0.f}; acc = MFMA16(bbf[nt], uf[mt], acc);
                *(LAS f32x4*)(bu + (16 * mt + fr) * 132 + 16 * nt + 4 * fq) = acc; }
        { const int rn = bl * S + min(ms + 1, 15) * 256 + wave * 32;
#pragma unroll
          for (int mt = 0; mt < 2; ++mt) { const bf16* up = P + (size_t)(rn + 16 * mt + fr) * INW + OFF_SSM + g * 16;
              uf[mt] = fq < 2 ? *(const bf16x8*)(up + 8 * fq) : z8; uepn[mt] = *(const v2u*)(up + 4 * fq); } }
        LDS_WAIT();
        float hr = 0.f, hi = 0.f;
#pragma unroll 8
        for (int t = 0; t < 32; ++t) { const float br = bu[t * 132 + lane], bi = bu[t * 132 + 64 + lane];
            const float nhr = ar * hr - ai * hi + br, nhi = ar * hi + ai * hr + bi; hr = nhr; hi = nhi; }
        ends[wave * 128 + lane] = hr; ends[wave * 128 + 64 + lane] = hi;
        __syncthreads();
        float sr = cr, si = ci, myr = cr, myi = ci;
#pragma unroll
        for (int w = 0; w < 8; ++w) { if (w == wave) { myr = sr; myi = si; }
            const float er = ends[w * 128 + lane], ei = ends[w * 128 + 64 + lane];
            const float nsr = pr * sr - pi * si + er, nsi = pr * si + pi * sr + ei; sr = nsr; si = nsi; }
        cr = sr; ci = si;
        hr = myr; hi = myi;
#pragma unroll 8
        for (int t = 0; t < 32; ++t) { const float br = bu[t * 132 + lane], bi = bu[t * 132 + 64 + lane];
            const float nhr = ar * hr - ai * hi + br, nhi = ar * hi + ai * hr + bi; hr = nhr; hi = nhi;
            hb[t * 136 + lane] = (bf16)f2bf(hr); hb[t * 136 + 64 + lane] = (bf16)f2bf(hi); }
        LDS_WAIT();
#pragma unroll
        for (int mt = 0; mt < 2; ++mt) { f32x4 acc = {0.f, 0.f, 0.f, 0.f};
#pragma unroll
            for (int ks = 0; ks < 4; ++ks) { const bf16x8 hf_ = *(const LAS bf16x8*)(hb + (16 * mt + fr) * 136 + 32 * ks + 8 * fq); acc = MFMA16(cmf[ks], hf_, acc); }
            const float y0 = gelu_t(acc[0] + bflo(uep[mt].x) * dsk[0]), y1 = gelu_t(acc[1] + bfhi(uep[mt].x) * dsk[1]);
            const float y2 = gelu_t(acc[2] + bflo(uep[mt].y) * dsk[2]), y3 = gelu_t(acc[3] + bfhi(uep[mt].y) * dsk[3]);
            v2u o; o.x = pk2(y0, y1); o.y = pk2(y2, y3);
            *(v2u*)(P + (size_t)(rbase + 16 * mt + fr) * INW + OFF_SSM + g * 16 + 4 * fq) = o; }
        uep[0] = uepn[0]; uep[1] = uepn[1];
        __syncthreads();
    }
}
template <int HD> struct AttnRegs { v4u kx[256 * (HD / 8) / 512], vx[256 * (HD / 8) / 512]; bf16x8 qf[HD / 32]; };
template <int HD>
__device__ __forceinline__ void attn_issue(AttnRegs<HD>& R, const bf16* Qp, size_t qstride, const bf16* Kp, const bf16* Vp, size_t kstride, int kfirst, int tid, int lane, int wave) {
    constexpr int CPR = HD / 8, NIT = 256 * CPR / 512, KST = HD / 32;
#pragma unroll
    for (int it = 0; it < NIT; ++it) { const int idx = tid + 512 * it, kk = idx / CPR, cc = idx % CPR;
        R.kx[it] = (v4u){0u, 0u, 0u, 0u}; R.vx[it] = (v4u){0u, 0u, 0u, 0u};
        if (kk >= kfirst) { R.kx[it] = *(const v4u*)(Kp + (ptrdiff_t)kk * (ptrdiff_t)kstride + cc * 8); R.vx[it] = *(const v4u*)(Vp + (ptrdiff_t)kk * (ptrdiff_t)kstride + cc * 8); } }
    const int qi = 16 * wave + (lane & 15), fq = lane >> 4;
#pragma unroll
    for (int ks = 0; ks < KST; ++ks) R.qf[ks] = *(const bf16x8*)(Qp + (size_t)qi * qstride + 32 * ks + 8 * fq);
}
template <int HD, bool DIL>
__device__ __forceinline__ void attn_stage(LAS unsigned char* lds, const AttnRegs<HD>& R, const float* relb, int dil, int gh, int tid) {
    constexpr int PITCH = HD + 8, CPR = HD / 8, NIT = 256 * CPR / 512;
    LAS bf16* Ks = (LAS bf16*)lds; LAS bf16* Vs = (LAS bf16*)(lds + 256 * PITCH * 2); LAS float* tb = (LAS float*)(lds + 2 * 256 * PITCH * 2);
#pragma unroll
    for (int it = 0; it < NIT; ++it) { const int idx = tid + 512 * it, kk = idx / CPR, cc = idx % CPR;
        *(LAS v4u*)(Ks + kk * PITCH + cc * 8) = R.kx[it]; *(LAS v4u*)(Vs + kk * PITCH + cc * 8) = R.vx[it]; }
    if (DIL) { if (tid < 256) { const int dist = tid - 64; tb[tid] = (dist >= 0 && dist <= 128) ? relb[t5_bucket(dist * dil) * 24 + gh] * 1.4426950408889634f : 0.f; } }
}
template <int HD, bool DIL>
__device__ __forceinline__ void attn_compute(LAS unsigned char* lds, const bf16x8 (&qf)[HD / 32], int kfirst, bf16* Op, size_t ostride, float* lsep, int dil, int tid, int lane, int wave) {
    constexpr int PITCH = HD + 8, KST = HD / 32, NDT = HD / 16, NT = DIL ? 10 : 16, NK2 = NT / 2;
    const int ntb = DIL ? (wave & ~1) : 0;
    LAS bf16* Ks = (LAS bf16*)lds; LAS bf16* Vs = (LAS bf16*)(lds + 256 * PITCH * 2); LAS float* tb = (LAS float*)(lds + 2 * 256 * PITCH * 2);
    const int fr = lane & 15, fq = lane >> 4;
    const int qi = 16 * wave + fr;
    f32x4 sacc[NT];
#pragma unroll
    for (int nt = 0; nt < NT; ++nt) { f32x4 acc = {0.f, 0.f, 0.f, 0.f};
#pragma unroll
        for (int ks = 0; ks < KST; ++ks) { const bf16x8 kf = *(const LAS bf16x8*)(Ks + (16 * (ntb + nt) + fr) * PITCH + 32 * ks + 8 * fq); acc = MFMA16(kf, qf[ks], acc); }
        sacc[nt] = acc; }
    const LAS float* tbl = tb + (33 + qi - 16 * ntb - 4 * fq);
    constexpr float SC = DIL ? 0.125f * 1.4426950408889634f : 1.4426950408889634f;
    const int dbase = 128 + qi - 16 * ntb - 4 * fq;
    const unsigned dmax = DIL ? (unsigned)(kfirst ? qi : 128) : 0u;
    float mx = -1e30f;
#pragma unroll
    for (int nt = 0; nt < NT; ++nt)
#pragma unroll
        for (int j = 0; j < 4; ++j) { float s = sacc[nt][j];
            if (DIL) { const unsigned dist = (unsigned)(dbase - (16 * nt + j));
                const float bv = tbl[159 - (16 * nt + j)];
                s = dist <= dmax ? fmaf(s, SC, bv) : -1e30f; }
            else s *= SC;
            sacc[nt][j] = s; mx = fmaxf(mx, s); }
    mx = fmaxf(mx, __shfl_xor(mx, 16)); mx = fmaxf(mx, __shfl_xor(mx, 32));
    float sum = 0.f;
    bf16x8 pf[NK2];
#pragma unroll
    for (int k2 = 0; k2 < NK2; ++k2) { float p[8];
#pragma unroll
        for (int j = 0; j < 4; ++j) { p[j] = __builtin_amdgcn_exp2f(sacc[2 * k2][j] - mx); p[4 + j] = __builtin_amdgcn_exp2f(sacc[2 * k2 + 1][j] - mx); }
#pragma unroll
        for (int j = 0; j < 8; ++j) sum += p[j];
        v4u w; w.x = pk2(p[0], p[1]); w.y = pk2(p[2], p[3]); w.z = pk2(p[4], p[5]); w.w = pk2(p[6], p[7]);
        pf[k2] = __builtin_bit_cast(bf16x8, w); }
    sum += __shfl_xor(sum, 16); sum += __shfl_xor(sum, 32);
    const float inv = 1.f / sum;
    const int tq = fr >> 2, tp = fr & 3;
#pragma unroll
    for (int dt = 0; dt < NDT; ++dt) { f32x4 oacc = {0.f, 0.f, 0.f, 0.f};
#pragma unroll
        for (int k2 = 0; k2 < NK2; ++k2) {
            const v4i16_t lo = __builtin_amdgcn_ds_read_tr16_b64_v4i16((LAS v4i16_t*)(Vs + (16 * ntb + 32 * k2 + 4 * fq + tq) * PITCH + 16 * dt + 4 * tp));
            const v4i16_t hi = __builtin_amdgcn_ds_read_tr16_b64_v4i16((LAS v4i16_t*)(Vs + (16 * ntb + 32 * k2 + 16 + 4 * fq + tq) * PITCH + 16 * dt + 4 * tp));
            const bf16x8 vf = {lo[0], lo[1], lo[2], lo[3], hi[0], hi[1], hi[2], hi[3]};
            oacc = MFMA16(vf, pf[k2], oacc); }
        v2u o; o.x = pk2(oacc[0] * inv, oacc[1] * inv); o.y = pk2(oacc[2] * inv, oacc[3] * inv);
        *(v2u*)(Op + (size_t)qi * ostride + 16 * dt + 4 * fq) = o; }
    if (DIL) { if (fq == 0) lsep[(size_t)qi * 8 * dil] = (mx + __log2f(sum)) * 0.6931471805599453f; }
    __syncthreads();
}
struct DilU { bf16* Qp; const bf16* Kp; size_t stride; float* lsep; int kfirst, dil, gh; };
__device__ __forceinline__ DilU dil_decode(int v, bf16* PROJp, float* LSEp) {
    const int h = v & 7, j32 = (v >> 3) & 31, bg = v >> 8, g = bg % 3, bl = bg / 3, dil = g == 0 ? 1 : (g == 1 ? 4 : 16), res = j32 % dil, n = j32 / dil;
    const int rq0 = bl * S + 128 * n * dil + res;
    DilU d; d.Qp = PROJp + (size_t)rq0 * INW + OFF_ATT + g * 512 + h * 64; d.Kp = d.Qp + 1536 - (ptrdiff_t)128 * dil * INW; d.stride = (size_t)dil * INW;
    d.lsep = LSEp + ((size_t)g * MH + rq0) * 8 + h; d.kfirst = n == 0 ? 128 : 0; d.dil = dil; d.gh = g * 8 + h; return d;
}
__device__ __forceinline__ const float* kin(int k) { int kk = k; asm volatile("" : "+s"(kk)); return ((const float* const __attribute__((address_space(4)))*)__builtin_amdgcn_kernarg_segment_ptr())[kk]; }
typedef __attribute__((address_space(1))) unsigned gu32;
#define XB_TMO      128
#define XB_XCNT(j)  (256  + 64 * (j))
#define XB_XSUB(j)  (1280 + 64 * (j))
#define XB_XGEN(j)  (2304 + 64 * (j))
#define XB_TOP      3328
#define XB_TOPGEN   3392
#define XCD_BAR_WORDS 3456
#define XB_SPIN_CAP (1u << 18)

__device__ __forceinline__ unsigned xb_ld(unsigned* p)              { return __hip_atomic_load(p, __ATOMIC_RELAXED, __HIP_MEMORY_SCOPE_AGENT); }
__device__ __forceinline__ unsigned xb_add(unsigned* p, unsigned v) { return __hip_atomic_fetch_add(p, v, __ATOMIC_RELAXED, __HIP_MEMORY_SCOPE_AGENT); }
__device__ __forceinline__ unsigned xb_xcc_id() { return (unsigned)__builtin_amdgcn_s_getreg((3 << 11) | 20) & 0xFu; }
#define XB_SPIN(cond, bar) do { unsigned _sp = 0; while (cond) { __builtin_amdgcn_s_sleep(1); \
    if ((++_sp & 255u) == 0u) { if (xb_ld(&(bar)[XB_TMO])) break; if (_sp > XB_SPIN_CAP) { atomicAdd(&(bar)[XB_TMO], 1u); break; } } } } while (0)

struct XcdBarrier {
    unsigned* bar; unsigned x;
    volatile LAS unsigned* st;
};

__device__ __forceinline__ XcdBarrier xcd_barrier_post(unsigned* bar, volatile LAS unsigned* st) {
    XcdBarrier b; b.bar = bar; b.x = xb_xcc_id(); b.st = st;
    if (threadIdx.x == 0) (void)xb_add(&bar[XB_XCNT(b.x)], 1u);
    return b;
}
__device__ __forceinline__ void xcd_barrier_complete(unsigned* bar, unsigned x, unsigned& nloc, unsigned& nx) {
    const unsigned G = gridDim.x * gridDim.y * gridDim.z;
    unsigned sum, cnt, mine, sp = 0u;
    for (;;) {
        sum = 0u; cnt = 0u; mine = 0u;
#pragma unroll
        for (unsigned j = 0; j < 16; ++j) { const unsigned c = xb_ld(&bar[XB_XCNT(j)]); sum += c; cnt += (c > 0u) ? 1u : 0u; mine = (j == x) ? c : mine; }
        if (sum == G) break;
        __builtin_amdgcn_s_sleep(1);
        if ((++sp & 255u) == 0u) { if (xb_ld(&bar[XB_TMO])) break; if (sp > XB_SPIN_CAP) { atomicAdd(&bar[XB_TMO], 1u); break; } }
    }
    nloc = mine > 0u ? mine : 1u; nx = cnt > 0u ? cnt : 1u;
}

__device__ __forceinline__ void xcd_barrier(const XcdBarrier& b) {
    asm volatile("s_waitcnt vmcnt(0)" ::: "memory");
    __syncthreads();
    if (threadIdx.x == 0) {
        unsigned* bar = b.bar;
        __builtin_amdgcn_s_waitcnt(0);
        unsigned nloc = b.st[0], nx = b.st[1];
        if (nloc == 0u) { xcd_barrier_complete(bar, b.x, nloc, nx); b.st[0] = nloc; b.st[1] = nx; }
        const unsigned old = xb_add(&bar[XB_XSUB(b.x)], 1u);
        const unsigned gen = old / nloc;
        if (old + 1u == (gen + 1u) * nloc) {
            __builtin_amdgcn_fence(__ATOMIC_RELEASE, "agent");
            asm volatile("s_waitcnt vmcnt(0)" ::: "memory");
            const unsigned og = xb_add(&bar[XB_TOP], 1u);
            const unsigned tg = og / nx;
            if (og + 1u == (tg + 1u) * nx) xb_add(&bar[XB_TOPGEN], 1u);
            else XB_SPIN(xb_ld(&bar[XB_TOPGEN]) == tg, bar);
            __builtin_amdgcn_fence(__ATOMIC_ACQUIRE, "agent");
            xb_add(&bar[XB_XGEN(b.x)], 1u);
            asm volatile("s_waitcnt vmcnt(0)" ::: "memory");
        } else {
            XB_SPIN(xb_ld(&bar[XB_XGEN(b.x)]) == gen, bar);
            __builtin_amdgcn_fence(__ATOMIC_ACQUIRE, "agent");
            asm volatile("s_waitcnt vmcnt(0)" ::: "memory");
        }
    }
    __syncthreads();
}

__global__ void __launch_bounds__(512, 2) mk_fwd(Args a) {
    extern __shared__ __attribute__((aligned(16))) unsigned char lds_raw[];
    cg::grid_group grid = cg::this_grid();
    LAS unsigned char* lds = (LAS unsigned char*)lds_raw;
    const int G = gridDim.x, bid = blockIdx.x, NGW = G * 8, NGT = G * 512;
#define PH_BEGIN unsigned char* ws = a.ws; asm volatile("" : "+s"(ws)); int tid = threadIdx.x; asm volatile("" : "+v"(tid)); int l = ll; asm volatile("" : "+s"(l)); \
    const int lane = tid & 63, wave = __builtin_amdgcn_readfirstlane(tid >> 6), gw = bid * 8 + wave, gt = bid * 512 + tid; (void)lane; (void)wave; (void)gw; (void)gt; (void)l; (void)ws;
#define WP(T, off) ((T*)(ws + (off)))
#define WIN_T WP(bf16, WS_WIN)
#define WUP_T WP(bf16, WS_WUP)
#define WOUT_T WP(bf16, WS_WOUT)
#define WCQ_T WP(bf16, WS_WCQ)
#define WCKV_T WP(bf16, WS_WCKV)
#define WCO_T WP(bf16, WS_WCO)
#define WFF1_T WP(bf16, WS_WFF1)
#define WFF2_T WP(bf16, WS_WFF2)
#define WGLU_T WP(bf16, WS_WGLU)
#define POOLT WP(bf16, WS_POOLT)
#define WST WP(bf16, WS_WST)
#define AB WP(float, WS_AB)
#define BBT WP(bf16, WS_BBT)
#define CM WP(bf16, WS_CM)
#define MEMN WP(bf16, WS_MEMN)
#define KV WP(bf16, WS_KV)
#define LSE WP(float, WS_LSE)
#define Hn WP(bf16, WS_H)
#define MERGED WP(bf16, WS_MERGED)
#define TOT WP(float, WS_TOT)
#define BR WP(bf16, WS_BR)
#define PROJ WP(bf16, WS_PROJ)
#define Y WP(bf16, WS_Y)
#define Qb WP(bf16, WS_Q)
#define Ob WP(bf16, WS_O)
#define HID WP(bf16, WS_HID)
#define YFF WP(bf16, WS_YFF)
#define X (a.out)
#define XS WP(bf16, WS_TOT)
#define IN(k) kin(k)
    volatile LAS unsigned* MISC = (volatile LAS unsigned*)(lds + LDS_BYTES - 64);
    if (threadIdx.x < 16) MISC[threadIdx.x] = 0u;
    __syncthreads();
    XcdBarrier xb = xcd_barrier_post((unsigned*)(a.ws + WS_CTL) + 4096, MISC + 8);
    grid.sync();
    for (int ll = 0; ll < DEPTH; ++ll) {
        { PH_BEGIN
            LAS float* scr = (LAS float*)(lds + wave * 16384);
            const float* w_in = IN(I_WIN) + (size_t)l * D * INW; const float* w_up = IN(I_WUP) + (size_t)l * 4 * 512 * 1024; const float* w_out = IN(I_WOUT) + (size_t)l * D * D;
            const float* w_cq = IN(I_WCQ) + (size_t)l * D * 512; const float* w_ckv = IN(I_WCKV) + (size_t)l * D * 1024; const float* w_co = IN(I_WCO) + (size_t)l * 512 * D;
            const float* w_ff1 = IN(I_WFF1) + (size_t)l * D * DFF; const float* w_ff2 = IN(I_WFF2) + (size_t)l * DFF * D; const float* w_glu = IN(I_WGLU) + (size_t)l * 512 * 512;
            const float* pool_w = IN(I_POOLW) + (size_t)l * 4 * 128 * 128;
            constexpr int N_WIN = (D / 64) * (INW / 32), N_UP = (512 / 64) * (1024 / 32), N_OUT = (D / 64) * (D / 32), N_CQ = (D / 64) * (512 / 32), N_CKV = (D / 64) * (1024 / 32),
                          N_CO = (512 / 64) * (D / 32), N_FF1 = (D / 64) * (DFF / 32), N_FF2 = (DFF / 64) * (D / 32), N_GLU = (512 / 64) * (512 / 32), N_POOL = (128 / 64) * (128 / 32);
            constexpr int NITEMS = N_WIN + 4 * N_UP + N_OUT + N_CQ + N_CKV + N_CO + N_FF1 + N_FF2 + N_GLU + 4 * N_POOL;
            for (int it = gw; it < NITEMS; it += NGW) {
                int r = it;
                if (r < N_WIN) { tr_item(w_in, D, INW, WIN_T, scr, r, lane); continue; } r -= N_WIN;
                if (r < 4 * N_UP) { const int i = r / N_UP; tr_item(w_up + (size_t)i * 512 * 1024, 512, 1024, WUP_T + (size_t)i * 1024 * 512, scr, r % N_UP, lane); continue; } r -= 4 * N_UP;
                if (r < N_OUT) { tr_item(w_out, D, D, WOUT_T, scr, r, lane); continue; } r -= N_OUT;
                if (r < N_CQ) { tr_item(w_cq, D, 512, WCQ_T, scr, r, lane); continue; } r -= N_CQ;
                if (r < N_CKV) { tr_item(w_ckv, D, 1024, WCKV_T, scr, r, lane); continue; } r -= N_CKV;
                if (r < N_CO) { tr_item(w_co, 512, D, WCO_T, scr, r, lane); continue; } r -= N_CO;
                if (r < N_FF1) { tr_item(w_ff1, D, DFF, WFF1_T, scr, r, lane); continue; } r -= N_FF1;
                if (r < N_FF2) { tr_item(w_ff2, DFF, D, WFF2_T, scr, r, lane); continue; } r -= N_FF2;
                if (r < N_GLU) { tr_item(w_glu, 512, 512, WGLU_T, scr, r, lane); continue; } r -= N_GLU;
                { const int i = r / N_POOL; tr_item(pool_w + (size_t)i * 128 * 128, 128, 128, POOLT + (size_t)i * 128 * 128, scr, r % N_POOL, lane); }
            }
            const float* w_s = IN(I_WS) + (size_t)l * 4 * 128 * 128;
            for (int e = gt; e < 4 * 128 * 128; e += NGT) { const int t = (e >> 7) & 127, s = e & 127; WST[e] = (s <= t) ? (bf16)f2bf(w_s[e]) : (bf16)0; }
            for (int e = gt; e < 32 * 64; e += NGT) {
                const int g = e >> 6, p = e & 63;
                const float are = fminf(IN(I_ARE)[(size_t)l * 2048 + e], -1e-4f), aim = IN(I_AIM)[(size_t)l * 2048 + e];
                const double lr = (double)are, li = (double)aim, dt = dexp((double)IN(I_LOGDT)[l * 32 + g]);
                const double mag = dexp_small(lr * dt); double sn, cs; dsincos(li * dt, sn, cs);
                const double abr = mag * cs, abi = mag * sn, den = lr * lr + li * li;
                const double fr_ = ((abr - 1.0) * lr + abi * li) / den, fi_ = (abi * lr - (abr - 1.0) * li) / den;
                AB[e * 2] = (float)abr; AB[e * 2 + 1] = (float)abi;
                const float* br_ = IN(I_BRE) + ((size_t)l * 2048 + e) * 16; const float* bi_ = IN(I_BIM) + ((size_t)l * 2048 + e) * 16;
                for (int c = 0; c < 16; ++c) { const double brc = br_[c], bic = bi_[c];
                    BBT[(g * 128 + p) * 16 + c] = (bf16)f2bf((float)(fr_ * brc - fi_ * bic)); BBT[(g * 128 + 64 + p) * 16 + c] = (bf16)f2bf((float)(fr_ * bic + fi_ * brc));
                    CM[(g * 16 + c) * 128 + p] = (bf16)f2bf(IN(I_CRE)[((size_t)l * 512 + g * 16 + c) * 64 + p]); CM[(g * 16 + c) * 128 + 64 + p] = (bf16)f2bf(-IN(I_CIM)[((size_t)l * 512 + g * 16 + c) * 64 + p]); }
            }
            for (int row = gw; row < NB * NMEM; row += NGW) rms_row_bf16(IN(I_MEM) + (size_t)row * D, IN(I_GMEM) + (size_t)l * D, MEMN + (size_t)row * D, lane);
            if (l == 0) for (int row = gw; row < M; row += NGW) rms_row_bf16(IN(I_X) + (size_t)row * D, IN(I_GMIXPRE), Hn + (size_t)row * D, lane);
        }
        xcd_barrier(xb);
        { PH_BEGIN
          pg8::Gemm g{MEMN, WCKV_T, NB * NMEM, 1024, D, D}; pg8::StaticOrder So; So.init(NB * NMEM, 1024, G, (bid + G / 2) % G);
          pg8::EpiPlain<0> E{KV, 1024, 1.f};
          pg8::gemm_phase<pg8::EpiPlain<0>, pg8::StaticOrder, true, true>(lds, g, So, E); }
        for (int hh = 0; hh < 2; ++hh) {
            { PH_BEGIN int hf = hh; asm volatile("" : "+s"(hf));
              pg8::Gemm g{Hn + (size_t)hf * MH * D, WIN_T, MH, INW, D, D}; pg8::StaticOrder So; So.init(MH, INW, G, bid);
              pg8::EpiProj E{PROJ, IN(I_GATEB) + (size_t)l * 4 * D};
              pg8::gemm_phase<pg8::EpiProj, pg8::StaticOrder, true, true>(lds, g, So, E); }
            xcd_barrier(xb);
            { PH_BEGIN int hf = hh; asm volatile("" : "+s"(hf));
                unsigned* ctr = (unsigned*)(ws + WS_CTL) + 8192 + (l * 2 + hf) * 64;
                volatile LAS int* nxt = (volatile LAS int*)(lds + LDS_BYTES - 64 + 16);
                if (tid == 0) { nxt[0] = (int)atomicAdd(ctr, 1u); nxt[1] = (int)atomicAdd(ctr, 1u); }
                __syncthreads();
                int u = nxt[0], un = nxt[1];
                __syncthreads();
                while (u < 1152) {
                    unsigned unn = 0u; if (tid == 0) unn = atomicAdd(ctr, 1u);
                    if (u < 128) ssm_unit(lds, PROJ, AB, BBT, CM, IN(I_DSKIP) + (size_t)l * 512, u, tid, lane, wave);
                    else if (u < 640) sgu_unit(lds, PROJ, WST, IN(I_LNG) + (size_t)l * 512, IN(I_LNB) + (size_t)l * 512, IN(I_BS) + (size_t)l * 512, BR + (size_t)3 * MH * 512, u - 128, tid, lane, wave);
                    else pool_unit(lds, PROJ, POOLT, IN(I_POOLS) + (size_t)l * 512, BR, u - 640, tid, lane, wave);
                    if (tid == 0) nxt[0] = (int)unn;
                    __syncthreads();
                    u = un; un = nxt[0];
                    __syncthreads();
                }
                if (u < 4224) {
                    AttnRegs<64> R;
                    { const DilU d = dil_decode(u - 1152, PROJ, LSE); attn_issue<64>(R, d.Qp, d.stride, d.Kp, d.Kp + 1536, d.stride, d.kfirst, tid, lane, wave); }
                    while (u < 4224) {
                        unsigned unn = 0u; if (tid == 0) unn = atomicAdd(ctr, 1u);
                        const DilU d = dil_decode(u - 1152, PROJ, LSE);
                        attn_stage<64, true>(lds, R, IN(I_RELB), d.dil, d.gh, tid);
                        bf16x8 qf[2] = {R.qf[0], R.qf[1]};
                        __syncthreads();
                        if (un < 4224) { const DilU dn = dil_decode(un - 1152, PROJ, LSE); attn_issue<64>(R, dn.Qp, dn.stride, dn.Kp, dn.Kp + 1536, dn.stride, dn.kfirst, tid, lane, wave); }
                        attn_compute<64, true>(lds, qf, d.kfirst, d.Qp, d.stride, d.lsep, d.dil, tid, lane, wave);
                        if (tid == 0) nxt[0] = (int)unn;
                        __syncthreads();
                        u = un; un = nxt[0];
                        __syncthreads();
                    }
                }
            }
            xcd_barrier(xb);
            { PH_BEGIN
                attn_merge(PROJ, LSE, BR + (size_t)1 * MH * 512, gt, NGT);
                pg8::Gemm g{PROJ + OFF_SSM, WGLU_T, MH, 512, 512, INW}; pg8::StaticOrder So; So.init(MH, 512, G, bid);
                pg8::EpiGlu E{PROJ, BR + (size_t)2 * MH * 512, IN(I_BGLU) + (size_t)l * 512};
                pg8::gemm_phase<pg8::EpiGlu, pg8::StaticOrder, true, true>(lds, g, So, E);
            }
            xcd_barrier(xb);
            { PH_BEGIN int hf = hh; asm volatile("" : "+s"(hf));
              pg8::Gemm g{BR, WUP_T, 4 * MH, 4 * 1024, 512, 512}; pg8::BranchOrder So{G, bid};
              pg8::EpiGateChain E{PROJ, MERGED + (size_t)hf * MH * D};
              pg8::gemm_phase<pg8::EpiGateChain, pg8::BranchOrder, true, true>(lds, g, So, E); }
            xcd_barrier(xb);
        }
        { PH_BEGIN
          pg8::Gemm g{MERGED, WOUT_T, M, D, D, D}; pg8::StaticOrder So; So.init(M, D, G, bid);
          pg8::EpiPlain<0> E{Y, D, 1.f};
          pg8::gemm_phase<pg8::EpiPlain<0>, pg8::StaticOrder, true, true>(lds, g, So, E); }
        xcd_barrier(xb);
        { PH_BEGIN if (l == 0) rowpass<true, false>(IN(I_X), Y, IN(I_GMIXPOST) + (size_t)l * D, IN(I_GXPRE) + (size_t)l * D, XS, Hn, gw, NGW, lane); else rowpass<false, false>(XS, Y, IN(I_GMIXPOST) + (size_t)l * D, IN(I_GXPRE) + (size_t)l * D, XS, Hn, gw, NGW, lane); }
        xcd_barrier(xb);
        { PH_BEGIN
          pg8::Gemm g{Hn, WCQ_T, M, 512, D, D}; pg8::StaticOrder So; So.init(M, 512, G, bid);
          pg8::EpiPlain<0> E{Qb, 512, 0.08838834764831845f};
          pg8::gemm_phase<pg8::EpiPlain<0>, pg8::StaticOrder, true, true>(lds, g, So, E); }
        xcd_barrier(xb);
        { PH_BEGIN
          for (int bu = bid; bu < 256; bu += G) {
              const int bh = bu >> 3, b = bh >> 2, h = bh & 3, tile0 = b * 32 + (bu & 7) * 4;
              const bf16* Kp = KV + (size_t)b * NMEM * 1024 + h * 128;
              bf16x8 qf[4];
              { AttnRegs<128> R; attn_issue<128>(R, Qb + (size_t)tile0 * 128 * 512 + h * 128, 512, Kp, Kp + 512, 1024, 0, tid, lane, wave);
                attn_stage<128, false>(lds, R, nullptr, 1, 0, tid);
#pragma unroll
                for (int ks = 0; ks < 4; ++ks) qf[ks] = R.qf[ks]; }
              __syncthreads();
              for (int k = 0; k < 4; ++k) { const int tile = tile0 + k, tn = tile0 + min(k + 1, 3);
                  bf16x8 qn[4];
#pragma unroll
                  for (int ks = 0; ks < 4; ++ks) qn[ks] = *(const bf16x8*)(Qb + (size_t)(tn * 128 + 16 * wave + (lane & 15)) * 512 + h * 128 + 32 * ks + 8 * (lane >> 4));
                  attn_compute<128, false>(lds, qf, 0, Ob + (size_t)tile * 128 * 512 + h * 128, 512, nullptr, 1, tid, lane, wave);
#pragma unroll
                  for (int ks = 0; ks < 4; ++ks) qf[ks] = qn[ks]; } } }
        xcd_barrier(xb);
        { PH_BEGIN
          pg8::Gemm g{Ob, WCO_T, M, D, 512, 512}; pg8::StaticOrder So; So.init(M, D, G, bid);
          pg8::EpiPlain<0> E{Y, D, 1.f};
          pg8::gemm_phase<pg8::EpiPlain<0>, pg8::StaticOrder, true, true>(lds, g, So, E); }
        xcd_barrier(xb);
        { PH_BEGIN rowpass<false, false>(XS, Y, IN(I_GXPOST) + (size_t)l * D, IN(I_GFFPRE) + (size_t)l * D, XS, Hn, gw, NGW, lane); }
        xcd_barrier(xb);
        { PH_BEGIN
          pg8::Gemm g{Hn, WFF1_T, M, DFF, D, D}; pg8::StaticOrder So; So.init(M, DFF, G, bid);
          pg8::EpiPlain<1> E{HID, DFF, 1.f};
          pg8::gemm_phase<pg8::EpiPlain<1>, pg8::StaticOrder, true, true>(lds, g, So, E); }
        xcd_barrier(xb);
        { PH_BEGIN
          pg8::Gemm g{HID, WFF2_T, M, D, DFF, DFF}; pg8::StaticOrder So; So.init(M, D, G, bid);
          pg8::EpiPlain<0> E{YFF, D, 1.f};
          pg8::gemm_phase<pg8::EpiPlain<0>, pg8::StaticOrder, true, true>(lds, g, So, E); }
        xcd_barrier(xb);
        { PH_BEGIN if (l + 1 < DEPTH) rowpass<false, false>(XS, YFF, IN(I_GFFPOST) + (size_t)l * D, IN(I_GMIXPRE) + (size_t)(l + 1) * D, XS, Hn, gw, NGW, lane); else rowpass<false, true>(XS, YFF, IN(I_GFFPOST) + (size_t)l * D, nullptr, X, Hn, gw, NGW, lane); }
        xcd_barrier(xb);
    }
}

extern "C" void kernel_launch(void* const* d_in, const int* in_sizes, int n_in, void* d_out, int out_size, void* d_ws, size_t ws_size, hipStream_t stream) {
    static int grid = 0;
    if (grid == 0) {
        if (n_in != 35 || in_sizes[0] != M * D || out_size != M * D || ws_size < WS_END) { fprintf(stderr, "kernel_launch: unexpected problem (n_in %d, ws %zu, need %zu)\n", n_in, ws_size, (size_t)WS_END); grid = -1; return; }
        int dev = 0, cus = 0, per_cu = 0;
        (void)hipGetDevice(&dev); (void)hipDeviceGetAttribute(&cus, hipDeviceAttributeMultiprocessorCount, dev);
        if (hipFuncSetAttribute((const void*)mk_fwd, hipFuncAttributeMaxDynamicSharedMemorySize, LDS_BYTES) != hipSuccess) { fprintf(stderr, "kernel_launch: hipFuncSetAttribute failed\n"); grid = -1; return; }
        if (hipOccupancyMaxActiveBlocksPerMultiprocessor(&per_cu, (const void*)mk_fwd, 512, LDS_BYTES) != hipSuccess || per_cu < 1) per_cu = 1;
        (void)hipGetLastError();
        grid = cus * 1;
        if (grid <= 0) grid = 256;
    }
    if (grid < 0) return;
    if (hipMemsetAsync((char*)d_ws + WS_CTL, 0, 65536, stream) != hipSuccess) { fprintf(stderr, "memset failed\n"); return; }
    Args a{};
    for (int i = 0; i < 35; ++i) a.in[i] = (const float*)d_in[i];
    a.out = (float*)d_out; a.ws = (unsigned char*)d_ws;
    void* args[] = {&a};
    hipError_t e = hipLaunchCooperativeKernel((const void*)mk_fwd, dim3(grid), dim3(512), args, LDS_BYTES, stream);
    if (e != hipSuccess) fprintf(stderr, "cooperative launch failed: %s (grid %d)\n", hipGetErrorString(e), grid);
}
```
